# Optimizing an MI355X kernel written in HIP

```python
import jax
import jax.numpy as jnp
from jax import lax
import numpy as np

D_MODEL = 1024
BATCH = 8
SEQ = 2048
DEPTH = 4

GRID_W = 64
CTX_LEN = 256
N_MIXERS = 3
N_SUB = 3
D_FF = 2816
MACARON_WEIGHT = 0.5
NORM_EPS = 1e-6

MLA_HEADS = 8
MLA_Q_RANK = 512
MLA_KV_RANK = 256
MLA_NOPE = 128
MLA_ROPE = 64
MLA_V = 128
MLA_SCALE = (MLA_NOPE + MLA_ROPE) ** -0.5
ROPE_PAIRS = MLA_ROPE // 4
ROPE_BASE = 10000.0
Q_BLOCK = 128

FNET_GROUPS = 8
FNET_GROUP_DIM = D_MODEL // FNET_GROUPS

RWKV_HEAD = 64
RWKV_HEADS = D_MODEL // RWKV_HEAD
RWKV_DECAY_LORA = 64
RWKV_AAA_LORA = 64
RWKV_GATE_LORA = 160
RWKV_GN_EPS = 64e-5
N_DIR = 2

N_LAYERS_A = (DEPTH + 2) // 3
N_LAYERS_B = (DEPTH + 1) // 3
N_LAYERS_C = DEPTH // 3

kernel_name = 'hybrid_mla_fnet_rwkv7_flow_block'


def rms_norm(x, g):
    x32 = x.astype(jnp.float32)
    y = x32 * lax.rsqrt(jnp.mean(x32 * x32, axis=-1, keepdims=True) + NORM_EPS)
    return (y * g.astype(jnp.float32)).astype(x.dtype)


def modulate(z, g, m):
    return rms_norm(z, g) * (1.0 + m[:, 1]) + m[:, 0]


def gated_residual(z, y, g, m, weight):
    return z + weight * m[:, 2] * rms_norm(y, g)


def swiglu(x, w_gate, w_up, w_down):
    return (jax.nn.silu(x @ w_gate) * (x @ w_up)) @ w_down


def ffn_sublayer(z, m, g_pre, g_post, w_gate, w_up, w_down):
    y = swiglu(modulate(z, g_pre, m), w_gate, w_up, w_down)
    return gated_residual(z, y, g_post, m, MACARON_WEIGHT)


def axial_rope_tables(T):
    rows = T // GRID_W
    row = jnp.repeat(jnp.arange(rows), GRID_W).astype(jnp.float32)
    col = jnp.tile(jnp.arange(GRID_W), rows).astype(jnp.float32)
    inv = ROPE_BASE ** (-jnp.arange(ROPE_PAIRS, dtype=jnp.float32) / ROPE_PAIRS)
    ang = jnp.stack([row[:, None] * inv, col[:, None] * inv], axis=1)
    return jnp.cos(ang), jnp.sin(ang)


def apply_axial_rope(x, cos, sin):
    xr = x.astype(jnp.float32).reshape(x.shape[:-1] + (2, 2, ROPE_PAIRS))
    x1, x2 = xr[..., 0, :], xr[..., 1, :]
    out = jnp.stack([x1 * cos - x2 * sin, x2 * cos + x1 * sin], axis=-2)
    return out.reshape(x.shape).astype(x.dtype)


def attention(q, k, v):
    s = jnp.einsum('bqhd,bkhd->bhqk', q, k).astype(jnp.float32)
    p = jax.nn.softmax(s, axis=-1).astype(v.dtype)
    return jnp.einsum('bhqk,bkhd->bqhd', p, v)


def blocked_attention(q, k, v):
    B, T, H, Dk = q.shape
    qb = jnp.moveaxis(q.reshape(B, T // Q_BLOCK, Q_BLOCK, H, Dk), 1, 0)
    o = lax.map(lambda qi: attention(qi, k, v), qb)
    return jnp.moveaxis(o, 0, 1).reshape(B, T, H, v.shape[-1])


def mla_queries(u, w_dq, q_norm, w_uq, cos, sin):
    B, T, _ = u.shape
    q = (rms_norm(u @ w_dq, q_norm) @ w_uq).reshape(B, T, MLA_HEADS, MLA_NOPE + MLA_ROPE)
    q_nope, q_pe = q[..., :MLA_NOPE], q[..., MLA_NOPE:]
    if cos is not None:
        q_pe = apply_axial_rope(q_pe, cos[:, None], sin[:, None])
    return jnp.concatenate([q_nope, q_pe], axis=-1) * MLA_SCALE


def mla_keys_values(u, w_dkv, kv_norm, w_ukv, cos, sin):
    B, T, _ = u.shape
    ckv = u @ w_dkv
    c_kv, k_pe = ckv[..., :MLA_KV_RANK], ckv[..., MLA_KV_RANK:]
    kv = (rms_norm(c_kv, kv_norm) @ w_ukv).reshape(B, T, MLA_HEADS, MLA_NOPE + MLA_V)
    k_nope, v = kv[..., :MLA_NOPE], kv[..., MLA_NOPE:]
    if cos is not None:
        k_pe = apply_axial_rope(k_pe, cos, sin)
    k_pe = jnp.broadcast_to(k_pe[:, :, None, :], (B, T, MLA_HEADS, MLA_ROPE))
    return jnp.concatenate([k_nope, k_pe], axis=-1), v


def mla_mixer(u, uc, cos, sin, ctx_out, w_dq, q_norm, w_uq, w_dkv, kv_norm, w_ukv, w_o):
    B, T, _ = u.shape
    k_c, v_c = mla_keys_values(uc, w_dkv, kv_norm, w_ukv, None, None)
    k_l, v_l = mla_keys_values(u, w_dkv, kv_norm, w_ukv, cos, sin)
    q_l = mla_queries(u, w_dq, q_norm, w_uq, cos, sin)
    o = blocked_attention(q_l, jnp.concatenate([k_l, k_c], axis=1), jnp.concatenate([v_l, v_c], axis=1))
    y = o.reshape(B, T, MLA_HEADS * MLA_V) @ w_o
    yc = None
    if ctx_out:
        q_c = mla_queries(uc, w_dq, q_norm, w_uq, None, None)
        yc = attention(q_c, k_c, v_c).reshape(B, uc.shape[1], MLA_HEADS * MLA_V) @ w_o
    return y, yc


def fourier_mix(u):
    B, T, D = u.shape
    z = u.astype(jnp.float32).reshape(B, T, FNET_GROUPS, FNET_GROUP_DIM)
    f = jnp.fft.fft2(z, axes=(1, 3), norm='ortho').real
    return f.reshape(B, T, D).astype(u.dtype)


def fnet_mixer(u, uc, ctx_out, w_o, b_o):
    y = fourier_mix(u) @ w_o + b_o
    yc = fourier_mix(uc) @ w_o + b_o if ctx_out else None
    return y, yc


def split_heads(z):
    return z.reshape(z.shape[:-1] + (RWKV_HEADS, RWKV_HEAD))


def centred_token_shift(x):
    z = jnp.pad(x, ((0, 0), (1, 1), (0, 0)))
    return 0.5 * (z[:, :-2] + z[:, 2:]) - x


def rwkv_features(u, mix, w_r, w_k, w_v, w0, w1, w2, a0, a1, a2, g1, g2, k_k, k_a):
    B, T, D = u.shape
    f32 = jnp.float32
    xx = centred_token_shift(u)
    xr, xw, xk, xv, xa, xg = (u + xx * mix[m] for m in range(6))
    r = (xr @ w_r).astype(f32)
    k = (xk @ w_k).astype(f32)
    v = (xv @ w_v).astype(f32)
    g = jax.nn.sigmoid(xg @ g1) @ g2
    w_lora = jnp.einsum('ebtr,erd->ebtd', jnp.tanh(jnp.einsum('btd,edr->ebtr', xw, w1)), w2)
    w_log = -jax.nn.softplus(-(w0[:, None, None, :] + w_lora).astype(f32)) - 0.5
    decay = jnp.exp(-jnp.exp(w_log))
    a_lora = jnp.einsum('ebtr,erd->ebtd', jnp.einsum('btd,edr->ebtr', xa, a1), a2)
    a = jax.nn.sigmoid((a0[:, None, None, :] + a_lora).astype(f32))
    kk = split_heads(k * k_k.astype(f32))
    kk = kk / jnp.maximum(jnp.sqrt(jnp.sum(kk * kk, axis=-1, keepdims=True)), 1e-12)
    k_dir = k[None] * (1.0 + (a - 1.0) * k_a.astype(f32))
    return split_heads(r), split_heads(decay), split_heads(k_dir), split_heads(v), kk, split_heads(a), g


def wkv_step(S, inp):
    r, w, k, v, a, b = inp
    sa = jnp.einsum('ebhij,ebhj->ebhi', S, a)
    S = S * w[..., None, :] + sa[..., :, None] * b[..., None, :] + v[..., :, None] * k[..., None, :]
    return S, jnp.einsum('ebhij,ebhj->ebhi', S, r)


def wkv_bidirectional(S0, r, decay, k_dir, v, kk, a):
    def orient(z):
        return jnp.stack([z[0], z[1][:, ::-1]])

    def both(z):
        return jnp.stack([z, z[:, ::-1]])

    xs = (both(r), orient(decay), orient(k_dir), both(v), both(-kk), orient(kk[None] * a))
    xs = tuple(jnp.moveaxis(z, 2, 0) for z in xs)
    S, ys = lax.scan(wkv_step, S0, xs)
    ys = jnp.moveaxis(ys, 0, 2)
    return S, ys[0] + ys[1][:, ::-1]


def rwkv_output(y, r, k_dir, v, g, r_k, ln_w, ln_b, w_o):
    B, T, H, N = y.shape
    f32 = jnp.float32
    mu = jnp.mean(y, axis=-1, keepdims=True)
    var = jnp.mean(jnp.square(y - mu), axis=-1, keepdims=True)
    yn = ((y - mu) * lax.rsqrt(var + RWKV_GN_EPS)).reshape(B, T, H * N)
    yn = yn * ln_w.astype(f32) + ln_b.astype(f32)
    coef = jnp.einsum('bthn,ebthn,hn->bth', r, k_dir, r_k.astype(f32))
    bonus = (coef[..., None] * v).reshape(B, T, H * N)
    out = (yn + bonus) * g.astype(f32)
    return out.astype(g.dtype) @ w_o


def rwkv_mixer(u, uc, ctx_out, mix, w_r, w_k, w_v, w0, w1, w2, a0, a1, a2, g1, g2,
               k_k, k_a, r_k, ln_w, ln_b, w_o):
    B = u.shape[0]
    fc = rwkv_features(uc, mix, w_r, w_k, w_v, w0, w1, w2, a0, a1, a2, g1, g2, k_k, k_a)
    S0 = jnp.zeros((N_DIR, B, RWKV_HEADS, RWKV_HEAD, RWKV_HEAD), jnp.float32)
    S_ctx, y_c = wkv_bidirectional(S0, *fc[:6])
    fl = rwkv_features(u, mix, w_r, w_k, w_v, w0, w1, w2, a0, a1, a2, g1, g2, k_k, k_a)
    _, y_l = wkv_bidirectional(S_ctx, *fl[:6])
    y = rwkv_output(y_l, fl[0], fl[2], fl[3], fl[6], r_k, ln_w, ln_b, w_o)
    yc = rwkv_output(y_c, fc[0], fc[2], fc[3], fc[6], r_k, ln_w, ln_b, w_o) if ctx_out else None
    return y, yc


def setup_inputs(seed: int = 0) -> dict:
    key = jax.random.key(seed)
    ks = iter(jax.random.split(key, 64))
    f32 = jnp.float32

    def nrm(shape, fan_in, scale=1.0):
        return jax.random.normal(next(ks), shape, f32) * (scale * fan_in ** -0.5)

    def gain(shape):
        return 1.0 + 0.02 * jax.random.normal(next(ks), shape, f32)

    def small(shape, s=0.01):
        return s * jax.random.normal(next(ks), shape, f32)

    def unif(shape, lo, hi):
        return jax.random.uniform(next(ks), shape, f32, lo, hi)

    D, L, F = D_MODEL, DEPTH, D_FF
    NA, NB, NC = N_LAYERS_A, N_LAYERS_B, N_LAYERS_C
    H, N = RWKV_HEADS, RWKV_HEAD
    return {
        'x': jax.random.normal(next(ks), (BATCH, SEQ, D), f32),
        'c': jax.random.normal(next(ks), (BATCH, D), f32),
        'ctx': jax.random.normal(next(ks), (BATCH, CTX_LEN, D), f32),
        'c_ctx': jax.random.normal(next(ks), (D,), f32),
        'mod_w': nrm((L, D, N_SUB * 3 * D), D, 0.5),
        'mod_b': small((L, N_SUB * 3 * D), 0.1),
        'norm_pre': gain((L, N_SUB, D)),
        'norm_post': gain((L, N_SUB, D)),
        'ffn_w_gate': nrm((L, 2, D, F), D),
        'ffn_w_up': nrm((L, 2, D, F), D),
        'ffn_w_down': nrm((L, 2, F, D), F),
        'mla_w_dq': nrm((NA, D, MLA_Q_RANK), D),
        'mla_q_norm': gain((NA, MLA_Q_RANK)),
        'mla_w_uq': nrm((NA, MLA_Q_RANK, MLA_HEADS * (MLA_NOPE + MLA_ROPE)), MLA_Q_RANK),
        'mla_w_dkv': nrm((NA, D, MLA_KV_RANK + MLA_ROPE), D),
        'mla_kv_norm': gain((NA, MLA_KV_RANK)),
        'mla_w_ukv': nrm((NA, MLA_KV_RANK, MLA_HEADS * (MLA_NOPE + MLA_V)), MLA_KV_RANK),
        'mla_w_o': nrm((NA, MLA_HEADS * MLA_V, D), MLA_HEADS * MLA_V),
        'fnet_w_o': nrm((NB, D, D), D),
        'fnet_b_o': small((NB, D)),
        'rwkv_mix': unif((NC, 6, D), 0.0, 1.0),
        'rwkv_w_r': nrm((NC, D, D), D),
        'rwkv_w_k': nrm((NC, D, D), D),
        'rwkv_w_v': nrm((NC, D, D), D),
        'rwkv_w0': unif((NC, N_DIR, D), -5.0, 1.0),
        'rwkv_w1': nrm((NC, N_DIR, D, RWKV_DECAY_LORA), D),
        'rwkv_w2': nrm((NC, N_DIR, RWKV_DECAY_LORA, D), RWKV_DECAY_LORA, 0.1),
        'rwkv_a0': small((NC, N_DIR, D), 0.1),
        'rwkv_a1': nrm((NC, N_DIR, D, RWKV_AAA_LORA), D),
        'rwkv_a2': nrm((NC, N_DIR, RWKV_AAA_LORA, D), RWKV_AAA_LORA, 0.1),
        'rwkv_g1': nrm((NC, D, RWKV_GATE_LORA), D),
        'rwkv_g2': nrm((NC, RWKV_GATE_LORA, D), RWKV_GATE_LORA),
        'rwkv_k_k': 0.85 + small((NC, D), 0.05),
        'rwkv_k_a': 1.0 + small((NC, D), 0.05),
        'rwkv_r_k': small((NC, H, N), 0.1),
        'rwkv_ln_w': gain((NC, D)),
        'rwkv_ln_b': small((NC, D)),
        'rwkv_w_o': nrm((NC, D, D), D),
    }


def reference(x, c, ctx, c_ctx, mod_w, mod_b, norm_pre, norm_post, ffn_w_gate, ffn_w_up, ffn_w_down,
              mla_w_dq, mla_q_norm, mla_w_uq, mla_w_dkv, mla_kv_norm, mla_w_ukv, mla_w_o,
              fnet_w_o, fnet_b_o,
              rwkv_mix, rwkv_w_r, rwkv_w_k, rwkv_w_v, rwkv_w0, rwkv_w1, rwkv_w2, rwkv_a0, rwkv_a1, rwkv_a2,
              rwkv_g1, rwkv_g2, rwkv_k_k, rwkv_k_a, rwkv_r_k, rwkv_ln_w, rwkv_ln_b, rwkv_w_o):
    B, T, D = x.shape
    cos, sin = axial_rope_tables(T)
    h, hc = x, ctx
    sc, scc = jax.nn.silu(c), jax.nn.silu(c_ctx)
    for i in range(DEPTH):
        kind, j, last = i % N_MIXERS, i // N_MIXERS, i == DEPTH - 1
        ctx_in = (not last) or kind != 1
        mod_l = (sc @ mod_w[i] + mod_b[i]).reshape(B, N_SUB, 3, 1, D)
        mod_c = (scc @ mod_w[i] + mod_b[i]).reshape(1, N_SUB, 3, 1, D)
        h = ffn_sublayer(h, mod_l[:, 0], norm_pre[i, 0], norm_post[i, 0],
                         ffn_w_gate[i, 0], ffn_w_up[i, 0], ffn_w_down[i, 0])
        if ctx_in:
            hc = ffn_sublayer(hc, mod_c[:, 0], norm_pre[i, 0], norm_post[i, 0],
                              ffn_w_gate[i, 0], ffn_w_up[i, 0], ffn_w_down[i, 0])
        u = modulate(h, norm_pre[i, 1], mod_l[:, 1])
        uc = modulate(hc, norm_pre[i, 1], mod_c[:, 1]) if ctx_in else None
        if kind == 0:
            y, yc = mla_mixer(u, uc, cos, sin, not last, mla_w_dq[j], mla_q_norm[j], mla_w_uq[j],
                              mla_w_dkv[j], mla_kv_norm[j], mla_w_ukv[j], mla_w_o[j])
        elif kind == 1:
            y, yc = fnet_mixer(u, uc, not last, fnet_w_o[j], fnet_b_o[j])
        else:
            y, yc = rwkv_mixer(u, uc, not last, rwkv_mix[j], rwkv_w_r[j], rwkv_w_k[j], rwkv_w_v[j],
                               rwkv_w0[j], rwkv_w1[j], rwkv_w2[j], rwkv_a0[j], rwkv_a1[j], rwkv_a2[j],
                               rwkv_g1[j], rwkv_g2[j], rwkv_k_k[j], rwkv_k_a[j], rwkv_r_k[j],
                               rwkv_ln_w[j], rwkv_ln_b[j], rwkv_w_o[j])
        h = gated_residual(h, y, norm_post[i, 1], mod_l[:, 1], 1.0)
        h = ffn_sublayer(h, mod_l[:, 2], norm_pre[i, 2], norm_post[i, 2],
                         ffn_w_gate[i, 1], ffn_w_up[i, 1], ffn_w_down[i, 1])
        if not last:
            hc = gated_residual(hc, yc, norm_post[i, 1], mod_c[:, 1], 1.0)
            hc = ffn_sublayer(hc, mod_c[:, 2], norm_pre[i, 2], norm_post[i, 2],
                              ffn_w_gate[i, 1], ffn_w_up[i, 1], ffn_w_down[i, 1])
    return h
```

```cpp
#include <hip/hip_runtime.h>
#include <hip/hip_cooperative_groups.h>
#include <cstdio>
namespace cg = cooperative_groups;

#define LAS __attribute__((address_space(3)))
#define DEVINL __device__ __forceinline__
typedef unsigned short bf16_t;
typedef short bf16x8 __attribute__((ext_vector_type(8)));
typedef short s16x4 __attribute__((ext_vector_type(4)));
typedef float f32x4 __attribute__((ext_vector_type(4)));
typedef float f32x16 __attribute__((ext_vector_type(16)));
typedef unsigned u32x4 __attribute__((ext_vector_type(4)));
typedef unsigned u32x2 __attribute__((ext_vector_type(2)));

constexpr int DM = 1024, NB = 8, SEQ = 2048, CTX = 256, DFF = 2816, NLAT = NB * SEQ, NCTX = NB * CTX, NTOK = NLAT + NCTX, TKV = SEQ + CTX;
constexpr int MODW = 9 * DM;
constexpr float EPS = 1e-6f;

constexpr size_t al256(size_t x) { return (x + 255) / 256 * 256; }
constexpr size_t WS_MOD = 0;
constexpr size_t WS_ROPE = al256(WS_MOD + (size_t)4 * 9 * MODW * 4);
constexpr size_t WS_HC = al256(WS_ROPE + 2 * 64 * 16 * 4);
constexpr size_t WS_XN = al256(WS_HC + (size_t)NCTX * DM * 4);
constexpr size_t WS_Y = al256(WS_XN + (size_t)NTOK * 2048 * 2);
constexpr size_t FFN_WGU = (size_t)2 * DFF * DM;
constexpr size_t FFN_WD = (size_t)DM * DFF;
constexpr size_t FFN_SLOT = 2 * (FFN_WGU + FFN_WD);
constexpr size_t WS_WF = al256(WS_Y + (size_t)NTOK * DM * 4);
constexpr size_t WS_WM = al256(WS_WF + 2 * FFN_SLOT * 2);
constexpr size_t MLA_DQKV = 0, MLA_UQ = MLA_DQKV + 1024 * 1024, MLA_UKV = MLA_UQ + 1536 * 512, MLA_WO = MLA_UKV + 2048 * 256, MLA_SZ = MLA_WO + 1024 * 1024;
constexpr size_t WM_MLA0 = 0, WM_MLA1 = MLA_SZ;
constexpr size_t WM_W2T = 2 * MLA_SZ, WM_DT2 = WM_W2T + 1024 * 2048, WM_DT2C = WM_DT2 + (size_t)4096 * 2048;
constexpr size_t WM_WCAT = WM_DT2C + 512 * 256, WM_BW = WM_WCAT + (size_t)3584 * 2048, WM_BA = WM_BW + 2048 * 256, WM_BG = WM_BA + 2048 * 256, WM_RWO = WM_BG + 1024 * 256;
constexpr size_t WM_END = WM_RWO + 1024 * 1024;
constexpr size_t WS_SCR = al256(WS_WM + WM_END * 2);
constexpr size_t SCR_BYTES = 245366784;
constexpr size_t WS_BAR = WS_SCR + SCR_BYTES;
constexpr int NSLAB = 6;
constexpr size_t WS_SLAB = WS_BAR + 16384;
constexpr size_t WS_END = WS_SLAB + (size_t)NSLAB * NCTX * DM * 4;
constexpr size_t S_G = 0;
constexpr size_t S_QN = 0, S_CKVN = S_QN + (size_t)NTOK * 512 * 2, S_Q = S_CKVN + (size_t)NTOK * 256 * 2, S_K = S_Q + (size_t)64 * TKV * 192 * 2,
                 S_V = S_K + (size_t)64 * TKV * 192 * 2;
constexpr size_t S_XT = 0, S_XTC = S_XT + (size_t)8 * 1024 * 2048 * 2, S_P = al256(S_XTC + (size_t)8 * 1024 * 256 * 2);
constexpr size_t S_R = 0, S_KK = S_R + (size_t)NTOK * DM * 2, S_VV = S_KK + (size_t)NTOK * DM * 2, S_A2 = S_VV + (size_t)NTOK * DM * 2,
                 S_AA = S_A2 + (size_t)NTOK * 512 * 2, S_GG = S_AA + (size_t)2 * NTOK * DM * 2;
static_assert(S_GG + (size_t)NTOK * DM * 2 <= SCR_BYTES, "scratch");
static_assert(S_V + (size_t)64 * TKV * 128 * 2 <= SCR_BYTES, "scratch");
static_assert(S_P + (size_t)NTOK * 2048 * 2 <= SCR_BYTES, "scratch");

constexpr int LDS_BYTES = 135168;

struct Params { const float* in[38]; float* out; unsigned char* ws; };
struct PV { const Params& p; int z; unsigned char* ws; float* out;
    __device__ __forceinline__ const float* in(int k) const { return p.in[k + z]; } };

DEVINL int otid() { int t = threadIdx.x; asm volatile("" : "+v"(t)); return t; }
DEVINL int obid() { int b = blockIdx.x; asm volatile("" : "+s"(b)); return b; }
DEVINL float bf2f(bf16_t b) { return __uint_as_float(((unsigned)b) << 16); }
DEVINL bf16_t f2bf(float f) { unsigned u = __float_as_uint(f); u += 0x7FFFu + ((u >> 16) & 1u); return (bf16_t)(u >> 16); }
typedef float f32x2c __attribute__((ext_vector_type(2)));
typedef __bf16 bf16x2c __attribute__((ext_vector_type(2)));
DEVINL unsigned pk2(float lo, float hi) { const f32x2c v = {lo, hi}; const bf16x2c r = __builtin_convertvector(v, bf16x2c); return __builtin_bit_cast(unsigned, r); }
DEVINL float wave_sum(float v) {
#pragma unroll
    for (int o = 32; o > 0; o >>= 1) v += __shfl_xor(v, o);
    return v; }
#define DPPF(v, ctrl) __builtin_bit_cast(float, __builtin_amdgcn_update_dpp(0, __builtin_bit_cast(int, (v)), (ctrl), 0xF, 0xF, false))
DEVINL float wave_sum_dpp(float v) {
    v += DPPF(v, 0xB1); v += DPPF(v, 0x4E); v += DPPF(v, 0x141); v += DPPF(v, 0x140);
    const int vi_ = __builtin_bit_cast(int, v);
    return __builtin_bit_cast(float, __builtin_amdgcn_readlane(vi_, 0)) + __builtin_bit_cast(float, __builtin_amdgcn_readlane(vi_, 16)) + __builtin_bit_cast(float, __builtin_amdgcn_readlane(vi_, 32)) + __builtin_bit_cast(float, __builtin_amdgcn_readlane(vi_, 48));
}
DEVINL float sum16(float v) {
#pragma unroll
    for (int o = 8; o > 0; o >>= 1) v += __shfl_xor(v, o);
    return v; }
DEVINL float silu_f(float x) { return x * __builtin_amdgcn_rcpf(1.f + __expf(-x)); }
DEVINL float sigm_f(float x) { return __builtin_amdgcn_rcpf(1.f + __expf(-x)); }
DEVINL float lo_bf(unsigned w) { return __uint_as_float(w << 16); }
DEVINL float hi_bf(unsigned w) { return __uint_as_float(w & 0xFFFF0000u); }

constexpr int BM = 256, BK = 64, HALF = 128, HTB = HALF * BK * 2, NXCD = 8, WGM = 8;
DEVINL int lds_byte(int r, int c) { const int st = (r >> 4) * 2 + (c >> 5), rr = r & 15, cc = c & 31, ob = rr * 64 + cc * 2; return st * 1024 + (ob ^ (((ob >> 9) & 1) << 5)); }
DEVINL void stage_rc(int b, int& R, int& C) { const int st = b / 1024, sb = b % 1024, swz = sb ^ (((sb >> 9) & 1) << 5); R = (st >> 1) * 16 + swz / 64; C = (st & 1) * 32 + (swz % 64) / 2; }
DEVINL int perm32(int rho) { const int n = rho >> 4, i = rho & 15; return 8 * (i >> 2) + 4 * n + (i & 3); }
struct Unit { int pm, pn, ks; };
struct Gemm { const bf16_t* A; const bf16_t* Bt; int lda, ldb, K, nM, nN, amod; size_t bbatch; int nTailM, nSl, KS; };
struct Sched {
    int nM, nN, nwg, G, c, ntail, nSl;
    DEVINL void init(int nM_, int nN_, int nTailM, int nSl_) { nM = nM_; nN = nN_; nwg = nM * nN; G = gridDim.x; c = obid(); nSl = nSl_; ntail = nTailM * nN_ * nSl_; }
    DEVINL bool next(int i, Unit& u) const {
        const long L = (long)i * G + c; if (L >= nwg + ntail) return false;
        if (L >= nwg) { const int t = (int)L - nwg, rest = t / nSl; u.ks = t % nSl; u.pn = rest % nN; u.pm = nM + rest / nN; return true; }
        u.ks = -1;
        int wgid = (int)L; { const int q = nwg / NXCD, r = nwg % NXCD, xcd = wgid % NXCD, off = wgid / NXCD; wgid = (xcd < r ? xcd * (q + 1) : r * (q + 1) + (xcd - r) * q) + off; }
        const int nig = WGM * nN, gid = wgid / nig, fm = gid * WGM, gsz = (nM - fm) < WGM ? (nM - fm) : WGM;
        u.pm = fm + ((wgid % nig) % gsz); u.pn = (wgid % nig) / gsz; return true;
    }
};
typedef f32x4 Acc[2][2][4][2];

template <class Epi>
DEVINL void gemm_phase(LAS unsigned char* lds, const Gemm g, const Epi& E) {
    const int tid = otid(), wid = __builtin_amdgcn_readfirstlane(tid >> 6), lane = tid & 63, wr = wid >> 2, wc = wid & 3, fr = lane & 15, fq = lane >> 4;
    Sched S; S.init(g.nM, g.nN, g.nTailM, g.nSl);
    const int K = g.K;
    unsigned voffA[2], voffB[2];
#pragma unroll
    for (int i = 0; i < 2; ++i) { int R, C; stage_rc(tid * 16 + i * 8192, R, C);
        const int Rb = Epi::PERM ? ((R & ~31) + perm32(R & 31)) : R;
        voffA[i] = (unsigned)(R * g.lda + C) * 2u; voffB[i] = (unsigned)(Rb * g.ldb + C) * 2u; }
    const size_t kstep = (size_t)(BK * 2);
    const size_t hstepA = (size_t)HALF * g.lda * 2, hstepB = (size_t)HALF * g.ldb * 2;
    const size_t tstepA = 2 * hstepA, tstepB = 2 * hstepB;
    const unsigned ldsw = (unsigned)wid * 1024u;
    const int aoff = lds_byte(wr * 64 + fr, fq * 8), boff = lds_byte(wc * 32 + fr, fq * 8);
#define PG8_SA(b, h) (((b) * 2 + (h)) * HTB)
#define PG8_SB(b, h) ((4 + (b) * 2 + (h)) * HTB)
#define PG8_STAGE(bufoff, gbase, voff) do { _Pragma("unroll") for (int _i = 0; _i < 2; ++_i) \
        __builtin_amdgcn_global_load_lds((const unsigned*)((const char*)(gbase) + (voff)[_i]), (LAS unsigned*)(lds + (bufoff) + ldsw + _i * 8192), 16, 0, 0); } while (0)
#define PG8_LDA(dst, b, h) do { _Pragma("unroll") for (int m = 0; m < 4; ++m) _Pragma("unroll") for (int k = 0; k < 2; ++k) dst[m][k] = *(const LAS bf16x8*)(lds + PG8_SA(b, h) + aoff + m * 2048 + k * 1024); } while (0)
#define PG8_LDB(dst, b, h) do { _Pragma("unroll") for (int n = 0; n < 2; ++n) _Pragma("unroll") for (int k = 0; k < 2; ++k) dst[n][k] = *(const LAS bf16x8*)(lds + PG8_SB(b, h) + boff + n * 2048 + k * 1024); } while (0)
#define PG8_MMA(ai, bj, At, Bt) do { __builtin_amdgcn_s_setprio(1); _Pragma("unroll") for (int m = 0; m < 4; ++m) _Pragma("unroll") for (int n = 0; n < 2; ++n) _Pragma("unroll") for (int k = 0; k < 2; ++k) \
        acc[ai][bj][m][n] = __builtin_amdgcn_mfma_f32_16x16x32_bf16(Bt[n][k], At[m][k], acc[ai][bj][m][n], 0, 0, 0); __builtin_amdgcn_s_setprio(0); } while (0)
#define PG8_WAIT_V(n) asm volatile("s_waitcnt vmcnt(" #n ")" ::: "memory")
#define PG8_WAIT_L(n) asm volatile("s_waitcnt lgkmcnt(" #n ")" ::: "memory")
#define PG8_BAR __builtin_amdgcn_s_barrier()
#define PG8_SCHED __builtin_amdgcn_sched_barrier(0)
    Unit cur, nxt; int ui = 0;
    if (!S.next(0, cur)) return;
    Acc acc;
#pragma unroll
    for (int a = 0; a < 2; ++a)
#pragma unroll
        for (int b = 0; b < 2; ++b)
#pragma unroll
            for (int m = 0; m < 4; ++m)
#pragma unroll
                for (int n = 0; n < 2; ++n) acc[a][b][m][n] = (f32x4){0.f, 0.f, 0.f, 0.f};
    bf16x8 At[4][2], B0[2][2], B1[2][2];
#define PG8_KOFF(u) ((u).ks > 0 ? (size_t)(u).ks * g.KS * 2 : (size_t)0)
#define PG8_NT(u) ((u).ks < 0 ? K / BK : ((K - (u).ks * g.KS) < g.KS ? (K - (u).ks * g.KS) : g.KS) / BK)
#define PG8_APTR(u) ((const char*)g.A + (size_t)(g.amod ? (u).pm % g.amod : (u).pm) * tstepA + PG8_KOFF(u))
#define PG8_BPTR(u) ((const char*)g.Bt + (size_t)(u).pn * tstepB + (g.amod ? (size_t)((u).pm / g.amod) * g.bbatch : (size_t)0) + PG8_KOFF(u))
    const char* cA = PG8_APTR(cur); const char* cB = PG8_BPTR(cur); int nt = PG8_NT(cur);
    PG8_STAGE(PG8_SB(0, 0), cB, voffB); PG8_STAGE(PG8_SA(0, 0), cA, voffA); PG8_STAGE(PG8_SB(0, 1), cB + hstepB, voffB); PG8_STAGE(PG8_SA(0, 1), cA + hstepA, voffA);
    if (wr == 1) PG8_BAR;
    PG8_WAIT_V(4); PG8_BAR;
    PG8_STAGE(PG8_SB(1, 0), cB + kstep, voffB); PG8_STAGE(PG8_SA(1, 0), cA + kstep, voffA); PG8_STAGE(PG8_SB(1, 1), cB + hstepB + kstep, voffB);
    PG8_WAIT_V(6); PG8_BAR;
    for (;;) {
        const bool has_next = S.next(ui + 1, nxt);
        const char* nA = has_next ? PG8_APTR(nxt) : cA; const char* nB = has_next ? PG8_BPTR(nxt) : cB;
        for (int t = 0; t < nt; t += 2) {
            const bool last = (t == nt - 2);
            const char* a1 = cA + (size_t)(t + 1) * kstep;
            const char* a2 = last ? nA : cA + (size_t)(t + 2) * kstep; const char* b2 = last ? nB : cB + (size_t)(t + 2) * kstep;
            const char* a3 = a2 + kstep; const char* b3 = b2 + kstep;
            PG8_LDB(B0, 0, 0); PG8_SCHED; PG8_LDA(At, 0, 0); PG8_STAGE(PG8_SA(1, 1), a1 + hstepA, voffA);
            PG8_WAIT_L(8); PG8_BAR; PG8_WAIT_L(0); PG8_MMA(0, 0, At, B0); PG8_BAR; PG8_SCHED;
            PG8_LDB(B1, 0, 1); PG8_STAGE(PG8_SB(0, 0), b2, voffB);
            PG8_BAR; PG8_WAIT_L(0); PG8_MMA(0, 1, At, B1); PG8_BAR;
            PG8_LDA(At, 0, 1); PG8_STAGE(PG8_SA(0, 0), a2, voffA);
            PG8_BAR; PG8_WAIT_L(0); PG8_MMA(1, 0, At, B0); PG8_BAR; PG8_SCHED;
            PG8_STAGE(PG8_SB(0, 1), b2 + hstepB, voffB);
            PG8_WAIT_V(6); PG8_BAR; PG8_MMA(1, 1, At, B1); PG8_BAR;
            PG8_LDB(B0, 1, 0); PG8_SCHED; PG8_LDA(At, 1, 0); PG8_STAGE(PG8_SA(0, 1), a2 + hstepA, voffA);
            PG8_WAIT_L(8); PG8_BAR; PG8_WAIT_L(0); PG8_MMA(0, 0, At, B0); PG8_BAR; PG8_SCHED;
            PG8_LDB(B1, 1, 1); PG8_STAGE(PG8_SB(1, 0), b3, voffB);
            PG8_BAR; PG8_WAIT_L(0); PG8_MMA(0, 1, At, B1); PG8_BAR;
            PG8_LDA(At, 1, 1); PG8_STAGE(PG8_SA(1, 0), a3, voffA);
            PG8_BAR; PG8_WAIT_L(0); PG8_MMA(1, 0, At, B0); PG8_BAR; PG8_SCHED;
            PG8_STAGE(PG8_SB(1, 1), b3 + hstepB, voffB);
            PG8_WAIT_V(6); PG8_BAR; PG8_MMA(1, 1, At, B1); PG8_BAR;
        }
        E(acc, cur, wr, wc, fr, fq);
        if (!has_next) break;
#pragma unroll
        for (int a = 0; a < 2; ++a)
#pragma unroll
            for (int b = 0; b < 2; ++b)
#pragma unroll
                for (int m = 0; m < 4; ++m)
#pragma unroll
                    for (int n = 0; n < 2; ++n) acc[a][b][m][n] = (f32x4){0.f, 0.f, 0.f, 0.f};
        cur = nxt; cA = nA; cB = nB; ++ui; nt = PG8_NT(cur);
    }
    PG8_WAIT_V(0);
    if (wr == 0) PG8_BAR;
    PG8_BAR;
#undef PG8_SA
#undef PG8_SB
#undef PG8_STAGE
#undef PG8_LDA
#undef PG8_LDB
#undef PG8_MMA
#undef PG8_BAR
#undef PG8_SCHED
#undef PG8_APTR
#undef PG8_KOFF
#undef PG8_NT
#undef PG8_BPTR
}
#define WAIT_V0() asm volatile("s_waitcnt vmcnt(0)" ::: "memory")

#define EPI_LOOP_ROWS for (int ai = 0; ai < 2; ++ai) for (int m = 0; m < 4; ++m)
DEVINL void st_bf4(bf16_t* p, f32x4 v) { u32x2 w; w.x = pk2(v[0], v[1]); w.y = pk2(v[2], v[3]); *(u32x2*)p = w; }

DEVINL void st_bf8(bf16_t* p, f32x4 a, f32x4 b) { u32x4 w; w.x = pk2(a[0], a[1]); w.y = pk2(a[2], a[3]); w.z = pk2(b[0], b[1]); w.w = pk2(b[2], b[3]); *(u32x4*)p = w; }
struct EpiF32 { static constexpr bool PERM = false;
    float* C; int ldc; const float* bias; float* Cs;
    DEVINL void operator()(const Acc& acc, const Unit& u, int wr, int wc, int fr, int fq) const {
        const int row0 = u.pm * BM + wr * 64 + fr, col0 = u.pn * BM + wc * 32 + 4 * fq;
        float* base = u.ks < 0 ? C : Cs + ((long)u.ks * NCTX - NLAT) * 1024;
#pragma unroll
        for (int ai = 0; ai < 2; ++ai)
#pragma unroll
            for (int m = 0; m < 4; ++m) { float* rowp = base + (size_t)(row0 + ai * HALF + m * 16) * ldc + col0;
#pragma unroll
                for (int bj = 0; bj < 2; ++bj)
#pragma unroll
                    for (int n = 0; n < 2; ++n) { f32x4 v = acc[ai][bj][m][n];
                        if (bias) v += *(const f32x4*)(bias + col0 + bj * HALF + n * 16);
                        *(f32x4*)(rowp + bj * HALF + n * 16) = v; } }
    }
};
struct EpiY { static constexpr bool PERM = true;
    bf16_t* Yb; const float* bias; float* Cs;
    DEVINL void operator()(const Acc& acc, const Unit& u, int wr, int wc, int fr, int fq) const {
        const int row0 = u.pm * BM + wr * 64 + fr, col0 = u.pn * BM + wc * 32 + 8 * fq;
        const bool addb = bias != nullptr && u.ks <= 0;
        float* sbase = Cs + ((long)u.ks * NCTX - NLAT) * 1024;
#pragma unroll
        for (int ai = 0; ai < 2; ++ai)
#pragma unroll
            for (int m = 0; m < 4; ++m) { const size_t ro = (size_t)(row0 + ai * HALF + m * 16) * 1024 + col0;
#pragma unroll
                for (int bj = 0; bj < 2; ++bj) { f32x4 v0 = acc[ai][bj][m][0], v1 = acc[ai][bj][m][1];
                    if (addb) { v0 += *(const f32x4*)(bias + col0 + bj * HALF); v1 += *(const f32x4*)(bias + col0 + bj * HALF + 4); }
                    if (u.ks < 0) st_bf8(Yb + ro + bj * HALF, v0, v1); else { *(f32x4*)(sbase + ro + bj * HALF) = v0; *(f32x4*)(sbase + ro + bj * HALF + 4) = v1; } } }
    }
};
struct EpiBf16 { static constexpr bool PERM = false;
    bf16_t* O; int ldc;
    DEVINL void operator()(const Acc& acc, const Unit& u, int wr, int wc, int fr, int fq) const {
        const int row0 = u.pm * BM + wr * 64 + fr, col0 = u.pn * BM + wc * 32 + 4 * fq;
#pragma unroll
        for (int ai = 0; ai < 2; ++ai)
#pragma unroll
            for (int m = 0; m < 4; ++m) { bf16_t* rowp = O + (size_t)(row0 + ai * HALF + m * 16) * ldc + col0;
#pragma unroll
                for (int bj = 0; bj < 2; ++bj)
#pragma unroll
                    for (int n = 0; n < 2; ++n) st_bf4(rowp + bj * HALF + n * 16, acc[ai][bj][m][n]); }
    }
};
struct EpiSwiGLU { static constexpr bool PERM = true;
    bf16_t* G;
    DEVINL void operator()(const Acc& acc, const Unit& u, int wr, int wc, int fr, int fq) const {
        const int row0 = u.pm * BM + wr * 64 + fr, col0 = u.pn * HALF + wc * 32 + 8 * fq;
#pragma unroll
        for (int ai = 0; ai < 2; ++ai)
#pragma unroll
            for (int m = 0; m < 4; ++m) { bf16_t* rowp = G + (size_t)(row0 + ai * HALF + m * 16) * DFF + col0;
                f32x4 o[2];
#pragma unroll
                for (int n = 0; n < 2; ++n) { const f32x4 gt = acc[ai][0][m][n], up = acc[ai][1][m][n];
#pragma unroll
                    for (int j = 0; j < 4; ++j) o[n][j] = silu_f(gt[j]) * up[j]; }
                st_bf8(rowp, o[0], o[1]); }
    }
};
DEVINL void tok_of_row(int r, int& b, int& tk, bool& lat) { lat = r < NLAT; if (lat) { b = r >> 11; tk = r & 2047; } else { const int rc = r - NLAT; b = rc >> 8; tk = SEQ + (rc & 255); } }
struct EpiUQ { static constexpr bool PERM = false;
    bf16_t* Q; const float* cosT; const float* sinT;
    DEVINL void operator()(const Acc& acc, const Unit& u, int wr, int wc, int fr, int fq) const {
#pragma unroll
        for (int ai = 0; ai < 2; ++ai)
#pragma unroll
            for (int m = 0; m < 4; ++m) { const int r = u.pm * BM + ai * HALF + wr * 64 + m * 16 + fr; int b, tq; bool lat; tok_of_row(r, b, tq, lat);
#pragma unroll
                for (int bj = 0; bj < 2; ++bj) { const int col32 = u.pn * BM + bj * HALF + wc * 32, head = col32 / 192, off = col32 % 192;
                    f32x4 v0 = acc[ai][bj][m][0], v1 = acc[ai][bj][m][1];
                    if (off >= 128 && lat) { const int axis = (off - 128) >> 5, pos = axis == 0 ? (tq >> 6) : (tq & 63);
                        const f32x4 c = *(const f32x4*)(cosT + pos * 16 + fq * 4), s = *(const f32x4*)(sinT + pos * 16 + fq * 4);
                        const f32x4 o0 = v0 * c - v1 * s, o1 = v1 * c + v0 * s; v0 = o0; v1 = o1; }
                    bf16_t* dst = Q + ((size_t)(b * 8 + head) * TKV + tq) * 192 + off + fq * 4;
                    st_bf4(dst, v0); st_bf4(dst + 16, v1); } }
    }
};
struct EpiUKV { static constexpr bool PERM = false;
    bf16_t* Kb; bf16_t* Vb;
    DEVINL void operator()(const Acc& acc, const Unit& u, int wr, int wc, int fr, int fq) const {
#pragma unroll
        for (int ai = 0; ai < 2; ++ai)
#pragma unroll
            for (int m = 0; m < 4; ++m) { const int r = u.pm * BM + ai * HALF + wr * 64 + m * 16 + fr; int b, tk; bool lat; tok_of_row(r, b, tk, lat);
                const size_t tokidx = (size_t)(b * 8 + u.pn) * TKV + tk; const int c = wc * 32 + fq * 4;
                bf16_t* kd = Kb + tokidx * 192 + c; bf16_t* vd = Vb + tokidx * 128 + c;
#pragma unroll
                for (int n = 0; n < 2; ++n) { st_bf4(kd + n * 16, acc[ai][0][m][n]); st_bf4(vd + n * 16, acc[ai][1][m][n]); } }
    }
};
struct EpiDFT1 { static constexpr bool PERM = false;
    bf16_t* P; int shift, rpb, rowbase;
    DEVINL void operator()(const Acc& acc, const Unit& u, int wr, int wc, int fr, int fq) const {
        const int b = u.pm >> shift, tile = u.pm & ((1 << shift) - 1), cs = tile >> (shift - 1), t0 = (tile & ((1 << (shift - 1)) - 1)) * 256;
        const int row0 = rowbase + b * rpb + t0 + wr * 64 + fr, col0 = cs * 1024 + u.pn * BM + wc * 32 + 4 * fq;
#pragma unroll
        for (int ai = 0; ai < 2; ++ai)
#pragma unroll
            for (int m = 0; m < 4; ++m) { bf16_t* rowp = P + (size_t)(row0 + ai * HALF + m * 16) * 2048 + col0;
#pragma unroll
                for (int bj = 0; bj < 2; ++bj)
#pragma unroll
                    for (int n = 0; n < 2; ++n) st_bf4(rowp + bj * HALF + n * 16, acc[ai][bj][m][n]); }
    }
};
struct EpiRwkv1 { static constexpr bool PERM = false;
    bf16_t* R; bf16_t* A2;
    DEVINL void operator()(const Acc& acc, const Unit& u, int wr, int wc, int fr, int fq) const {
        const int row0 = u.pm * BM + wr * 64 + fr;
#pragma unroll
        for (int ai = 0; ai < 2; ++ai)
#pragma unroll
            for (int m = 0; m < 4; ++m) { const size_t r = (size_t)(row0 + ai * HALF + m * 16);
#pragma unroll
                for (int bj = 0; bj < 2; ++bj)
#pragma unroll
                    for (int n = 0; n < 2; ++n) { f32x4 v = acc[ai][bj][m][n]; const int c = bj * HALF + wc * 32 + n * 16 + fq * 4;
                        if (u.pn < 12) { st_bf4(R + (size_t)(u.pn >> 2) * NTOK * DM + r * DM + (u.pn & 3) * 256 + c, v); }
                        else if (u.pn == 12) { if (bj == 0) {
#pragma unroll
                                for (int j = 0; j < 4; ++j) { const float ee = __expf(-2.f * fabsf(v[j])); const float th = (1.f - ee) / (1.f + ee); v[j] = v[j] < 0.f ? -th : th; } }
                            st_bf4(A2 + r * 512 + c, v); }
                        else {
#pragma unroll
                            for (int j = 0; j < 4; ++j) v[j] = (c + j < 160) ? sigm_f(v[j]) : 0.f;
                            st_bf4(A2 + r * 512 + 256 + c, v); } } }
    }
};
template <int mode> struct EpiRwkv2 { static constexpr bool PERM = false;
    bf16_t* O; const float* bias;
    DEVINL void operator()(const Acc& acc, const Unit& u, int wr, int wc, int fr, int fq) const {
        const int row0 = u.pm * BM + wr * 64 + fr, e = u.pn >> 2, d0 = (u.pn & 3) * 256 + wc * 32 + 4 * fq;
#pragma unroll
        for (int ai = 0; ai < 2; ++ai)
#pragma unroll
            for (int m = 0; m < 4; ++m) { bf16_t* rowp = O + (size_t)e * NTOK * DM + (size_t)(row0 + ai * HALF + m * 16) * DM + d0;
#pragma unroll
                for (int bj = 0; bj < 2; ++bj)
#pragma unroll
                    for (int n = 0; n < 2; ++n) { const int d = d0 + bj * HALF + n * 16; f32x4 v = acc[ai][bj][m][n] + *(const f32x4*)(bias + e * DM + d);
                        st_bf4(rowp + bj * HALF + n * 16, v); } }
    }
};

DEVINL void convT(float* tile, const float* src, int ldsrc, int K, int N, bf16_t* dst, int ldd, int drow0, int dcol0, const float* rs, int rdiv, int rmul, int bid = -1, int nb = 0) {
    const int tid = otid(), tK = (K + 63) / 64, tN = (N + 63) / 64;
    if (bid < 0) { bid = obid(); nb = gridDim.x; }
    for (int t = bid; t < tK * tN; t += nb) {
        const int k0 = (t / tN) * 64, n0 = (t % tN) * 64;
        __syncthreads();
#pragma unroll
        for (int p = 0; p < 8; ++p) { const int i = (tid >> 6) + 8 * p, j = tid & 63; float v = 0.f;
            if (k0 + i < K && n0 + j < N) { v = src[(size_t)(k0 + i) * ldsrc + n0 + j]; if (rs) v *= rs[k0 + i]; }
            tile[i * 65 + j] = v; }
        __syncthreads();
#pragma unroll
        for (int p = 0; p < 4; ++p) { const int j = (tid >> 5) + 16 * p, i = (tid & 31) * 2, n = n0 + j;
            if (n < N && k0 + i < K) { const int row = (n / rdiv) * rmul + (n % rdiv) + drow0;
                *(unsigned*)(dst + (size_t)row * ldd + dcol0 + k0 + i) = pk2(tile[i * 65 + j], tile[(i + 1) * 65 + j]); } }
    }
}
DEVINL void zero2d(bf16_t* dst, int ld, int r0, int r1, int c0, int c1, int bid = -1, int nb = 0) {
    const int w = (c1 - c0) / 2, n = (r1 - r0) * w;
    if (bid < 0) { bid = obid(); nb = gridDim.x; }
    for (int i = bid * 512 + otid(); i < n; i += nb * 512) { const int r = r0 + i / w, c = c0 + (i % w) * 2; *(unsigned*)(dst + (size_t)r * ld + c) = 0u; }
}
DEVINL void conv_ffn_w(float* tile, const PV& p, int layer, int w, bf16_t* slot, int bid, int nb) {
    const size_t o = (size_t)(layer * 2 + w) * DM * DFF;
    bf16_t* gu = slot + w * (FFN_WGU + FFN_WD); bf16_t* wd = gu + FFN_WGU;
    convT(tile, p.in(8) + o, DFF, DM, DFF, gu, DM, 0, 0, nullptr, 128, 256, bid, nb);
    convT(tile, p.in(9) + o, DFF, DM, DFF, gu, DM, 128, 0, nullptr, 128, 256, bid, nb);
    convT(tile, p.in(10) + o, DM, DFF, DM, wd, DFF, 0, 0, nullptr, 1 << 30, 0, bid, nb);
}
DEVINL void conv_ffn(float* tile, const PV& p, int layer, bf16_t* slot) { conv_ffn_w(tile, p, layer, 0, slot, obid(), gridDim.x); conv_ffn_w(tile, p, layer, 1, slot, obid(), gridDim.x); }

DEVINL void phase_prep(const PV& p, unsigned char* sm) {
    const int tid = otid(), wid = tid >> 6, lane = tid & 63;
    unsigned char* ws = p.ws;
    float* tile = (float*)sm;
    bf16_t* WM = (bf16_t*)(ws + WS_WM);
    {
        float* sc = (float*)sm; float* part = sc + 9 * 1024;
        for (int i = tid; i < 9 * 1024; i += 512) { const float v = i < 8192 ? p.in(1)[i] : p.in(3)[i - 8192]; sc[i] = silu_f(v); }
        __syncthreads();
        float* MOD = (float*)(ws + WS_MOD);
        for (int it = obid(); it < 4 * 144; it += gridDim.x) {
            const int layer = it / 144, col = (it % 144) * 64 + lane;
            const float* W = p.in(4) + (size_t)layer * DM * MODW + col;
            float a[9];
#pragma unroll
            for (int r = 0; r < 9; ++r) a[r] = 0.f;
            const int kb = wid * 128;
#pragma unroll 16
            for (int k = 0; k < 128; ++k) { const float w = W[(size_t)(kb + k) * MODW];
#pragma unroll
                for (int r = 0; r < 9; ++r) a[r] += sc[r * 1024 + kb + k] * w; }
#pragma unroll
            for (int r = 0; r < 9; ++r) part[(wid * 9 + r) * 64 + lane] = a[r];
            __syncthreads();
            for (int o = tid; o < 9 * 64; o += 512) { const int r = o >> 6, l = o & 63; float s = 0.f;
#pragma unroll
                for (int w = 0; w < 8; ++w) s += part[(w * 9 + r) * 64 + l];
                const int c = (it % 144) * 64 + l;
                MOD[((size_t)layer * 9 + r) * MODW + c] = s + p.in(5)[(size_t)layer * MODW + c]; }
            __syncthreads();
        }
    }
    { float* ct = (float*)(ws + WS_ROPE); float* st = ct + 1024;
      for (int i = obid() * 512 + tid; i < 1024; i += gridDim.x * 512) { const int pos = i >> 4, pp = i & 15;
          const float inv = exp2f(-(float)pp * (13.287712379549449f / 16.f)); const float ang = (float)pos * inv; ct[i] = cosf(ang); st[i] = sinf(ang); } }
    conv_ffn(tile, p, 0, (bf16_t*)(ws + WS_WF));
    for (int j = 0; j < 1; ++j) {
        bf16_t* M = WM + (j ? WM_MLA1 : WM_MLA0);
        convT(tile, p.in(11) + (size_t)j * 1024 * 512, 512, 1024, 512, M + MLA_DQKV, 1024, 0, 0, nullptr, 1 << 30, 0);
        convT(tile, p.in(14) + (size_t)j * 1024 * 320, 320, 1024, 320, M + MLA_DQKV, 1024, 512, 0, nullptr, 1 << 30, 0);
        zero2d(M + MLA_DQKV, 1024, 832, 1024, 0, 1024);
        convT(tile, p.in(13) + (size_t)j * 512 * 1536, 1536, 512, 1536, M + MLA_UQ, 512, 0, 0, nullptr, 1 << 30, 0);
        convT(tile, p.in(16) + (size_t)j * 256 * 2048, 2048, 256, 2048, M + MLA_UKV, 256, 0, 0, nullptr, 1 << 30, 0);
        convT(tile, p.in(17) + (size_t)j * 1024 * 1024, 1024, 1024, 1024, M + MLA_WO, 1024, 0, 0, nullptr, 1 << 30, 0);
    }
    __syncthreads();
}

DEVINL void prep_late(const PV& p, unsigned char* sm, int bid, int nb) {
    const int tid = otid(), wid = tid >> 6, lane = tid & 63;
    unsigned char* ws = p.ws;
    float* tile = (float*)sm;
    bf16_t* WM = (bf16_t*)(ws + WS_WM);
    (void)wid; (void)lane;
    { bf16_t* DT = WM + WM_DT2;
      for (size_t i = (size_t)bid * 512 + tid; i < (size_t)4096 * 1024; i += (size_t)nb * 512) {
          const int row = (int)(i >> 10), t = (int)(i & 1023) * 2, cs = row >> 11, to = row & 2047;
          float v[2];
#pragma unroll
          for (int q = 0; q < 2; ++q) { const int mm = (to * (t + q)) & 2047; const float x = (float)mm * (1.f / 1024.f); v[q] = (cs ? sinpif(x) : cospif(x)) * 0.022097086912079608f; }
          *(unsigned*)(DT + (size_t)row * 2048 + t) = pk2(v[0], v[1]); }
      bf16_t* DC = WM + WM_DT2C;
      for (int i = bid * 512 + tid; i < 512 * 128; i += nb * 512) {
          const int row = i >> 7, t = (i & 127) * 2, cs = row >> 8, to = row & 255;
          float v[2];
#pragma unroll
          for (int q = 0; q < 2; ++q) { const int mm = (to * (t + q)) & 255; const float x = (float)mm * (1.f / 128.f); v[q] = (cs ? sinpif(x) : cospif(x)) * 0.0625f; }
          *(unsigned*)(DC + (size_t)row * 256 + t) = pk2(v[0], v[1]); } }
    {
        __syncthreads();
        float* ctab = (float*)sm; float* stab = ctab + 128; float* wt = ctab + 256;
        if (tid < 128) { const float x = (float)tid * (1.f / 64.f); ctab[tid] = cospif(x) * 0.08838834764831845f; stab[tid] = -sinpif(x) * 0.08838834764831845f; }
        bf16_t* W2 = WM + WM_W2T; const float* wo = p.in(18);
        for (int it = bid; it < 128; it += nb) {
            const int g = it >> 4, n0 = (it & 15) * 64;
            __syncthreads();
            for (int q = tid; q < 128 * 64; q += 512) wt[q] = wo[(size_t)(g * 128 + (q >> 6)) * DM + n0 + (q & 63)];
            __syncthreads();
            const int k = tid & 127, cs = (tid >> 7) & 1, ng = tid >> 8; const float* tab = cs ? stab : ctab;
            float acc[32];
#pragma unroll
            for (int q = 0; q < 32; ++q) acc[q] = 0.f;
            for (int j = 0; j < 128; ++j) { const float t = tab[(k * j) & 127]; const float* wr = wt + j * 64 + ng * 32;
#pragma unroll
                for (int q = 0; q < 32; q += 4) { const f32x4 w4 = *(const f32x4*)(wr + q); acc[q] += t * w4[0]; acc[q + 1] += t * w4[1]; acc[q + 2] += t * w4[2]; acc[q + 3] += t * w4[3]; } }
#pragma unroll
            for (int q = 0; q < 32; ++q) W2[(size_t)(n0 + ng * 32 + q) * 2048 + cs * 1024 + g * 128 + k] = f2bf(acc[q]);
        }
        __syncthreads();
    }
    for (int j = 1; j < 2; ++j) {
        bf16_t* M = WM + (j ? WM_MLA1 : WM_MLA0);
        convT(tile, p.in(11) + (size_t)j * 1024 * 512, 512, 1024, 512, M + MLA_DQKV, 1024, 0, 0, nullptr, 1 << 30, 0, bid, nb);
        convT(tile, p.in(14) + (size_t)j * 1024 * 320, 320, 1024, 320, M + MLA_DQKV, 1024, 512, 0, nullptr, 1 << 30, 0, bid, nb);
        zero2d(M + MLA_DQKV, 1024, 832, 1024, 0, 1024, bid, nb);
        convT(tile, p.in(13) + (size_t)j * 512 * 1536, 1536, 512, 1536, M + MLA_UQ, 512, 0, 0, nullptr, 1 << 30, 0, bid, nb);
        convT(tile, p.in(16) + (size_t)j * 256 * 2048, 2048, 256, 2048, M + MLA_UKV, 256, 0, 0, nullptr, 1 << 30, 0, bid, nb);
        convT(tile, p.in(17) + (size_t)j * 1024 * 1024, 1024, 1024, 1024, M + MLA_WO, 1024, 0, 0, nullptr, 1 << 30, 0, bid, nb);
    }
    {
        bf16_t* WC = WM + WM_WCAT; const float* mix = p.in(20);
        for (int h = 0; h < 2; ++h) { const int dc = h * 1024;
            convT(tile, p.in(21), 1024, 1024, 1024, WC, 2048, 0, dc, h ? mix + 0 * 1024 : nullptr, 1 << 30, 0, bid, nb);
            convT(tile, p.in(22), 1024, 1024, 1024, WC, 2048, 1024, dc, h ? mix + 2 * 1024 : nullptr, 1 << 30, 0, bid, nb);
            convT(tile, p.in(23), 1024, 1024, 1024, WC, 2048, 2048, dc, h ? mix + 3 * 1024 : nullptr, 1 << 30, 0, bid, nb);
            for (int e = 0; e < 2; ++e) {
                convT(tile, p.in(25) + (size_t)e * 1024 * 64, 64, 1024, 64, WC, 2048, 3072 + e * 64, dc, h ? mix + 1 * 1024 : nullptr, 1 << 30, 0, bid, nb);
                convT(tile, p.in(28) + (size_t)e * 1024 * 64, 64, 1024, 64, WC, 2048, 3200 + e * 64, dc, h ? mix + 4 * 1024 : nullptr, 1 << 30, 0, bid, nb); }
            convT(tile, p.in(30), 160, 1024, 160, WC, 2048, 3328, dc, h ? mix + 5 * 1024 : nullptr, 1 << 30, 0, bid, nb); }
        zero2d(WC, 2048, 3488, 3584, 0, 2048, bid, nb);
        bf16_t* BW = WM + WM_BW; bf16_t* BA = WM + WM_BA; bf16_t* BG = WM + WM_BG;
        for (int e = 0; e < 2; ++e) {
            convT(tile, p.in(26) + (size_t)e * 64 * 1024, 1024, 64, 1024, BW, 256, e * 1024, e * 64, nullptr, 1 << 30, 0, bid, nb);
            convT(tile, p.in(29) + (size_t)e * 64 * 1024, 1024, 64, 1024, BA, 256, e * 1024, 128 + e * 64, nullptr, 1 << 30, 0, bid, nb);
            zero2d(BW, 256, e * 1024, e * 1024 + 1024, (1 - e) * 64, (1 - e) * 64 + 64, bid, nb); zero2d(BW, 256, e * 1024, e * 1024 + 1024, 128, 256, bid, nb);
            zero2d(BA, 256, e * 1024, e * 1024 + 1024, 128 + (1 - e) * 64, 128 + (1 - e) * 64 + 64, bid, nb); zero2d(BA, 256, e * 1024, e * 1024 + 1024, 0, 128, bid, nb); }
        convT(tile, p.in(31), 1024, 160, 1024, BG, 256, 0, 0, nullptr, 1 << 30, 0, bid, nb);
        zero2d(BG, 256, 0, 1024, 160, 256, bid, nb);
        convT(tile, p.in(37), 1024, 1024, 1024, WM + WM_RWO, 1024, 0, 0, nullptr, 1 << 30, 0, bid, nb);
    }
    __syncthreads();
}

struct RowArgs {
    const float* hin_l; const float* hin_c; float* hout_l; float* hout_c;
    const float* Y; const float* modp; int subp; const float* gpost; float coef;
    const float* modn; int subn; const float* gpre;
    bf16_t* xn; int xn_ld; int nrows; int upd_ctx; const float* Ys; int nslab;
    int pad_;
};
struct RowIn { f32x4 h[4], y[4]; };
DEVINL void row_load(const RowArgs& a, int r, int lane, RowIn& v) {
    const bool lat = r < NLAT; const int rc = r - NLAT;
    const float* hin = lat ? a.hin_l + (size_t)r * DM : a.hin_c + (size_t)rc * DM;
#pragma unroll
    for (int i = 0; i < 4; ++i) v.h[i] = *(const f32x4*)(hin + i * 256 + lane * 4);
    if (a.Y != nullptr && (lat || a.upd_ctx)) {
        if (lat || a.nslab == 0) {
#pragma unroll
            for (int i = 0; i < 4; ++i) { const u32x2 w = *(const u32x2*)((const bf16_t*)a.Y + (size_t)r * DM + i * 256 + lane * 4); v.y[i] = (f32x4){lo_bf(w.x), hi_bf(w.x), lo_bf(w.y), hi_bf(w.y)}; }
        } else {
#pragma unroll
            for (int i = 0; i < 4; ++i) v.y[i] = *(const f32x4*)(a.Ys + (size_t)rc * DM + i * 256 + lane * 4);
            for (int sl = 1; sl < a.nslab; ++sl) {
#pragma unroll
                for (int i = 0; i < 4; ++i) v.y[i] += *(const f32x4*)(a.Ys + ((size_t)sl * NCTX + rc) * DM + i * 256 + lane * 4); }
        }
    }
}
DEVINL void row_math(const RowArgs& a, int r, int lane, RowIn& v, f32x4 (&xo)[4]) {
    const bool lat = r < NLAT; const int rc = r - NLAT; const int mrow = lat ? (r >> 11) : 8;
    const float* hin = lat ? a.hin_l + (size_t)r * DM : a.hin_c + (size_t)rc * DM;
    float* hout = lat ? a.hout_l + (size_t)r * DM : a.hout_c + (size_t)rc * DM;
    const bool upd = a.Y != nullptr && (lat || a.upd_ctx);
    if (upd) {
        float ss = 0.f;
#pragma unroll
        for (int i = 0; i < 4; ++i)
#pragma unroll
            for (int j = 0; j < 4; ++j) ss += v.y[i][j] * v.y[i][j];
        ss = wave_sum_dpp(ss); const float rs = rsqrtf(ss * (1.f / 1024.f) + EPS) * a.coef;
        const float* gate = a.modp + (size_t)mrow * MODW + (a.subp * 3 + 2) * 1024;
#pragma unroll
        for (int i = 0; i < 4; ++i) { const int c = i * 256 + lane * 4; const f32x4 gt = *(const f32x4*)(gate + c), gp = *(const f32x4*)(a.gpost + c);
            v.h[i] += gt * (v.y[i] * gp) * rs; }
    }
    if (upd || hin != hout) {
#pragma unroll
        for (int i = 0; i < 4; ++i) *(f32x4*)(hout + i * 256 + lane * 4) = v.h[i];
    }
    if (a.modn) {
        float ss = 0.f;
#pragma unroll
        for (int i = 0; i < 4; ++i)
#pragma unroll
            for (int j = 0; j < 4; ++j) ss += v.h[i][j] * v.h[i][j];
        ss = wave_sum_dpp(ss); const float rs = rsqrtf(ss * (1.f / 1024.f) + EPS);
        const float* sh = a.modn + (size_t)mrow * MODW + (a.subn * 3 + 0) * 1024; const float* scl = sh + 1024;
#pragma unroll
        for (int i = 0; i < 4; ++i) { const int c = i * 256 + lane * 4; const f32x4 g = *(const f32x4*)(a.gpre + c), s1 = *(const f32x4*)(scl + c), s0 = *(const f32x4*)(sh + c);
            xo[i] = (v.h[i] * rs * g) * (s1 + 1.f) + s0; }
    }
}
DEVINL void row_core(const RowArgs& a, int r, int lane, f32x4 (&xo)[4]) { RowIn v; row_load(a, r, lane, v); row_math(a, r, lane, v, xo); }
DEVINL void phase_rows(const RowArgs& a) {
    const int lane = otid() & 63, gw = obid() * 8 + (otid() >> 6), nw = gridDim.x * 8;
    RowIn cur, n1, n2;
    if (gw < a.nrows) row_load(a, gw, lane, cur);
    if (gw + nw < a.nrows) row_load(a, gw + nw, lane, n1);
    for (int r = gw; r < a.nrows; r += nw) {
        if (r + 2 * nw < a.nrows) row_load(a, r + 2 * nw, lane, n2);
        f32x4 xo[4]; row_math(a, r, lane, cur, xo);
        if (a.modn) {
#pragma unroll
            for (int i = 0; i < 4; ++i) st_bf4(a.xn + (size_t)r * a.xn_ld + i * 256 + lane * 4, xo[i]);
        }
        cur = n1; n1 = n2;
    }
}
DEVINL void phase_rows_T(const RowArgs& a, unsigned char* sm, bf16_t* XT, bf16_t* XTc) {
    const int tid = otid(), wid = tid >> 6, lane = tid & 63;
    constexpr int RS = 2052;
    for (int tl = obid(); tl < NTOK / 64; tl += gridDim.x) {
        __syncthreads();
        RowIn cur, nxt; row_load(a, tl * 64 + wid * 8, lane, cur);
        for (int q = 0; q < 8; ++q) { const int lr = wid * 8 + q, r = tl * 64 + lr; f32x4 xo[4];
            if (q < 7) row_load(a, r + 1, lane, nxt);
            row_math(a, r, lane, cur, xo); cur = nxt;
#pragma unroll
            for (int i = 0; i < 4; ++i) { u32x2 w; w.x = pk2(xo[i][0], xo[i][1]); w.y = pk2(xo[i][2], xo[i][3]);
                unsigned* dp = (unsigned*)(sm + lr * RS + (i * 256 + lane * 4) * 2); dp[0] = w.x; dp[1] = w.y; } }
        __syncthreads();
        const int r0 = tl * 64; const bool lat = r0 < NLAT; const int b = lat ? (r0 >> 11) : ((r0 - NLAT) >> 8), t0 = lat ? (r0 & 2047) : ((r0 - NLAT) & 255), T = lat ? 2048 : 256;
        bf16_t* dstb = (lat ? XT : XTc) + (size_t)b * 1024 * T + t0;
        for (int it = tid; it < 1024 * 8; it += 512) { const int d = it >> 3, tc = it & 7; unsigned w[4];
#pragma unroll
            for (int q = 0; q < 4; ++q) { const unsigned lo = *(const bf16_t*)(sm + (tc * 8 + q * 2) * RS + d * 2), hi = *(const bf16_t*)(sm + (tc * 8 + q * 2 + 1) * RS + d * 2); w[q] = lo | (hi << 16); }
            *(u32x4*)(dstb + (size_t)d * T + tc * 8) = (u32x4){w[0], w[1], w[2], w[3]}; }
    }
    __syncthreads();
}

DEVINL void phase_mla_norm(const PV& p, int j, const float* raw, bf16_t* QN, bf16_t* CKVN, bf16_t* Kb) {
    const int lane = otid() & 63, gw = obid() * 8 + (otid() >> 6), nw = gridDim.x * 8;
    const float* qg = p.in(12) + j * 512; const float* kg = p.in(15) + j * 256;
    const float* ct = (const float*)(p.ws + WS_ROPE); const float* st = ct + 1024;
    for (int r = gw; r < NTOK; r += nw) {
        const float* row = raw + (size_t)r * 1024;
        f32x4 q0 = *(const f32x4*)(row + lane * 4), q1 = *(const f32x4*)(row + 256 + lane * 4), kv = *(const f32x4*)(row + 512 + lane * 4);
        const float kp = row[768 + lane];
        float sq = 0.f, sk = 0.f;
#pragma unroll
        for (int i = 0; i < 4; ++i) { sq += q0[i] * q0[i] + q1[i] * q1[i]; sk += kv[i] * kv[i]; }
        sq = wave_sum_dpp(sq); sk = wave_sum_dpp(sk);
        const float rq = rsqrtf(sq * (1.f / 512.f) + EPS), rk = rsqrtf(sk * (1.f / 256.f) + EPS);
        st_bf4(QN + (size_t)r * 512 + lane * 4, q0 * rq * *(const f32x4*)(qg + lane * 4));
        st_bf4(QN + (size_t)r * 512 + 256 + lane * 4, q1 * rq * *(const f32x4*)(qg + 256 + lane * 4));
        st_bf4(CKVN + (size_t)r * 256 + lane * 4, kv * rk * *(const f32x4*)(kg + lane * 4));
        int b, tk; bool lat; tok_of_row(r, b, tk, lat);
        const float other = __shfl_xor(kp, 16); float o = kp;
        if (lat) { const int axis = lane >> 5, half = (lane >> 4) & 1, pp = lane & 15, pos = axis == 0 ? (tk >> 6) : (tk & 63);
            const float c = ct[pos * 16 + pp], s = st[pos * 16 + pp];
            o = half == 0 ? kp * c - other * s : kp * c + other * s; }
        const bf16_t ob = f2bf(o);
#pragma unroll
        for (int h = 0; h < 8; ++h) Kb[((size_t)(b * 8 + h) * TKV + tk) * 192 + 128 + lane] = ob;
    }
}

constexpr int QBLK = 32, KVBLK = 64, NW = 8;
constexpr float ATT_SCALE = 0.07216878364870322f;
constexpr float ATT_THR = 8.f;
constexpr size_t SHM_V = KVBLK * 128 * 2, SHM_K = KVBLK * 192 * 2;
#define KSWZ(row, colB) ((row) * 384 + ((colB) ^ ((((row) >> 1) & 7) << 4)))
#define SBAR() __builtin_amdgcn_sched_barrier(0)
DEVINL int crow(int r, int hi) { return (r & 3) + 8 * (r >> 2) + 4 * hi; }
DEVINL void partialSM(f32x16& p0, f32x16& p1, float& m_reg, float& mn, float& alpha) {
    constexpr float C = ATT_SCALE * 1.4426950408889634f;
    float pmax = p0[0];
#pragma unroll
    for (int r = 1; r < 16; ++r) pmax = fmaxf(pmax, p0[r]);
#pragma unroll
    for (int r = 0; r < 16; ++r) pmax = fmaxf(pmax, p1[r]);
    { auto rr = __builtin_amdgcn_permlane32_swap(__float_as_uint(pmax), __float_as_uint(pmax), false, false);
      pmax = fmaxf(__uint_as_float(rr[0]), __uint_as_float(rr[1])); }
    if (__builtin_expect(__all(pmax - m_reg <= ATT_THR / ATT_SCALE), 1)) { mn = m_reg; alpha = 1.f; }
    else { mn = fmaxf(m_reg, pmax); alpha = __builtin_amdgcn_exp2f((m_reg - mn) * C); m_reg = mn; }
    const float mnC = -mn * C;
#pragma unroll
    for (int r = 0; r < 16; ++r) p0[r] = fmaf(p0[r], C, mnC);
#pragma unroll
    for (int r = 0; r < 16; ++r) p1[r] = fmaf(p1[r], C, mnC);
#pragma unroll
    for (int r = 0; r < 16; ++r) p0[r] = __builtin_amdgcn_exp2f(p0[r]);
}
DEVINL void finishSM(f32x16& p0, f32x16& p1, float alpha, float& l_reg, bf16x8& pa0, bf16x8& pa1, bf16x8& pa2, bf16x8& pa3) {
#pragma unroll
    for (int r = 0; r < 16; ++r) p1[r] = __builtin_amdgcn_exp2f(p1[r]);
    float ps = 0;
#pragma unroll
    for (int r = 0; r < 16; ++r) ps += p0[r];
#pragma unroll
    for (int r = 0; r < 16; ++r) ps += p1[r];
    { auto rr = __builtin_amdgcn_permlane32_swap(__float_as_uint(ps), __float_as_uint(ps), false, false);
      ps = __uint_as_float(rr[0]) + __uint_as_float(rr[1]); }
    l_reg = l_reg * alpha + ps;
#define PK4(P, BASE, OUT) do { unsigned a0 = pk2(P[BASE + 0], P[BASE + 1]), a1 = pk2(P[BASE + 2], P[BASE + 3]);   \
    unsigned b0 = pk2(P[BASE + 4], P[BASE + 5]), b1 = pk2(P[BASE + 6], P[BASE + 7]);                              \
    auto r0 = __builtin_amdgcn_permlane32_swap(a0, b0, false, false); auto r1 = __builtin_amdgcn_permlane32_swap(a1, b1, false, false); \
    u32x4 w = {r0[0], r1[0], r0[1], r1[1]}; OUT = *reinterpret_cast<bf16x8*>(&w); } while (0)
    PK4(p0, 0, pa0); PK4(p0, 8, pa1); PK4(p1, 0, pa2); PK4(p1, 8, pa3);
#undef PK4
}
DEVINL void qkt(f32x16& p0, f32x16& p1, const char* Ks, const bf16x8* qr, const char* qpe, int qsw, int r32, int hi) {
    p0 = f32x16{}; p1 = f32x16{};
#pragma unroll
    for (int d0 = 0; d0 < 12; ++d0) { const int cb = (d0 * 16 + hi * 8) * 2;
        const bf16x8 b0 = *reinterpret_cast<const bf16x8*>(Ks + KSWZ(r32, cb));
        const bf16x8 b1 = *reinterpret_cast<const bf16x8*>(Ks + KSWZ(32 + r32, cb));
        const bf16x8 q = d0 < 8 ? qr[d0 < 8 ? d0 : 0] : *reinterpret_cast<const bf16x8*>(qpe + (((((d0 - 8) * 2 + hi) ^ qsw) & 7) << 4));
        p0 = __builtin_amdgcn_mfma_f32_32x32x16_bf16(b0, q, p0, 0, 0, 0);
        p1 = __builtin_amdgcn_mfma_f32_32x32x16_bf16(b1, q, p1, 0, 0, 0); }
}
DEVINL int v_st(int k, int c) { const int kk = (k & ~0xC) | ((k & 4) << 1) | ((k & 8) >> 1); return ((kk >> 3) * 4 + (c >> 5)) * 512 + ((kk & 7) * 32 + (c & 31)) * 2; }
DEVINL int v_rd_base(int lane) { return ((lane & 3) << 3) | (((lane >> 2) & 3) << 6) | (((lane >> 4) & 1) << 5) | (((lane >> 5) & 1) << 8); }
constexpr int v_rd_off(int d0, int ks, int half) { return d0 * 512 + ks * 4096 + half * 2048; }
template <int OFF> DEVINL s16x4 tr_read(int vb) { s16x4 r; asm volatile("ds_read_b64_tr_b16 %0, %1 offset:%2" : "=&v"(r) : "v"(vb), "i"(OFF) : "memory"); return r; }
template <int D0> DEVINL void pv_one(f32x16& od, int vb, bf16x8 pa0, bf16x8 pa1, bf16x8 pa2, bf16x8 pa3) {
    const s16x4 l0 = tr_read<v_rd_off(D0, 0, 0)>(vb), h0 = tr_read<v_rd_off(D0, 0, 1)>(vb), l1 = tr_read<v_rd_off(D0, 1, 0)>(vb), h1 = tr_read<v_rd_off(D0, 1, 1)>(vb);
    const s16x4 l2 = tr_read<v_rd_off(D0, 2, 0)>(vb), h2 = tr_read<v_rd_off(D0, 2, 1)>(vb), l3 = tr_read<v_rd_off(D0, 3, 0)>(vb), h3 = tr_read<v_rd_off(D0, 3, 1)>(vb);
    asm volatile("s_waitcnt lgkmcnt(0)" ::: "memory"); SBAR();
#define PK(L, H) (bf16x8){L[0], L[1], L[2], L[3], H[0], H[1], H[2], H[3]}
    od = __builtin_amdgcn_mfma_f32_32x32x16_bf16(pa0, PK(l0, h0), od, 0, 0, 0);
    od = __builtin_amdgcn_mfma_f32_32x32x16_bf16(pa1, PK(l1, h1), od, 0, 0, 0);
    od = __builtin_amdgcn_mfma_f32_32x32x16_bf16(pa2, PK(l2, h2), od, 0, 0, 0);
    od = __builtin_amdgcn_mfma_f32_32x32x16_bf16(pa3, PK(l3, h3), od, 0, 0, 0);
#undef PK
}
DEVINL void pv_d0(f32x16* o, int vb, bf16x8 pa0, bf16x8 pa1, bf16x8 pa2, bf16x8 pa3) {
    pv_one<0>(o[0], vb, pa0, pa1, pa2, pa3); pv_one<1>(o[1], vb, pa0, pa1, pa2, pa3); pv_one<2>(o[2], vb, pa0, pa1, pa2, pa3); pv_one<3>(o[3], vb, pa0, pa1, pa2, pa3);
}
DEVINL void attn_body(const bf16_t* __restrict__ Qb, const bf16_t* __restrict__ Kh, const bf16_t* __restrict__ Vh, bf16_t* __restrict__ Ob, int seq, char* lds) {
    const int tid = otid(), wid = tid >> 6, lane = tid & 63, r32 = lane & 31, hi = lane >> 5;
    char* V_lds = lds; char* K_lds = lds + 2 * SHM_V;
    float* wsm = (float*)(lds + 2 * SHM_V + 2 * SHM_K) + wid * 64; float* li_l = wsm; float* al_l = wsm + 32;
    float m_reg = -1e30f, l_reg = 0; f32x16 o[4] = {}; bf16x8 qr[8];
    const bf16_t* Qw = Qb + (long)(wid * QBLK + r32) * 192 + hi * 8;
    char* qpe = lds + 2 * SHM_V + 2 * SHM_K + 2048 + wid * 4096 + r32 * 128; const int qsw = (r32 >> 1) & 7;
#pragma unroll
    for (int d0 = 0; d0 < 8; ++d0) qr[d0] = *reinterpret_cast<const bf16x8*>(Qw + d0 * 16);
#pragma unroll
    for (int d0 = 8; d0 < 12; ++d0) *reinterpret_cast<bf16x8*>(qpe + (((((d0 - 8) * 2 + hi) ^ qsw) & 7) << 4)) = *reinterpret_cast<const bf16x8*>(Qw + d0 * 16);
    const int sr = tid >> 4, sc = (tid & 15) * 8, vst0 = v_st(sr, sc), vst1 = v_st(32 + sr, sc);
    int kst[3];
#pragma unroll
    for (int i = 0; i < 3; ++i) { const int id = tid + 512 * i, row = id / 24, ch = id % 24; kst[i] = KSWZ(row, ch * 16); }
    const int vb0 = (int)(uintptr_t)V_lds + v_rd_base(lane);
    bf16x8 vs0, vs1, ks0, ks1, ks2;
#define SLOAD(k0) do { vs0 = *reinterpret_cast<const bf16x8*>(&Vh[(long)((k0) + sr) * 128 + sc]); vs1 = *reinterpret_cast<const bf16x8*>(&Vh[(long)((k0) + 32 + sr) * 128 + sc]); \
    const bf16_t* kp_ = Kh + (long)(k0) * 192 + tid * 8; ks0 = *reinterpret_cast<const bf16x8*>(kp_); ks1 = *reinterpret_cast<const bf16x8*>(kp_ + 4096); ks2 = *reinterpret_cast<const bf16x8*>(kp_ + 8192); } while (0)
#define SWRITE(b) do { *(bf16x8*)(V_lds + (b) * SHM_V + vst0) = vs0; *(bf16x8*)(V_lds + (b) * SHM_V + vst1) = vs1; \
    *(bf16x8*)(K_lds + (b) * SHM_K + kst[0]) = ks0; *(bf16x8*)(K_lds + (b) * SHM_K + kst[1]) = ks1; *(bf16x8*)(K_lds + (b) * SHM_K + kst[2]) = ks2; } while (0)
#define RESC(a) do { if (__any((a) < 1.f)) { if (hi == 0) al_l[r32] = (a); asm volatile("s_waitcnt lgkmcnt(0)" ::: "memory"); \
    _Pragma("unroll") for (int d = 0; d < 4; ++d) _Pragma("unroll") for (int r = 0; r < 16; ++r) o[d][r] *= al_l[crow(r, hi)]; } } while (0)
    f32x16 pA0, pA1, pB0, pB1; float mnA, mnB, alA, alB; bf16x8 pa0, pa1, pa2, pa3; const int NT = seq / KVBLK;
    __syncthreads();
    SLOAD(0); WAIT_V0(); SWRITE(0); __syncthreads();
    qkt(pA0, pA1, K_lds, qr, qpe, qsw, r32, hi); partialSM(pA0, pA1, m_reg, mnA, alA);
    SLOAD(KVBLK);
    WAIT_V0(); SWRITE(1); __syncthreads();
    for (int j = 1; j + 1 < NT; j += 2) {
        SBAR(); qkt(pB0, pB1, K_lds + SHM_K, qr, qpe, qsw, r32, hi);
        finishSM(pA0, pA1, alA, l_reg, pa0, pa1, pa2, pa3); SBAR();
        SLOAD((j + 1) * KVBLK); SBAR();
        pv_d0(o, vb0, pa0, pa1, pa2, pa3); partialSM(pB0, pB1, m_reg, mnB, alB);
        __syncthreads(); WAIT_V0(); SWRITE(0);
        RESC(alB); __syncthreads();
        SBAR(); qkt(pA0, pA1, K_lds, qr, qpe, qsw, r32, hi);
        finishSM(pB0, pB1, alB, l_reg, pa0, pa1, pa2, pa3); SBAR();
        SLOAD((j + 2) * KVBLK); SBAR();
        pv_d0(o, vb0 + (int)SHM_V, pa0, pa1, pa2, pa3); partialSM(pA0, pA1, m_reg, mnA, alA);
        __syncthreads(); WAIT_V0(); SWRITE(1);
        RESC(alA); __syncthreads();
    }
    SBAR(); qkt(pB0, pB1, K_lds + SHM_K, qr, qpe, qsw, r32, hi);
    finishSM(pA0, pA1, alA, l_reg, pa0, pa1, pa2, pa3); SBAR();
    pv_d0(o, vb0, pa0, pa1, pa2, pa3); partialSM(pB0, pB1, m_reg, mnB, alB);
    __syncthreads(); RESC(alB);
    finishSM(pB0, pB1, alB, l_reg, pa0, pa1, pa2, pa3); SBAR();
    pv_d0(o, vb0 + (int)SHM_V, pa0, pa1, pa2, pa3);
    if (hi == 0) li_l[r32] = l_reg; asm volatile("s_waitcnt lgkmcnt(0)" ::: "memory");
    float rli[16];
#pragma unroll
    for (int r = 0; r < 16; ++r) rli[r] = __builtin_amdgcn_rcpf(li_l[crow(r, hi)]);
    bf16_t* Ow = Ob + (long)(wid * QBLK) * 1024;
#pragma unroll
    for (int r = 0; r < 16; ++r) { const int orow = crow(r, hi);
#pragma unroll
        for (int d0 = 0; d0 < 4; ++d0) Ow[(long)orow * 1024 + d0 * 32 + r32] = f2bf(o[d0][r] * rli[r]); }
#undef SLOAD
#undef SWRITE
#undef RESC
}
DEVINL void phase_attn(const bf16_t* Q, const bf16_t* K, const bf16_t* V, bf16_t* O, bool with_ctx, char* lds) {
    const int nu = 512 + (with_ctx ? 64 : 0);
    for (int u = obid(); u < nu; u += gridDim.x) {
        if (u < 512) {
            int bh = u >> 3, qb = u & 7;
            if (gridDim.x == 256) { const int x = u & 7, l = (u >> 8) * 32 + ((u & 255) >> 3); bh = x * 8 + (l >> 3); qb = l & 7; }
            const int b = bh >> 3, h = bh & 7;
            attn_body(Q + ((size_t)bh * TKV + qb * 256) * 192, K + (size_t)bh * TKV * 192, V + (size_t)bh * TKV * 128, O + ((size_t)(b * SEQ + qb * 256)) * 1024 + h * 128, TKV, lds); }
        else { const int bh = u - 512, b = bh >> 3, h = bh & 7;
            attn_body(Q + ((size_t)bh * TKV + SEQ) * 192, K + ((size_t)bh * TKV + SEQ) * 192, V + ((size_t)bh * TKV + SEQ) * 128, O + ((size_t)(NLAT + b * CTX)) * 1024 + h * 128, CTX, lds); }
    }
    __syncthreads();
}

DEVINL void phase_rwkv_shift(bf16_t* XN) {
    for (size_t it = (size_t)obid() * 512 + otid(); it < (size_t)NTOK * 128; it += (size_t)gridDim.x * 512) {
        const int r = (int)(it >> 7), c = (int)(it & 127) * 8; int b, tk; bool lat; tok_of_row(r, b, tk, lat);
        const int t = lat ? tk : tk - SEQ, T = lat ? SEQ : CTX;
        const bf16_t* up = XN + (size_t)r * 2048 + c;
        const u32x4 u0 = *(const u32x4*)up; u32x4 um = {0, 0, 0, 0}, upl = {0, 0, 0, 0};
        if (t > 0) um = *(const u32x4*)(up - 2048);
        if (t < T - 1) upl = *(const u32x4*)(up + 2048);
        u32x4 o;
#pragma unroll
        for (int q = 0; q < 4; ++q) { const float a = 0.5f * (lo_bf(um[q]) + lo_bf(upl[q])) - lo_bf(u0[q]), bq = 0.5f * (hi_bf(um[q]) + hi_bf(upl[q])) - hi_bf(u0[q]); o[q] = pk2(a, bq); }
        *(u32x4*)(XN + (size_t)r * 2048 + 1024 + c) = o;
    }
}
DEVINL void zero_f32(float* p, size_t n4) { for (size_t i = (size_t)obid() * 512 + otid(); i < n4; i += (size_t)gridDim.x * 512) ((f32x4*)p)[i] = (f32x4){0.f, 0.f, 0.f, 0.f}; }

DEVINL float red8(float v) {
    v += __builtin_bit_cast(float, __builtin_amdgcn_update_dpp(0, __builtin_bit_cast(int, v), 0xB1, 0xF, 0xF, false));
    v += __builtin_bit_cast(float, __builtin_amdgcn_update_dpp(0, __builtin_bit_cast(int, v), 0x4E, 0xF, 0xF, false));
    v += __builtin_bit_cast(float, __builtin_amdgcn_update_dpp(0, __builtin_bit_cast(int, v), 0x141, 0xF, 0xF, false));
    return v;
}
typedef float f32x2 __attribute__((ext_vector_type(2)));
struct StepOps { f32x4 a0, a1, q0, q1, w0, w1, b0, b1, k0, k1; float viA, viB; f32x2 sc2; };
DEVINL void phase_scan(const PV& p, const bf16_t* R, const bf16_t* Kf, const bf16_t* Vf, const bf16_t* AA, const bf16_t* LW, float* Y0, bf16_t* Y1, unsigned char* sm) {
    constexpr int TC = 32, NCH = (CTX + SEQ) / TC;
    const int tid = otid(), wid = __builtin_amdgcn_readfirstlane(tid >> 6), lane = tid & 63;
    float* Fb = (float*)sm;
    float* ybb = Fb + 2 * TC * 384;
    float* sclb = ybb + 2 * TC * 64;
    const float* kkp = p.in(32); const float* kap = p.in(33);
    for (int it = obid(); it < 256; it += gridDim.x) {
        const int e = it >> 7, b = (it >> 4) & 7, h = it & 15, ch = h * 64 + lane;
        __syncthreads();
        if (wid >= 4) {
            const int hw = wid - 4;
            const float k_k = kkp[ch], k_a = kap[ch];
            const bf16_t* Ae = AA + (size_t)e * NTOK * DM; const bf16_t* Le = LW + (size_t)e * NTOK * DM;
            bf16_t pr[8], pk[8], pv[8], pa[8], pl[8];
#define SC_ROW(c_, s_) ({ const int g_ = (c_) * TC + (s_); const bool cx_ = g_ < CTX; const int sl_ = cx_ ? g_ : g_ - CTX, T_ = cx_ ? CTX : SEQ; \
            (cx_ ? NLAT + b * CTX : b * SEQ) + (e == 0 ? sl_ : T_ - 1 - sl_); })
#define SC_LOAD(c_) do { _Pragma("unroll") for (int q = 0; q < 8; ++q) { const size_t o_ = (size_t)SC_ROW(c_, hw + 4 * q) * DM + ch; \
            pr[q] = R[o_]; pk[q] = Kf[o_]; pv[q] = Vf[o_]; pa[q] = Ae[o_]; pl[q] = Le[o_]; } } while (0)
#define SC_DERIVE(c_) do { float* F_ = Fb + ((c_) & 1) * TC * 384; float* scl_ = sclb + ((c_) & 1) * TC * 2; _Pragma("unroll") for (int q = 0; q < 8; ++q) { const int s = hw + 4 * q; \
            const float r = bf2f(pr[q]), k = bf2f(pk[q]), v = bf2f(pv[q]), a = sigm_f(bf2f(pa[q])), nx = -bf2f(pl[q]); \
            const float sp = fmaxf(nx, 0.f) + __logf(1.f + __expf(-fabsf(nx))), w = __expf(-__expf(-sp - 0.5f)); \
            const float kv = k * k_k; const float n2 = wave_sum_dpp(kv * kv); const float kk = kv * __builtin_amdgcn_rsqf(fmaxf(n2, 1e-24f)); \
            const float bb = kk * a, kd = k * (1.f + (a - 1.f) * k_a); \
            const float br = wave_sum_dpp(bb * r), kr = wave_sum_dpp(kd * r); \
            float* f = F_ + s * 384 + lane; \
            f[0] = -kk; f[64] = bb; f[128] = w; f[192] = kd; f[256] = w * r; f[320] = v; \
            if (lane == 0) { scl_[s * 2] = br; scl_[s * 2 + 1] = kr; } } } while (0)
#define SC_FLUSH(c_) do { const float* yb_ = ybb + ((c_) & 1) * TC * 64; _Pragma("unroll") for (int q = 0; q < 8; ++q) { const int s = hw + 4 * q; const size_t o_ = (size_t)SC_ROW(c_, s) * DM + ch; \
            const float yv = yb_[s * 64 + lane]; if (e == 0) Y0[o_] = yv; else Y1[o_] = f2bf(yv); } } while (0)
            SC_LOAD(0); SC_DERIVE(0); SC_LOAD(1);
            __syncthreads();
            for (int c = 0; c < NCH; ++c) {
                if (c + 1 < NCH) { SC_DERIVE(c + 1); if (c + 2 < NCH) SC_LOAD(c + 2); }
                if (c >= 1) SC_FLUSH(c - 1);
                __syncthreads();
            }
            SC_FLUSH(NCH - 1);
#undef SC_LOAD
#undef SC_DERIVE
#undef SC_FLUSH
#undef SC_ROW
        } else {
            f32x2 SA[4], SB[4];
#pragma unroll
            for (int j = 0; j < 4; ++j) { SA[j] = (f32x2){0.f, 0.f}; SB[j] = (f32x2){0.f, 0.f}; }
            const int iA = wid * 16 + (lane >> 3), iB = iA + 8, cg8 = (lane & 7) * 8;
            __syncthreads();
            for (int c = 0; c < NCH; ++c) {
                const float* F = Fb + (c & 1) * TC * 384; float* yb = ybb + (c & 1) * TC * 64; const float* scl = sclb + (c & 1) * TC * 2;
#define ST_LD(o, s_) do { const float* f_ = F + (s_) * 384 + cg8; o.a0 = *(const f32x4*)(f_); o.a1 = *(const f32x4*)(f_ + 4); o.q0 = *(const f32x4*)(f_ + 256); o.q1 = *(const f32x4*)(f_ + 260); \
                o.w0 = *(const f32x4*)(f_ + 128); o.w1 = *(const f32x4*)(f_ + 132); o.b0 = *(const f32x4*)(f_ + 64); o.b1 = *(const f32x4*)(f_ + 68); o.k0 = *(const f32x4*)(f_ + 192); o.k1 = *(const f32x4*)(f_ + 196); \
                o.viA = F[(s_) * 384 + 320 + iA]; o.viB = F[(s_) * 384 + 320 + iB]; o.sc2 = *(const f32x2*)(scl + (s_) * 2); } while (0)
#define P2(v, i) (f32x2){v[i], v[i + 1]}
#define ST_ROW(o, S, vi, irow, s_) do { \
                f32x2 da = S[0] * P2(o.a0, 0), dq = S[0] * P2(o.q0, 0); da += S[1] * P2(o.a0, 2); dq += S[1] * P2(o.q0, 2); \
                da += S[2] * P2(o.a1, 0); dq += S[2] * P2(o.q1, 0); da += S[3] * P2(o.a1, 2); dq += S[3] * P2(o.q1, 2); \
                float sa = da[0] + da[1], sy = dq[0] + dq[1]; \
                sa += DPPF(sa, 0xB1); sy += DPPF(sy, 0xB1); sa += DPPF(sa, 0x4E); sy += DPPF(sy, 0x4E); sa += DPPF(sa, 0x141); sy += DPPF(sy, 0x141); \
                const f32x2 sa2 = {sa, sa}, vi2 = {vi, vi}; \
                S[0] = S[0] * P2(o.w0, 0) + sa2 * P2(o.b0, 0) + vi2 * P2(o.k0, 0); S[1] = S[1] * P2(o.w0, 2) + sa2 * P2(o.b0, 2) + vi2 * P2(o.k0, 2); \
                S[2] = S[2] * P2(o.w1, 0) + sa2 * P2(o.b1, 0) + vi2 * P2(o.k1, 0); S[3] = S[3] * P2(o.w1, 2) + sa2 * P2(o.b1, 2) + vi2 * P2(o.k1, 2); \
                yb[(s_) * 64 + irow] = sy + sa * o.sc2[0] + vi * o.sc2[1]; } while (0)
                StepOps X, Z; ST_LD(X, 0);
#pragma unroll
                for (int s = 0; s < TC; s += 2) {
                    ST_LD(Z, s + 1);
                    ST_ROW(X, SA, X.viA, iA, s); ST_ROW(X, SB, X.viB, iB, s);
                    ST_LD(X, s + 2);
                    ST_ROW(Z, SA, Z.viA, iA, s + 1); ST_ROW(Z, SB, Z.viB, iB, s + 1);
                }
#undef ST_LD
#undef ST_ROW
#undef P2
                __syncthreads();
            }
        }
    }
    __syncthreads();
}
DEVINL void phase_rwkv_out(const PV& p, const float* Y, const bf16_t* Y1, const bf16_t* R, const bf16_t* Kf, const bf16_t* Vf, const bf16_t* AA, const bf16_t* Gg, bf16_t* XO) {
    const int lane = otid() & 63, gw = obid() * 8 + (otid() >> 6), nw = gridDim.x * 8;
    const float* k_a = p.in(33); const float* r_k = p.in(34); const float* lnw = p.in(35); const float* lnb = p.in(36);
    for (int r = gw; r < NTOK; r += nw) {
#pragma unroll
        for (int i = 0; i < 4; ++i) { const int c = i * 256 + lane * 4; const size_t o = (size_t)r * DM + c;
            const u32x2 y1w = *(const u32x2*)(Y1 + o);
            const f32x4 y = *(const f32x4*)(Y + o) + (f32x4){lo_bf(y1w.x), hi_bf(y1w.x), lo_bf(y1w.y), hi_bf(y1w.y)};
            const u32x2 rw = *(const u32x2*)(R + o), kw = *(const u32x2*)(Kf + o), vw = *(const u32x2*)(Vf + o), a0w = *(const u32x2*)(AA + o), a1w = *(const u32x2*)(AA + (size_t)NTOK * DM + o), gw2 = *(const u32x2*)(Gg + o);
            const f32x4 rr = {lo_bf(rw.x), hi_bf(rw.x), lo_bf(rw.y), hi_bf(rw.y)}, kk = {lo_bf(kw.x), hi_bf(kw.x), lo_bf(kw.y), hi_bf(kw.y)}, vv = {lo_bf(vw.x), hi_bf(vw.x), lo_bf(vw.y), hi_bf(vw.y)};
            const f32x4 a0 = {sigm_f(lo_bf(a0w.x)), sigm_f(hi_bf(a0w.x)), sigm_f(lo_bf(a0w.y)), sigm_f(hi_bf(a0w.y))}, a1 = {sigm_f(lo_bf(a1w.x)), sigm_f(hi_bf(a1w.x)), sigm_f(lo_bf(a1w.y)), sigm_f(hi_bf(a1w.y))}, gg = {lo_bf(gw2.x), hi_bf(gw2.x), lo_bf(gw2.y), hi_bf(gw2.y)};
            const f32x4 ka = *(const f32x4*)(k_a + c), rk = *(const f32x4*)(r_k + c), lw = *(const f32x4*)(lnw + c), lb = *(const f32x4*)(lnb + c);
            float s = y[0] + y[1] + y[2] + y[3]; s = sum16(s); const float mu = s * (1.f / 64.f);
            const f32x4 d = y - mu; float vs = d[0] * d[0] + d[1] * d[1] + d[2] * d[2] + d[3] * d[3]; vs = sum16(vs);
            const float rstd = rsqrtf(vs * (1.f / 64.f) + 64e-5f);
            const f32x4 kd = kk * ((a0 + a1 - 2.f) * ka + 2.f);
            const f32x4 cf = rr * kd * rk; float co = cf[0] + cf[1] + cf[2] + cf[3]; co = sum16(co);
            const f32x4 out = (d * rstd * lw + lb + vv * co) * gg;
            st_bf4(XO + o, out); }
    }
}

enum { OP_PREP, OP_ROW0, OP_ROW_A, OP_ROW_B, OP_ROW_C, OP_FFN_UP, OP_FFN_DN, OP_MLA_DQKV, OP_MLA_NORM, OP_MLA_UQ, OP_MLA_UKV, OP_MLA_ATTN, OP_MLA_WO,
       OP_FN_DFT, OP_FN_DFTC, OP_FN_OUT, OP_RW_SHIFT, OP_RW_G1, OP_RW_G2W, OP_RW_G2A, OP_RW_G2G, OP_RW_SCAN, OP_RW_OUT, OP_RW_WO };
#define OPC(op, layer, which, nosync) ((op) | ((layer) << 8) | ((which) << 12) | ((nosync) << 16))
#define FFN1(l) OPC(OP_FFN_UP, l, 0, 0), OPC(OP_FFN_DN, l, 0, 0), OPC(OP_ROW_A, l, 0, 0)
#define FFN2(l) OPC(OP_ROW_B, l, 0, 0), OPC(OP_FFN_UP, l, 1, 0), OPC(OP_FFN_DN, l, 1, 0), OPC(OP_ROW_C, l, 0, 0)
#define MLA(l) OPC(OP_MLA_DQKV, l, 0, 0), OPC(OP_MLA_NORM, l, 0, 0), OPC(OP_MLA_UQ, l, 0, 1), OPC(OP_MLA_UKV, l, 0, 0), OPC(OP_MLA_ATTN, l, 0, 0), OPC(OP_MLA_WO, l, 0, 0)
constexpr int PROG[] = {
    OPC(OP_PREP, 0, 0, 0), OPC(OP_ROW0, 0, 0, 0),
    FFN1(0), MLA(0), FFN2(0),
    FFN1(1), OPC(OP_FN_DFT, 1, 0, 1), OPC(OP_FN_DFTC, 1, 0, 0), OPC(OP_FN_OUT, 1, 0, 0), FFN2(1),
    FFN1(2), OPC(OP_RW_SHIFT, 2, 0, 0), OPC(OP_RW_G1, 2, 0, 0), OPC(OP_RW_G2W, 2, 0, 1), OPC(OP_RW_G2A, 2, 0, 1), OPC(OP_RW_G2G, 2, 0, 0), OPC(OP_RW_SCAN, 2, 0, 0),
             OPC(OP_RW_OUT, 2, 0, 0), OPC(OP_RW_WO, 2, 0, 0), FFN2(2),
    FFN1(3), MLA(3), FFN2(3) };
constexpr int NPROG = 2 + (3 + 6 + 4) + (3 + 3 + 4) + (3 + 8 + 4) + (3 + 6 + 4);

#define XB_TMO      128
#define XB_XCNT(j)  (256  + 64 * (j))
#define XB_XSUB(j)  (1280 + 64 * (j))
#define XB_XGEN(j)  (2304 + 64 * (j))
#define XB_TOP      3328
#define XB_TOPGEN   3392
#define XCD_BAR_WORDS 3456
#define XB_SPIN_CAP (1u << 20)
DEVINL unsigned xb_ld(unsigned* p)              { return __hip_atomic_load(p, __ATOMIC_RELAXED, __HIP_MEMORY_SCOPE_AGENT); }
DEVINL unsigned xb_add(unsigned* p, unsigned v) { return __hip_atomic_fetch_add(p, v, __ATOMIC_RELAXED, __HIP_MEMORY_SCOPE_AGENT); }
DEVINL unsigned xb_xcc_id() { return (unsigned)__builtin_amdgcn_s_getreg((3 << 11) | 20) & 0xFu; }
#define XB_SPIN(cond, bar) do { unsigned _sp = 0; while (cond) { __builtin_amdgcn_s_sleep(1); \
    if ((++_sp & 255u) == 0u) { if (xb_ld(&(bar)[XB_TMO])) break; if (_sp > XB_SPIN_CAP) { atomicAdd(&(bar)[XB_TMO], 1u); break; } } } } while (0)
DEVINL void xcd_barrier_post(unsigned* bar) { if (otid() == 0) (void)xb_add(&bar[XB_XCNT(xb_xcc_id())], 1u); }
DEVINL void xcd_barrier_complete(unsigned* bar, unsigned x, unsigned& nloc, unsigned& nx) {
    const unsigned G = gridDim.x;
    unsigned sum, cnt, mine, sp = 0u;
    for (;;) {
        sum = 0u; cnt = 0u; mine = 0u;
#pragma unroll
        for (unsigned j = 0; j < 16; ++j) { const unsigned c = xb_ld(&bar[XB_XCNT(j)]); sum += c; cnt += (c > 0u) ? 1u : 0u; mine = (j == x) ? c : mine; }
        if (sum == G) break;
        __builtin_amdgcn_s_sleep(1);
        if ((++sp & 255u) == 0u) { if (xb_ld(&bar[XB_TMO])) break; if (sp > XB_SPIN_CAP) { atomicAdd(&bar[XB_TMO], 1u); break; } }
    }
    nloc = mine > 0u ? mine : 1u; nx = cnt > 0u ? cnt : 1u;
}
DEVINL void xcd_barrier(unsigned* bar, volatile LAS unsigned* st) {
    asm volatile("s_waitcnt vmcnt(0)" ::: "memory");
    __syncthreads();
    if (otid() == 0) {
        const unsigned x = xb_xcc_id();
        __builtin_amdgcn_s_waitcnt(0);
        unsigned nloc = st[0], nx = st[1];
        if (nloc == 0u) { xcd_barrier_complete(bar, x, nloc, nx); st[0] = nloc; st[1] = nx; }
        const unsigned old = xb_add(&bar[XB_XSUB(x)], 1u);
        const unsigned gen = old / nloc;
        if (old + 1u == (gen + 1u) * nloc) {
            __builtin_amdgcn_fence(__ATOMIC_RELEASE, "agent");
            asm volatile("s_waitcnt vmcnt(0)" ::: "memory");
            const unsigned og = xb_add(&bar[XB_TOP], 1u);
            const unsigned tg = og / nx;
            if (og + 1u == (tg + 1u) * nx) xb_add(&bar[XB_TOPGEN], 1u);
            else XB_SPIN(xb_ld(&bar[XB_TOPGEN]) == tg, bar);
            __builtin_amdgcn_fence(__ATOMIC_ACQUIRE, "agent");
            xb_add(&bar[XB_XGEN(x)], 1u);
            asm volatile("s_waitcnt vmcnt(0)" ::: "memory");
        } else {
            XB_SPIN(xb_ld(&bar[XB_XGEN(x)]) == gen, bar);
            __builtin_amdgcn_fence(__ATOMIC_ACQUIRE, "agent");
            asm volatile("s_waitcnt vmcnt(0)" ::: "memory");
        }
    }
    __syncthreads();
}
constexpr int bar_ordinal(int pc) { int n = 0; for (int q = 1; q <= pc; ++q) if (!((PROG[q] >> 16) & 1)) ++n; return n; }
template <int PC>
DEVINL void run_prog(const Params& kp, unsigned char* smem, cg::grid_group& grid) {
    LAS unsigned char* lds = (LAS unsigned char*)smem;
    {
        constexpr int code = PROG[PC], op = code & 0xff, i = (code >> 8) & 0xf, which = (code >> 12) & 0xf, nosync = (code >> 16) & 1;
        unsigned char* ws = kp.ws;
        const int zz = 0;
        float* outp = kp.out;
        const PV p{kp, zz, ws, outp};
        float* MOD = (float*)(ws + WS_MOD); float* HC = (float*)(ws + WS_HC); bf16_t* XN = (bf16_t*)(ws + WS_XN); float* Y = (float*)(ws + WS_Y);
        bf16_t* WM = (bf16_t*)(ws + WS_WM); unsigned char* SCR = ws + WS_SCR;
        const float* npre = p.in(6); const float* npost = p.in(7);
        const int kind = i % 3, j = i / 3; const bool last = (i == 3);
        const float* modi = MOD + (size_t)i * 9 * MODW;
        bf16_t* slot = (bf16_t*)(ws + WS_WF) + (size_t)(i & 1) * FFN_SLOT;
        bf16_t* G = (bf16_t*)(SCR + S_G);
        bf16_t* M = WM + (j ? WM_MLA1 : WM_MLA0);
        switch (op) {
        case OP_PREP: phase_prep(p, smem); break;
        case OP_ROW0: case OP_ROW_A: case OP_ROW_B: case OP_ROW_C: {
            RowArgs a{}; a.hin_l = p.out; a.hin_c = HC; a.hout_l = p.out; a.hout_c = HC; a.Y = Y; a.modp = modi; a.xn = XN; a.xn_ld = 1024; a.nrows = NTOK; a.upd_ctx = 1; a.modn = modi;
            if (op == OP_ROW0) { a.hin_l = p.in(0); a.hin_c = p.in(2); a.Y = nullptr; a.subn = 0; a.gpre = npre; }
            else if (op == OP_ROW_A) { a.Ys = (const float*)(ws + WS_SLAB); a.nslab = NSLAB; a.subp = 0; a.gpost = npost + (i * 3 + 0) * 1024; a.coef = 0.5f; a.subn = 1; a.gpre = npre + (i * 3 + 1) * 1024; a.xn_ld = (kind == 2) ? 2048 : 1024; }
            else if (op == OP_ROW_B) { a.Ys = (const float*)(ws + WS_SLAB); a.nslab = last ? 0 : 4; a.subp = 1; a.gpost = npost + (i * 3 + 1) * 1024; a.coef = 1.0f; a.subn = 2; a.gpre = npre + (i * 3 + 2) * 1024; a.nrows = last ? NLAT : NTOK; }
            else { a.Ys = (const float*)(ws + WS_SLAB); a.nslab = last ? 0 : NSLAB; a.subp = 2; a.gpost = npost + (i * 3 + 2) * 1024; a.coef = 0.5f; a.nrows = last ? NLAT : NTOK;
                   if (last) a.modn = nullptr; else { a.modn = MOD + (size_t)(i + 1) * 9 * MODW; a.subn = 0; a.gpre = npre + ((i + 1) * 3 + 0) * 1024; } }
            if (op == OP_ROW_A && kind == 1) phase_rows_T(a, smem, (bf16_t*)(SCR + S_XT), (bf16_t*)(SCR + S_XTC)); else phase_rows(a);
        } break;
        case OP_FFN_UP: { Gemm g{XN, slot + (size_t)which * (FFN_WGU + FFN_WD), 1024, 1024, 1024, ((last && which) ? NLAT : NTOK) / 256, 2 * DFF / 256, 0, 0}; EpiSwiGLU E{G}; gemm_phase(lds, g, E);
            if (i < 3) { const int nbusy = (g.nM * g.nN) % (int)gridDim.x, bid = obid();
                if (bid >= nbusy) { __syncthreads(); conv_ffn_w((float*)smem, p, i + 1, which, (bf16_t*)(ws + WS_WF) + (size_t)((i + 1) & 1) * FFN_SLOT, bid - nbusy, (int)gridDim.x - nbusy); } } } break;
        case OP_MLA_DQKV: { Gemm g{XN, M + MLA_DQKV, 1024, 1024, 1024, NTOK / 256, 4, 0, 0}; EpiF32 E{Y, 1024, nullptr, nullptr}; gemm_phase(lds, g, E);
            if (i == 0) { const int nbusy = (g.nM * g.nN) % (int)gridDim.x, bid = obid(); if (bid >= nbusy) { __syncthreads(); prep_late(p, smem, bid - nbusy, (int)gridDim.x - nbusy); } } } break;
        case OP_FFN_DN: case OP_MLA_WO: case OP_FN_OUT: case OP_RW_WO: {
            Gemm g{XN, M + MLA_WO, 1024, 1024, 1024, NLAT / 256, 4, 0, 0}; EpiY E{(bf16_t*)Y, nullptr, (float*)(ws + WS_SLAB)};
            bool tail = true;
            if (op == OP_FFN_DN) { g.A = G; g.Bt = slot + (size_t)which * (FFN_WGU + FFN_WD) + FFN_WGU; g.lda = g.ldb = g.K = DFF; tail = !(last && which); g.KS = 512; g.nSl = NSLAB; }
            else if (op == OP_MLA_WO) { tail = !last; g.KS = 256; g.nSl = 4; }
            else if (op == OP_FN_OUT) { g.A = (bf16_t*)(SCR + S_P); g.Bt = WM + WM_W2T; g.lda = g.ldb = g.K = 2048; E.bias = p.in(19); g.KS = 512; g.nSl = 4; }
            else { g.Bt = WM + WM_RWO; g.KS = 256; g.nSl = 4; }
            if (tail) g.nTailM = NCTX / 256; else g.nSl = 0;
            gemm_phase(lds, g, E);
        } break;
        case OP_MLA_NORM: phase_mla_norm(p, j, Y, (bf16_t*)(SCR + S_QN), (bf16_t*)(SCR + S_CKVN), (bf16_t*)(SCR + S_K)); break;
        case OP_MLA_UQ: { Gemm g{(bf16_t*)(SCR + S_QN), M + MLA_UQ, 512, 512, 512, NTOK / 256, 6, 0, 0}; EpiUQ E{(bf16_t*)(SCR + S_Q), (const float*)(ws + WS_ROPE), (const float*)(ws + WS_ROPE) + 1024}; gemm_phase(lds, g, E); } break;
        case OP_MLA_UKV: { Gemm g{(bf16_t*)(SCR + S_CKVN), M + MLA_UKV, 256, 256, 256, NTOK / 256, 8, 0, 0}; EpiUKV E{(bf16_t*)(SCR + S_K), (bf16_t*)(SCR + S_V)}; gemm_phase(lds, g, E); } break;
        case OP_MLA_ATTN: phase_attn((bf16_t*)(SCR + S_Q), (bf16_t*)(SCR + S_K), (bf16_t*)(SCR + S_V), XN, !last, (char*)smem); break;
        case OP_FN_DFT: case OP_FN_DFTC: {
            Gemm g{WM + WM_DT2, (bf16_t*)(SCR + S_XT), 2048, 2048, 2048, 128, 4, 16, (size_t)1024 * 2048 * 2}; EpiDFT1 E{(bf16_t*)(SCR + S_P), 4, 2048, 0};
            if (op == OP_FN_DFTC) { g.A = WM + WM_DT2C; g.Bt = (bf16_t*)(SCR + S_XTC); g.lda = g.ldb = g.K = 256; g.nM = 16; g.amod = 2; g.bbatch = (size_t)1024 * 256 * 2; E.shift = 1; E.rpb = 256; E.rowbase = NLAT; }
            gemm_phase(lds, g, E);
        } break;
        case OP_RW_SHIFT: phase_rwkv_shift(XN); break;
        case OP_RW_G1: { Gemm g{XN, WM + WM_WCAT, 2048, 2048, 2048, NTOK / 256, 14, 0, 0}; EpiRwkv1 E{(bf16_t*)(SCR + S_R), (bf16_t*)(SCR + S_A2)}; gemm_phase(lds, g, E); } break;
        case OP_RW_G2W: case OP_RW_G2A: {
            Gemm g{(bf16_t*)(SCR + S_A2), WM + WM_BW, 512, 256, 256, NTOK / 256, 8, 0, 0};
            if (op == OP_RW_G2A) { g.Bt = WM + WM_BA; EpiRwkv2<1> E{(bf16_t*)(SCR + S_AA), p.in(27)}; gemm_phase(lds, g, E); }
            else { EpiRwkv2<0> E{XN, p.in(24)}; gemm_phase(lds, g, E); }
        } break;
        case OP_RW_G2G: { Gemm g{(bf16_t*)(SCR + S_A2) + 256, WM + WM_BG, 512, 256, 256, NTOK / 256, 4, 0, 0}; EpiBf16 E{(bf16_t*)(SCR + S_GG), 1024}; gemm_phase(lds, g, E); } break;
        case OP_RW_SCAN: phase_scan(p, (bf16_t*)(SCR + S_R), (bf16_t*)(SCR + S_KK), (bf16_t*)(SCR + S_VV), (bf16_t*)(SCR + S_AA), XN, Y, (bf16_t*)(ws + WS_SLAB), smem); break;
        case OP_RW_OUT: phase_rwkv_out(p, Y, (const bf16_t*)(ws + WS_SLAB), (bf16_t*)(SCR + S_R), (bf16_t*)(SCR + S_KK), (bf16_t*)(SCR + S_VV), (bf16_t*)(SCR + S_AA), (bf16_t*)(SCR + S_GG), XN); break;
        default: break;
        }
        if (!nosync && PC + 1 < NPROG) { if (PC == 0 && kp.ws == nullptr) grid.sync(); xcd_barrier((unsigned*)(kp.ws + WS_BAR), (volatile LAS unsigned*)(lds + LDS_BYTES - 16)); }
    }
    if constexpr (PC + 1 < NPROG) run_prog<PC + 1>(kp, smem, grid);
}
__global__ void __launch_bounds__(512) fwd_megakernel(Params kp) {
    extern __shared__ __attribute__((aligned(16))) unsigned char smem[];
    cg::grid_group grid = cg::this_grid();
    if (otid() < 4) ((volatile LAS unsigned*)((LAS unsigned char*)smem + LDS_BYTES - 16))[otid()] = 0u;
    __syncthreads();
    xcd_barrier_post((unsigned*)(kp.ws + WS_BAR));
    run_prog<0>(kp, smem, grid);
}

extern "C" void kernel_launch(void* const* d_in, const int* in_sizes, int n_in, void* d_out, int out_size, void* d_ws, size_t ws_size, hipStream_t stream) {
    static int grid = 0;
    if (grid == 0) {
        if (n_in != 38 || ws_size < WS_END) { fprintf(stderr, "kernel_launch: need 38 inputs and %zu bytes of workspace; got %d, %zu\n", (size_t)WS_END, n_in, ws_size); grid = -1; return; }
        int dev = 0, cus = 0, per_cu = 0;
        (void)hipGetDevice(&dev); (void)hipDeviceGetAttribute(&cus, hipDeviceAttributeMultiprocessorCount, dev);
        if (hipFuncSetAttribute((const void*)fwd_megakernel, hipFuncAttributeMaxDynamicSharedMemorySize, LDS_BYTES) != hipSuccess) { fprintf(stderr, "kernel_launch: hipFuncSetAttribute failed\n"); grid = -1; return; }
        if (hipOccupancyMaxActiveBlocksPerMultiprocessor(&per_cu, (const void*)fwd_megakernel, 512, LDS_BYTES) != hipSuccess || per_cu < 1) { fprintf(stderr, "kernel_launch: occupancy query says %d\n", per_cu); per_cu = 1; }
        (void)hipGetLastError();
        grid = cus * 1;
    }
    if (grid < 0) return;
    Params p{};
    for (int i = 0; i < 38; ++i) p.in[i] = (const float*)d_in[i];
    p.out = (float*)d_out; p.ws = (unsigned char*)d_ws;
    if (hipMemsetAsync((char*)d_ws + WS_BAR, 0, 16384, stream) != hipSuccess) { fprintf(stderr, "kernel_launch: memset failed\n"); return; }
    void* args[] = {&p};
    hipError_t e = hipLaunchCooperativeKernel((const void*)fwd_megakernel, dim3(grid), dim3(512), args, LDS_BYTES, stream);
    if (e != hipSuccess) fprintf(stderr, "cooperative launch failed: %s (grid %d)\n", hipGetErrorString(e), grid);
}
```

```cpp
#include <hip/hip_runtime.h>
#include <hip/hip_cooperative_groups.h>
#include <cstdio>
namespace cg = cooperative_groups;

#define LAS __attribute__((address_space(3)))
#define DEVINL __device__ __forceinline__
typedef unsigned short bf16_t;
typedef short bf16x8 __attribute__((ext_vector_type(8)));
typedef short s16x4 __attribute__((ext_vector_type(4)));
typedef float f32x4 __attribute__((ext_vector_type(4)));
typedef float f32x16 __attribute__((ext_vector_type(16)));
typedef unsigned u32x4 __attribute__((ext_vector_type(4)));
typedef unsigned u32x2 __attribute__((ext_vector_type(2)));

constexpr int DM = 1024, NB = 8, SEQ = 2048, CTX = 256, DFF = 2816, NLAT = NB * SEQ, NCTX = NB * CTX, NTOK = NLAT + NCTX, TKV = SEQ + CTX;
constexpr int MODW = 9 * DM;
constexpr float EPS = 1e-6f;

constexpr size_t al256(size_t x) { return (x + 255) / 256 * 256; }
constexpr size_t WS_MOD = 0;
constexpr size_t WS_ROPE = al256(WS_MOD + (size_t)4 * 9 * MODW * 4);
constexpr size_t WS_HC = al256(WS_ROPE + 2 * 64 * 16 * 4);
constexpr size_t WS_XN = al256(WS_HC + (size_t)NCTX * DM * 4);
constexpr size_t WS_Y = al256(WS_XN + (size_t)NTOK * 2048 * 2);
constexpr size_t FFN_WGU = (size_t)2 * DFF * DM;
constexpr size_t FFN_WD = (size_t)DM * DFF;
constexpr size_t FFN_SLOT = 2 * (FFN_WGU + FFN_WD);
constexpr size_t WS_WF = al256(WS_Y + (size_t)NTOK * DM * 4);
constexpr size_t WS_WM = al256(WS_WF + 2 * FFN_SLOT * 2);
constexpr size_t MLA_DQKV = 0, MLA_UQ = MLA_DQKV + 1024 * 1024, MLA_UKV = MLA_UQ + 1536 * 512, MLA_WO = MLA_UKV + 2048 * 256, MLA_SZ = MLA_WO + 1024 * 1024;
constexpr size_t WM_MLA0 = 0, WM_MLA1 = MLA_SZ;
constexpr size_t WM_W2T = 2 * MLA_SZ, WM_DT2 = WM_W2T + 1024 * 2048, WM_DT2C = WM_DT2 + (size_t)4096 * 2048;
constexpr size_t WM_WCAT = WM_DT2C + 512 * 256, WM_BW = WM_WCAT + (size_t)3584 * 2048, WM_BA = WM_BW + 2048 * 256, WM_BG = WM_BA + 2048 * 256, WM_RWO = WM_BG + 1024 * 256;
constexpr size_t WM_END = WM_RWO + 1024 * 1024;
constexpr size_t WS_SCR = al256(WS_WM + WM_END * 2);
constexpr size_t SCR_BYTES = 245366784;
constexpr size_t WS_BAR = WS_SCR + SCR_BYTES;
constexpr int NSLAB = 6;
constexpr size_t WS_SLAB = WS_BAR + 16384;
constexpr size_t WS_END = WS_SLAB + (size_t)NSLAB * NCTX * DM * 4;
constexpr size_t S_G = 0;
constexpr size_t S_QN = 0, S_CKVN = S_QN + (size_t)NTOK * 512 * 2, S_Q = S_CKVN + (size_t)NTOK * 256 * 2, S_K = S_Q + (size_t)64 * TKV * 192 * 2,
                 S_V = S_K + (size_t)64 * TKV * 192 * 2;
constexpr size_t S_XT = 0, S_XTC = S_XT + (size_t)8 * 1024 * 2048 * 2, S_P = al256(S_XTC + (size_t)8 * 1024 * 256 * 2);
constexpr size_t S_R = 0, S_KK = S_R + (size_t)NTOK * DM * 2, S_VV = S_KK + (size_t)NTOK * DM * 2, S_A2 = S_VV + (size_t)NTOK * DM * 2,
                 S_AA = S_A2 + (size_t)NTOK * 512 * 2, S_GG = S_AA + (size_t)2 * NTOK * DM * 2;
static_assert(S_GG + (size_t)NTOK * DM * 2 <= SCR_BYTES, "scratch");
static_assert(S_V + (size_t)64 * TKV * 128 * 2 <= SCR_BYTES, "scratch");
static_assert(S_P + (size_t)NTOK * 2048 * 2 <= SCR_BYTES, "scratch");

constexpr int LDS_BYTES = 135168;

struct Params { const float* in[38]; float* out; unsigned char* ws; };
struct PV { const Params& p; int z; unsigned char* ws; float* out;
    __device__ __forceinline__ const float* in(int k) const { return p.in[k + z]; } };

DEVINL int otid() { int t = threadIdx.x; asm volatile("" : "+v"(t)); return t; }
DEVINL int obid() { int b = blockIdx.x; asm volatile("" : "+s"(b)); return b; }
DEVINL float bf2f(bf16_t b) { return __uint_as_float(((unsigned)b) << 16); }
DEVINL bf16_t f2bf(float f) { unsigned u = __float_as_uint(f); u += 0x7FFFu + ((u >> 16) & 1u); return (bf16_t)(u >> 16); }
typedef float f32x2c __attribute__((ext_vector_type(2)));
typedef __bf16 bf16x2c __attribute__((ext_vector_type(2)));
DEVINL unsigned pk2(float lo, float hi) { const f32x2c v = {lo, hi}; const bf16x2c r = __builtin_convertvector(v, bf16x2c); return __builtin_bit_cast(unsigned, r); }
DEVINL float wave_sum(float v) {
#pragma unroll
    for (int o = 32; o > 0; o >>= 1) v += __shfl_xor(v, o);
    return v; }
#define DPPF(v, ctrl) __builtin_bit_cast(float, __builtin_amdgcn_update_dpp(0, __builtin_bit_cast(int, (v)), (ctrl), 0xF, 0xF, false))
DEVINL float wave_sum_dpp(float v) {
    v += DPPF(v, 0xB1); v += DPPF(v, 0x4E); v += DPPF(v, 0x141); v += DPPF(v, 0x140);
    const int vi_ = __builtin_bit_cast(int, v);
    return __builtin_bit_cast(float, __builtin_amdgcn_readlane(vi_, 0)) + __builtin_bit_cast(float, __builtin_amdgcn_readlane(vi_, 16)) + __builtin_bit_cast(float, __builtin_amdgcn_readlane(vi_, 32)) + __builtin_bit_cast(float, __builtin_amdgcn_readlane(vi_, 48));
}
DEVINL float sum16(float v) {
#pragma unroll
    for (int o = 8; o > 0; o >>= 1) v += __shfl_xor(v, o);
    return v; }
DEVINL float silu_f(float x) { return x * __builtin_amdgcn_rcpf(1.f + __expf(-x)); }
DEVINL float sigm_f(float x) { return __builtin_amdgcn_rcpf(1.f + __expf(-x)); }
DEVINL float lo_bf(unsigned w) { return __uint_as_float(w << 16); }
DEVINL float hi_bf(unsigned w) { return __uint_as_float(w & 0xFFFF0000u); }

constexpr int BM = 256, BK = 64, HALF = 128, HTB = HALF * BK * 2, NXCD = 8, WGM = 8;
DEVINL int lds_byte(int r, int c) { const int st = (r >> 4) * 2 + (c >> 5), rr = r & 15, cc = c & 31, ob = rr * 64 + cc * 2; return st * 1024 + (ob ^ (((ob >> 9) & 1) << 5)); }
DEVINL void stage_rc(int b, int& R, int& C) { const int st = b / 1024, sb = b % 1024, swz = sb ^ (((sb >> 9) & 1) << 5); R = (st >> 1) * 16 + swz / 64; C = (st & 1) * 32 + (swz % 64) / 2; }
DEVINL int perm32(int rho) { const int n = rho >> 4, i = rho & 15; return 8 * (i >> 2) + 4 * n + (i & 3); }
struct Unit { int pm, pn, ks; };
struct Gemm { const bf16_t* A; const bf16_t* Bt; int lda, ldb, K, nM, nN, amod; size_t bbatch; int nTailM, nSl, KS; };
struct Sched {
    int nM, nN, nwg, G, c, ntail, nSl;
    DEVINL void init(int nM_, int nN_, int nTailM, int nSl_) { nM = nM_; nN = nN_; nwg = nM * nN; G = gridDim.x; c = obid(); nSl = nSl_; ntail = nTailM * nN_ * nSl_; }
    DEVINL bool next(int i, Unit& u) const {
        const long L = (long)i * G + c; if (L >= nwg + ntail) return false;
        if (L >= nwg) { const int t = (int)L - nwg, rest = t / nSl; u.ks = t % nSl; u.pn = rest % nN; u.pm = nM + rest / nN; return true; }
        u.ks = -1;
        int wgid = (int)L; { const int q = nwg / NXCD, r = nwg % NXCD, xcd = wgid % NXCD, off = wgid / NXCD; wgid = (xcd < r ? xcd * (q + 1) : r * (q + 1) + (xcd - r) * q) + off; }
        const int nig = WGM * nN, gid = wgid / nig, fm = gid * WGM, gsz = (nM - fm) < WGM ? (nM - fm) : WGM;
        u.pm = fm + ((wgid % nig) % gsz); u.pn = (wgid % nig) / gsz; return true;
    }
};
typedef f32x4 Acc[2][2][4][2];

template <class Epi>
DEVINL void gemm_phase(LAS unsigned char* lds, const Gemm g, const Epi& E) {
    const int tid = otid(), wid = __builtin_amdgcn_readfirstlane(tid >> 6), lane = tid & 63, wr = wid >> 2, wc = wid & 3, fr = lane & 15, fq = lane >> 4;
    Sched S; S.init(g.nM, g.nN, g.nTailM, g.nSl);
    const int K = g.K;
    unsigned voffA[2], voffB[2];
#pragma unroll
    for (int i = 0; i < 2; ++i) { int R, C; stage_rc(tid * 16 + i * 8192, R, C);
        const int Rb = Epi::PERM ? ((R & ~31) + perm32(R & 31)) : R;
        voffA[i] = (unsigned)(R * g.lda + C) * 2u; voffB[i] = (unsigned)(Rb * g.ldb + C) * 2u; }
    const size_t kstep = (size_t)(BK * 2);
    const size_t hstepA = (size_t)HALF * g.lda * 2, hstepB = (size_t)HALF * g.ldb * 2;
    const size_t tstepA = 2 * hstepA, tstepB = 2 * hstepB;
    const unsigned ldsw = (unsigned)wid * 1024u;
    const int aoff = lds_byte(wr * 64 + fr, fq * 8), boff = lds_byte(wc * 32 + fr, fq * 8);
#define PG8_SA(b, h) (((b) * 2 + (h)) * HTB)
#define PG8_SB(b, h) ((4 + (b) * 2 + (h)) * HTB)
#define PG8_STAGE(bufoff, gbase, voff) do { _Pragma("unroll") for (int _i = 0; _i < 2; ++_i) \
        __builtin_amdgcn_global_load_lds((const unsigned*)((const char*)(gbase) + (voff)[_i]), (LAS unsigned*)(lds + (bufoff) + ldsw + _i * 8192), 16, 0, 0); } while (0)
#define PG8_LDA(dst, b, h) do { _Pragma("unroll") for (int m = 0; m < 4; ++m) _Pragma("unroll") for (int k = 0; k < 2; ++k) dst[m][k] = *(const LAS bf16x8*)(lds + PG8_SA(b, h) + aoff + m * 2048 + k * 1024); } while (0)
#define PG8_LDB(dst, b, h) do { _Pragma("unroll") for (int n = 0; n < 2; ++n) _Pragma("unroll") for (int k = 0; k < 2; ++k) dst[n][k] = *(const LAS bf16x8*)(lds + PG8_SB(b, h) + boff + n * 2048 + k * 1024); } while (0)
#define PG8_MMA(ai, bj, At, Bt) do { __builtin_amdgcn_s_setprio(1); _Pragma("unroll") for (int m = 0; m < 4; ++m) _Pragma("unroll") for (int n = 0; n < 2; ++n) _Pragma("unroll") for (int k = 0; k < 2; ++k) \
        acc[ai][bj][m][n] = __builtin_amdgcn_mfma_f32_16x16x32_bf16(Bt[n][k], At[m][k], acc[ai][bj][m][n], 0, 0, 0); __builtin_amdgcn_s_setprio(0); } while (0)
#define PG8_WAIT_V(n) asm volatile("s_waitcnt vmcnt(" #n ")" ::: "memory")
#define PG8_WAIT_L(n) asm volatile("s_waitcnt lgkmcnt(" #n ")" ::: "memory")
#define PG8_BAR __builtin_amdgcn_s_barrier()
#define PG8_SCHED __builtin_amdgcn_sched_barrier(0)
    Unit cur, nxt; int ui = 0;
    if (!S.next(0, cur)) return;
    Acc acc;
#pragma unroll
    for (int a = 0; a < 2; ++a)
#pragma unroll
        for (int b = 0; b < 2; ++b)
#pragma unroll
            for (int m = 0; m < 4; ++m)
#pragma unroll
                for (int n = 0; n < 2; ++n) acc[a][b][m][n] = (f32x4){0.f, 0.f, 0.f, 0.f};
    bf16x8 At[4][2], B0[2][2], B1[2][2];
#define PG8_KOFF(u) ((u).ks > 0 ? (size_t)(u).ks * g.KS * 2 : (size_t)0)
#define PG8_NT(u) ((u).ks < 0 ? K / BK : ((K - (u).ks * g.KS) < g.KS ? (K - (u).ks * g.KS) : g.KS) / BK)
#define PG8_APTR(u) ((const char*)g.A + (size_t)(g.amod ? (u).pm % g.amod : (u).pm) * tstepA + PG8_KOFF(u))
#define PG8_BPTR(u) ((const char*)g.Bt + (size_t)(u).pn * tstepB + (g.amod ? (size_t)((u).pm / g.amod) * g.bbatch : (size_t)0) + PG8_KOFF(u))
    const char* cA = PG8_APTR(cur); const char* cB = PG8_BPTR(cur); int nt = PG8_NT(cur);
    PG8_STAGE(PG8_SB(0, 0), cB, voffB); PG8_STAGE(PG8_SA(0, 0), cA, voffA); PG8_STAGE(PG8_SB(0, 1), cB + hstepB, voffB); PG8_STAGE(PG8_SA(0, 1), cA + hstepA, voffA);
    if (wr == 1) PG8_BAR;
    PG8_WAIT_V(4); PG8_BAR;
    PG8_STAGE(PG8_SB(1, 0), cB + kstep, voffB); PG8_STAGE(PG8_SA(1, 0), cA + kstep, voffA); PG8_STAGE(PG8_SB(1, 1), cB + hstepB + kstep, voffB);
    PG8_WAIT_V(6); PG8_BAR;
    for (;;) {
        const bool has_next = S.next(ui + 1, nxt);
        const char* nA = has_next ? PG8_APTR(nxt) : cA; const char* nB = has_next ? PG8_BPTR(nxt) : cB;
        for (int t = 0; t < nt; t += 2) {
            const bool last = (t == nt - 2);
            const char* a1 = cA + (size_t)(t + 1) * kstep;
            const char* a2 = last ? nA : cA + (size_t)(t + 2) * kstep; const char* b2 = last ? nB : cB + (size_t)(t + 2) * kstep;
            const char* a3 = a2 + kstep; const char* b3 = b2 + kstep;
            PG8_LDB(B0, 0, 0); PG8_SCHED; PG8_LDA(At, 0, 0); PG8_STAGE(PG8_SA(1, 1), a1 + hstepA, voffA);
            PG8_WAIT_L(8); PG8_BAR; PG8_WAIT_L(0); PG8_MMA(0, 0, At, B0); PG8_BAR; PG8_SCHED;
            PG8_LDB(B1, 0, 1); PG8_STAGE(PG8_SB(0, 0), b2, voffB);
            PG8_BAR; PG8_WAIT_L(0); PG8_MMA(0, 1, At, B1); PG8_BAR;
            PG8_LDA(At, 0, 1); PG8_STAGE(PG8_SA(0, 0), a2, voffA);
            PG8_BAR; PG8_WAIT_L(0); PG8_MMA(1, 0, At, B0); PG8_BAR; PG8_SCHED;
            PG8_STAGE(PG8_SB(0, 1), b2 + hstepB, voffB);
            PG8_WAIT_V(6); PG8_BAR; PG8_MMA(1, 1, At, B1); PG8_BAR;
            PG8_LDB(B0, 1, 0); PG8_SCHED; PG8_LDA(At, 1, 0); PG8_STAGE(PG8_SA(0, 1), a2 + hstepA, voffA);
            PG8_WAIT_L(8); PG8_BAR; PG8_WAIT_L(0); PG8_MMA(0, 0, At, B0); PG8_BAR; PG8_SCHED;
            PG8_LDB(B1, 1, 1); PG8_STAGE(PG8_SB(1, 0), b3, voffB);
            PG8_BAR; PG8_WAIT_L(0); PG8_MMA(0, 1, At, B1); PG8_BAR;
            PG8_LDA(At, 1, 1); PG8_STAGE(PG8_SA(1, 0), a3, voffA);
            PG8_BAR; PG8_WAIT_L(0); PG8_MMA(1, 0, At, B0); PG8_BAR; PG8_SCHED;
            PG8_STAGE(PG8_SB(1, 1), b3 + hstepB, voffB);
            PG8_WAIT_V(6); PG8_BAR; PG8_MMA(1, 1, At, B1); PG8_BAR;
        }
        E(acc, cur, wr, wc, fr, fq);
        if (!has_next) break;
#pragma unroll
        for (int a = 0; a < 2; ++a)
#pragma unroll
            for (int b = 0; b < 2; ++b)
#pragma unroll
                for (int m = 0; m < 4; ++m)
#pragma unroll
                    for (int n = 0; n < 2; ++n) acc[a][b][m][n] = (f32x4){0.f, 0.f, 0.f, 0.f};
        cur = nxt; cA = nA; cB = nB; ++ui; nt = PG8_NT(cur);
    }
    PG8_WAIT_V(0);
    if (wr == 0) PG8_BAR;
    PG8_BAR;
#undef PG8_SA
#undef PG8_SB
#undef PG8_STAGE
#undef PG8_LDA
#undef PG8_LDB
#undef PG8_MMA
#undef PG8_BAR
#undef PG8_SCHED
#undef PG8_APTR
#undef PG8_KOFF
#undef PG8_NT
#undef PG8_BPTR
}
#define WAIT_V0() asm volatile("s_waitcnt vmcnt(0)" ::: "memory")

#define EPI_LOOP_ROWS for (int ai = 0; ai < 2; ++ai) for (int m = 0; m < 4; ++m)
DEVINL void st_bf4(bf16_t* p, f32x4 v) { u32x2 w; w.x = pk2(v[0], v[1]); w.y = pk2(v[2], v[3]); *(u32x2*)p = w; }

DEVINL void st_bf8(bf16_t* p, f32x4 a, f32x4 b) { u32x4 w; w.x = pk2(a[0], a[1]); w.y = pk2(a[2], a[3]); w.z = pk2(b[0], b[1]); w.w = pk2(b[2], b[3]); *(u32x4*)p = w; }
struct EpiF32 { static constexpr bool PERM = false;
    float* C; int ldc; const float* bias; float* Cs;
    DEVINL void operator()(const Acc& acc, const Unit& u, int wr, int wc, int fr, int fq) const {
        const int row0 = u.pm * BM + wr * 64 + fr, col0 = u.pn * BM + wc * 32 + 4 * fq;
        float* base = u.ks < 0 ? C : Cs + ((long)u.ks * NCTX - NLAT) * 1024;
#pragma unroll
        for (int ai = 0; ai < 2; ++ai)
#pragma unroll
            for (int m = 0; m < 4; ++m) { float* rowp = base + (size_t)(row0 + ai * HALF + m * 16) * ldc + col0;
#pragma unroll
                for (int bj = 0; bj < 2; ++bj)
#pragma unroll
                    for (int n = 0; n < 2; ++n) { f32x4 v = acc[ai][bj][m][n];
                        if (bias) v += *(const f32x4*)(bias + col0 + bj * HALF + n * 16);
                        *(f32x4*)(rowp + bj * HALF + n * 16) = v; } }
    }
};
struct EpiY { static constexpr bool PERM = true;
    bf16_t* Yb; const float* bias; float* Cs;
    DEVINL void operator()(const Acc& acc, const Unit& u, int wr, int wc, int fr, int fq) const {
        const int row0 = u.pm * BM + wr * 64 + fr, col0 = u.pn * BM + wc * 32 + 8 * fq;
        const bool addb = bias != nullptr && u.ks <= 0;
        float* sbase = Cs + ((long)u.ks * NCTX - NLAT) * 1024;
#pragma unroll
        for (int ai = 0; ai < 2; ++ai)
#pragma unroll
            for (int m = 0; m < 4; ++m) { const size_t ro = (size_t)(row0 + ai * HALF + m * 16) * 1024 + col0;
#pragma unroll
                for (int bj = 0; bj < 2; ++bj) { f32x4 v0 = acc[ai][bj][m][0], v1 = acc[ai][bj][m][1];
                    if (addb) { v0 += *(const f32x4*)(bias + col0 + bj * HALF); v1 += *(const f32x4*)(bias + col0 + bj * HALF + 4); }
                    if (u.ks < 0) st_bf8(Yb + ro + bj * HALF, v0, v1); else { *(f32x4*)(sbase + ro + bj * HALF) = v0; *(f32x4*)(sbase + ro + bj * HALF + 4) = v1; } } }
    }
};
struct EpiBf16 { static constexpr bool PERM = true;
    bf16_t* O; int ldc;
    DEVINL void operator()(const Acc& acc, const Unit& u, int wr, int wc, int fr, int fq) const {
        const int row0 = u.pm * BM + wr * 64 + fr, col0 = u.pn * BM + wc * 32 + 8 * fq;
#pragma unroll
        for (int ai = 0; ai < 2; ++ai)
#pragma unroll
            for (int m = 0; m < 4; ++m) { bf16_t* rowp = O + (size_t)(row0 + ai * HALF + m * 16) * ldc + col0;
#pragma unroll
                for (int bj = 0; bj < 2; ++bj) st_bf8(rowp + bj * HALF, acc[ai][bj][m][0], acc[ai][bj][m][1]); }
    }
};
struct EpiSwiGLU { static constexpr bool PERM = true;
    bf16_t* G;
    DEVINL void operator()(const Acc& acc, const Unit& u, int wr, int wc, int fr, int fq) const {
        const int row0 = u.pm * BM + wr * 64 + fr, col0 = u.pn * HALF + wc * 32 + 8 * fq;
#pragma unroll
        for (int ai = 0; ai < 2; ++ai)
#pragma unroll
            for (int m = 0; m < 4; ++m) { bf16_t* rowp = G + (size_t)(row0 + ai * HALF + m * 16) * DFF + col0;
                f32x4 o[2];
#pragma unroll
                for (int n = 0; n < 2; ++n) { const f32x4 gt = acc[ai][0][m][n], up = acc[ai][1][m][n];
#pragma unroll
                    for (int j = 0; j < 4; ++j) o[n][j] = silu_f(gt[j]) * up[j]; }
                st_bf8(rowp, o[0], o[1]); }
    }
};
DEVINL void tok_of_row(int r, int& b, int& tk, bool& lat) { lat = r < NLAT; if (lat) { b = r >> 11; tk = r & 2047; } else { const int rc = r - NLAT; b = rc >> 8; tk = SEQ + (rc & 255); } }
struct EpiUQ { static constexpr bool PERM = false;
    bf16_t* Q; const float* cosT; const float* sinT;
    DEVINL void operator()(const Acc& acc, const Unit& u, int wr, int wc, int fr, int fq) const {
#pragma unroll
        for (int ai = 0; ai < 2; ++ai)
#pragma unroll
            for (int m = 0; m < 4; ++m) { const int r = u.pm * BM + ai * HALF + wr * 64 + m * 16 + fr; int b, tq; bool lat; tok_of_row(r, b, tq, lat);
#pragma unroll
                for (int bj = 0; bj < 2; ++bj) { const int col32 = u.pn * BM + bj * HALF + wc * 32, head = col32 / 192, off = col32 % 192;
                    f32x4 v0 = acc[ai][bj][m][0], v1 = acc[ai][bj][m][1];
                    if (off >= 128 && lat) { const int axis = (off - 128) >> 5, pos = axis == 0 ? (tq >> 6) : (tq & 63);
                        const f32x4 c = *(const f32x4*)(cosT + pos * 16 + fq * 4), s = *(const f32x4*)(sinT + pos * 16 + fq * 4);
                        const f32x4 o0 = v0 * c - v1 * s, o1 = v1 * c + v0 * s; v0 = o0; v1 = o1; }
                    bf16_t* dst = Q + ((size_t)(b * 8 + head) * TKV + tq) * 192 + off + fq * 4;
                    st_bf4(dst, v0); st_bf4(dst + 16, v1); } }
    }
};
struct EpiUKV { static constexpr bool PERM = false;
    bf16_t* Kb; bf16_t* Vb;
    DEVINL void operator()(const Acc& acc, const Unit& u, int wr, int wc, int fr, int fq) const {
#pragma unroll
        for (int ai = 0; ai < 2; ++ai)
#pragma unroll
            for (int m = 0; m < 4; ++m) { const int r = u.pm * BM + ai * HALF + wr * 64 + m * 16 + fr; int b, tk; bool lat; tok_of_row(r, b, tk, lat);
                const size_t tokidx = (size_t)(b * 8 + u.pn) * TKV + tk; const int c = wc * 32 + fq * 4;
                bf16_t* kd = Kb + tokidx * 192 + c; bf16_t* vd = Vb + tokidx * 128 + c;
#pragma unroll
                for (int n = 0; n < 2; ++n) { st_bf4(kd + n * 16, acc[ai][0][m][n]); st_bf4(vd + n * 16, acc[ai][1][m][n]); } }
    }
};
struct EpiDFT1 { static constexpr bool PERM = true;
    bf16_t* P; int shift, rpb, rowbase;
    DEVINL void operator()(const Acc& acc, const Unit& u, int wr, int wc, int fr, int fq) const {
        const int b = u.pm >> shift, tile = u.pm & ((1 << shift) - 1), cs = tile >> (shift - 1), t0 = (tile & ((1 << (shift - 1)) - 1)) * 256;
        const int row0 = rowbase + b * rpb + t0 + wr * 64 + fr, col0 = cs * 1024 + u.pn * BM + wc * 32 + 8 * fq;
#pragma unroll
        for (int ai = 0; ai < 2; ++ai)
#pragma unroll
            for (int m = 0; m < 4; ++m) { bf16_t* rowp = P + (size_t)(row0 + ai * HALF + m * 16) * 2048 + col0;
#pragma unroll
                for (int bj = 0; bj < 2; ++bj) st_bf8(rowp + bj * HALF, acc[ai][bj][m][0], acc[ai][bj][m][1]); }
    }
};
struct EpiRwkv1 { static constexpr bool PERM = false;
    bf16_t* R; bf16_t* A2;
    DEVINL void operator()(const Acc& acc, const Unit& u, int wr, int wc, int fr, int fq) const {
        const int row0 = u.pm * BM + wr * 64 + fr;
#pragma unroll
        for (int ai = 0; ai < 2; ++ai)
#pragma unroll
            for (int m = 0; m < 4; ++m) { const size_t r = (size_t)(row0 + ai * HALF + m * 16);
#pragma unroll
                for (int bj = 0; bj < 2; ++bj)
#pragma unroll
                    for (int n = 0; n < 2; ++n) { f32x4 v = acc[ai][bj][m][n]; const int c = bj * HALF + wc * 32 + n * 16 + fq * 4;
                        if (u.pn < 12) { st_bf4(R + (size_t)(u.pn >> 2) * NTOK * DM + r * DM + (u.pn & 3) * 256 + c, v); }
                        else if (u.pn == 12) { if (bj == 0) {
#pragma unroll
                                for (int j = 0; j < 4; ++j) { const float ee = __expf(-2.f * fabsf(v[j])); const float th = (1.f - ee) / (1.f + ee); v[j] = v[j] < 0.f ? -th : th; } }
                            st_bf4(A2 + r * 512 + c, v); }
                        else {
#pragma unroll
                            for (int j = 0; j < 4; ++j) v[j] = (c + j < 160) ? sigm_f(v[j]) : 0.f;
                            st_bf4(A2 + r * 512 + 256 + c, v); } } }
    }
};
template <int mode> struct EpiRwkv2 { static constexpr bool PERM = true;
    bf16_t* O; const float* bias;
    DEVINL void operator()(const Acc& acc, const Unit& u, int wr, int wc, int fr, int fq) const {
        const int row0 = u.pm * BM + wr * 64 + fr, e = u.pn >> 2, d0 = (u.pn & 3) * 256 + wc * 32 + 8 * fq;
#pragma unroll
        for (int ai = 0; ai < 2; ++ai)
#pragma unroll
            for (int m = 0; m < 4; ++m) { bf16_t* rowp = O + (size_t)e * NTOK * DM + (size_t)(row0 + ai * HALF + m * 16) * DM + d0;
#pragma unroll
                for (int bj = 0; bj < 2; ++bj) { const int d = d0 + bj * HALF;
                    st_bf8(rowp + bj * HALF, acc[ai][bj][m][0] + *(const f32x4*)(bias + e * DM + d), acc[ai][bj][m][1] + *(const f32x4*)(bias + e * DM + d + 4)); } }
    }
};

DEVINL void convT(float* tile, const float* src, int ldsrc, int K, int N, bf16_t* dst, int ldd, int drow0, int dcol0, const float* rs, int rdiv, int rmul, int bid = -1, int nb = 0) {
    const int tid = otid(), tK = (K + 63) / 64, tN = (N + 63) / 64;
    if (bid < 0) { bid = obid(); nb = gridDim.x; }
    for (int t = bid; t < tK * tN; t += nb) {
        const int k0 = (t / tN) * 64, n0 = (t % tN) * 64;
        __syncthreads();
#pragma unroll
        for (int p = 0; p < 8; ++p) { const int i = (tid >> 6) + 8 * p, j = tid & 63; float v = 0.f;
            if (k0 + i < K && n0 + j < N) { v = src[(size_t)(k0 + i) * ldsrc + n0 + j]; if (rs) v *= rs[k0 + i]; }
            tile[i * 65 + j] = v; }
        __syncthreads();
#pragma unroll
        for (int p = 0; p < 4; ++p) { const int j = (tid >> 5) + 16 * p, i = (tid & 31) * 2, n = n0 + j;
            if (n < N && k0 + i < K) { const int row = (n / rdiv) * rmul + (n % rdiv) + drow0;
                *(unsigned*)(dst + (size_t)row * ldd + dcol0 + k0 + i) = pk2(tile[i * 65 + j], tile[(i + 1) * 65 + j]); } }
    }
}
DEVINL void zero2d(bf16_t* dst, int ld, int r0, int r1, int c0, int c1, int bid = -1, int nb = 0) {
    const int w = (c1 - c0) / 2, n = (r1 - r0) * w;
    if (bid < 0) { bid = obid(); nb = gridDim.x; }
    for (int i = bid * 512 + otid(); i < n; i += nb * 512) { const int r = r0 + i / w, c = c0 + (i % w) * 2; *(unsigned*)(dst + (size_t)r * ld + c) = 0u; }
}
DEVINL void conv_ffn_w(float* tile, const PV& p, int layer, int w, bf16_t* slot, int bid, int nb) {
    const size_t o = (size_t)(layer * 2 + w) * DM * DFF;
    bf16_t* gu = slot + w * (FFN_WGU + FFN_WD); bf16_t* wd = gu + FFN_WGU;
    convT(tile, p.in(8) + o, DFF, DM, DFF, gu, DM, 0, 0, nullptr, 128, 256, bid, nb);
    convT(tile, p.in(9) + o, DFF, DM, DFF, gu, DM, 128, 0, nullptr, 128, 256, bid, nb);
    convT(tile, p.in(10) + o, DM, DFF, DM, wd, DFF, 0, 0, nullptr, 1 << 30, 0, bid, nb);
}
DEVINL void conv_ffn(float* tile, const PV& p, int layer, bf16_t* slot) { conv_ffn_w(tile, p, layer, 0, slot, obid(), gridDim.x); conv_ffn_w(tile, p, layer, 1, slot, obid(), gridDim.x); }

DEVINL void phase_prep(const PV& p, unsigned char* sm) {
    const int tid = otid(), wid = tid >> 6, lane = tid & 63;
    unsigned char* ws = p.ws;
    float* tile = (float*)sm;
    bf16_t* WM = (bf16_t*)(ws + WS_WM);
    {
        float* sc = (float*)sm; float* part = sc + 9 * 1024;
        for (int i = tid; i < 9 * 1024; i += 512) { const float v = i < 8192 ? p.in(1)[i] : p.in(3)[i - 8192]; sc[i] = silu_f(v); }
        __syncthreads();
        float* MOD = (float*)(ws + WS_MOD);
        for (int it = obid(); it < 4 * 144; it += gridDim.x) {
            const int layer = it / 144, col = (it % 144) * 64 + lane;
            const float* W = p.in(4) + (size_t)layer * DM * MODW + col;
            float a[9];
#pragma unroll
            for (int r = 0; r < 9; ++r) a[r] = 0.f;
            const int kb = wid * 128;
#pragma unroll 16
            for (int k = 0; k < 128; ++k) { const float w = W[(size_t)(kb + k) * MODW];
#pragma unroll
                for (int r = 0; r < 9; ++r) a[r] += sc[r * 1024 + kb + k] * w; }
#pragma unroll
            for (int r = 0; r < 9; ++r) part[(wid * 9 + r) * 64 + lane] = a[r];
            __syncthreads();
            for (int o = tid; o < 9 * 64; o += 512) { const int r = o >> 6, l = o & 63; float s = 0.f;
#pragma unroll
                for (int w = 0; w < 8; ++w) s += part[(w * 9 + r) * 64 + l];
                const int c = (it % 144) * 64 + l;
                MOD[((size_t)layer * 9 + r) * MODW + c] = s + p.in(5)[(size_t)layer * MODW + c]; }
            __syncthreads();
        }
    }
    { float* ct = (float*)(ws + WS_ROPE); float* st = ct + 1024;
      for (int i = obid() * 512 + tid; i < 1024; i += gridDim.x * 512) { const int pos = i >> 4, pp = i & 15;
          const float inv = exp2f(-(float)pp * (13.287712379549449f / 16.f)); const float ang = (float)pos * inv; ct[i] = cosf(ang); st[i] = sinf(ang); } }
    conv_ffn(tile, p, 0, (bf16_t*)(ws + WS_WF));
    for (int j = 0; j < 1; ++j) {
        bf16_t* M = WM + (j ? WM_MLA1 : WM_MLA0);
        convT(tile, p.in(11) + (size_t)j * 1024 * 512, 512, 1024, 512, M + MLA_DQKV, 1024, 0, 0, nullptr, 1 << 30, 0);
        convT(tile, p.in(14) + (size_t)j * 1024 * 320, 320, 1024, 320, M + MLA_DQKV, 1024, 512, 0, nullptr, 1 << 30, 0);
        zero2d(M + MLA_DQKV, 1024, 832, 1024, 0, 1024);
        convT(tile, p.in(13) + (size_t)j * 512 * 1536, 1536, 512, 1536, M + MLA_UQ, 512, 0, 0, nullptr, 1 << 30, 0);
        convT(tile, p.in(16) + (size_t)j * 256 * 2048, 2048, 256, 2048, M + MLA_UKV, 256, 0, 0, nullptr, 1 << 30, 0);
        convT(tile, p.in(17) + (size_t)j * 1024 * 1024, 1024, 1024, 1024, M + MLA_WO, 1024, 0, 0, nullptr, 1 << 30, 0);
    }
    __syncthreads();
}

DEVINL void prep_late(const PV& p, unsigned char* sm, int bid, int nb) {
    const int tid = otid(), wid = tid >> 6, lane = tid & 63;
    unsigned char* ws = p.ws;
    float* tile = (float*)sm;
    bf16_t* WM = (bf16_t*)(ws + WS_WM);
    (void)wid; (void)lane;
    { bf16_t* DT = WM + WM_DT2;
      for (size_t i = (size_t)bid * 512 + tid; i < (size_t)4096 * 1024; i += (size_t)nb * 512) {
          const int row = (int)(i >> 10), t = (int)(i & 1023) * 2, cs = row >> 11, to = row & 2047;
          float v[2];
#pragma unroll
          for (int q = 0; q < 2; ++q) { const int mm = (to * (t + q)) & 2047; const float x = (float)mm * (1.f / 1024.f); v[q] = (cs ? sinpif(x) : cospif(x)) * 0.022097086912079608f; }
          *(unsigned*)(DT + (size_t)row * 2048 + t) = pk2(v[0], v[1]); }
      bf16_t* DC = WM + WM_DT2C;
      for (int i = bid * 512 + tid; i < 512 * 128; i += nb * 512) {
          const int row = i >> 7, t = (i & 127) * 2, cs = row >> 8, to = row & 255;
          float v[2];
#pragma unroll
          for (int q = 0; q < 2; ++q) { const int mm = (to * (t + q)) & 255; const float x = (float)mm * (1.f / 128.f); v[q] = (cs ? sinpif(x) : cospif(x)) * 0.0625f; }
          *(unsigned*)(DC + (size_t)row * 256 + t) = pk2(v[0], v[1]); } }
    {
        __syncthreads();
        float* ctab = (float*)sm; float* stab = ctab + 128; float* wt = ctab + 256;
        if (tid < 128) { const float x = (float)tid * (1.f / 64.f); ctab[tid] = cospif(x) * 0.08838834764831845f; stab[tid] = -sinpif(x) * 0.08838834764831845f; }
        bf16_t* W2 = WM + WM_W2T; const float* wo = p.in(18);
        for (int it = bid; it < 128; it += nb) {
            const int g = it >> 4, n0 = (it & 15) * 64;
            __syncthreads();
            for (int q = tid; q < 128 * 64; q += 512) wt[q] = wo[(size_t)(g * 128 + (q >> 6)) * DM + n0 + (q & 63)];
            __syncthreads();
            const int k = tid & 127, cs = (tid >> 7) & 1, ng = tid >> 8; const float* tab = cs ? stab : ctab;
            float acc[32];
#pragma unroll
            for (int q = 0; q < 32; ++q) acc[q] = 0.f;
            for (int j = 0; j < 128; ++j) { const float t = tab[(k * j) & 127]; const float* wr = wt + j * 64 + ng * 32;
#pragma unroll
                for (int q = 0; q < 32; q += 4) { const f32x4 w4 = *(const f32x4*)(wr + q); acc[q] += t * w4[0]; acc[q + 1] += t * w4[1]; acc[q + 2] += t * w4[2]; acc[q + 3] += t * w4[3]; } }
#pragma unroll
            for (int q = 0; q < 32; ++q) W2[(size_t)(n0 + ng * 32 + q) * 2048 + cs * 1024 + g * 128 + k] = f2bf(acc[q]);
        }
        __syncthreads();
    }
    for (int j = 1; j < 2; ++j) {
        bf16_t* M = WM + (j ? WM_MLA1 : WM_MLA0);
        convT(tile, p.in(11) + (size_t)j * 1024 * 512, 512, 1024, 512, M + MLA_DQKV, 1024, 0, 0, nullptr, 1 << 30, 0, bid, nb);
        convT(tile, p.in(14) + (size_t)j * 1024 * 320, 320, 1024, 320, M + MLA_DQKV, 1024, 512, 0, nullptr, 1 << 30, 0, bid, nb);
        zero2d(M + MLA_DQKV, 1024, 832, 1024, 0, 1024, bid, nb);
        convT(tile, p.in(13) + (size_t)j * 512 * 1536, 1536, 512, 1536, M + MLA_UQ, 512, 0, 0, nullptr, 1 << 30, 0, bid, nb);
        convT(tile, p.in(16) + (size_t)j * 256 * 2048, 2048, 256, 2048, M + MLA_UKV, 256, 0, 0, nullptr, 1 << 30, 0, bid, nb);
        convT(tile, p.in(17) + (size_t)j * 1024 * 1024, 1024, 1024, 1024, M + MLA_WO, 1024, 0, 0, nullptr, 1 << 30, 0, bid, nb);
    }
    {
        bf16_t* WC = WM + WM_WCAT; const float* mix = p.in(20);
        for (int h = 0; h < 2; ++h) { const int dc = h * 1024;
            convT(tile, p.in(21), 1024, 1024, 1024, WC, 2048, 0, dc, h ? mix + 0 * 1024 : nullptr, 1 << 30, 0, bid, nb);
            convT(tile, p.in(22), 1024, 1024, 1024, WC, 2048, 1024, dc, h ? mix + 2 * 1024 : nullptr, 1 << 30, 0, bid, nb);
            convT(tile, p.in(23), 1024, 1024, 1024, WC, 2048, 2048, dc, h ? mix + 3 * 1024 : nullptr, 1 << 30, 0, bid, nb);
            for (int e = 0; e < 2; ++e) {
                convT(tile, p.in(25) + (size_t)e * 1024 * 64, 64, 1024, 64, WC, 2048, 3072 + e * 64, dc, h ? mix + 1 * 1024 : nullptr, 1 << 30, 0, bid, nb);
                convT(tile, p.in(28) + (size_t)e * 1024 * 64, 64, 1024, 64, WC, 2048, 3200 + e * 64, dc, h ? mix + 4 * 1024 : nullptr, 1 << 30, 0, bid, nb); }
            convT(tile, p.in(30), 160, 1024, 160, WC, 2048, 3328, dc, h ? mix + 5 * 1024 : nullptr, 1 << 30, 0, bid, nb); }
        zero2d(WC, 2048, 3488, 3584, 0, 2048, bid, nb);
        bf16_t* BW = WM + WM_BW; bf16_t* BA = WM + WM_BA; bf16_t* BG = WM + WM_BG;
        for (int e = 0; e < 2; ++e) {
            convT(tile, p.in(26) + (size_t)e * 64 * 1024, 1024, 64, 1024, BW, 256, e * 1024, e * 64, nullptr, 1 << 30, 0, bid, nb);
            convT(tile, p.in(29) + (size_t)e * 64 * 1024, 1024, 64, 1024, BA, 256, e * 1024, 128 + e * 64, nullptr, 1 << 30, 0, bid, nb);
            zero2d(BW, 256, e * 1024, e * 1024 + 1024, (1 - e) * 64, (1 - e) * 64 + 64, bid, nb); zero2d(BW, 256, e * 1024, e * 1024 + 1024, 128, 256, bid, nb);
            zero2d(BA, 256, e * 1024, e * 1024 + 1024, 128 + (1 - e) * 64, 128 + (1 - e) * 64 + 64, bid, nb); zero2d(BA, 256, e * 1024, e * 1024 + 1024, 0, 128, bid, nb); }
        convT(tile, p.in(31), 1024, 160, 1024, BG, 256, 0, 0, nullptr, 1 << 30, 0, bid, nb);
        zero2d(BG, 256, 0, 1024, 160, 256, bid, nb);
        convT(tile, p.in(37), 1024, 1024, 1024, WM + WM_RWO, 1024, 0, 0, nullptr, 1 << 30, 0, bid, nb);
    }
    __syncthreads();
}

struct RowArgs {
    const float* hin_l; const float* hin_c; float* hout_l; float* hout_c;
    const float* Y; const float* modp; int subp; const float* gpost; float coef;
    const float* modn; int subn; const float* gpre;
    bf16_t* xn; int xn_ld; int nrows; int upd_ctx; const float* Ys; int nslab;
    int pad_;
};
struct RowIn { f32x4 h[4], y[4]; };
DEVINL void row_load(const RowArgs& a, int r, int lane, RowIn& v) {
    const bool lat = r < NLAT; const int rc = r - NLAT;
    const float* hin = lat ? a.hin_l + (size_t)r * DM : a.hin_c + (size_t)rc * DM;
#pragma unroll
    for (int i = 0; i < 4; ++i) v.h[i] = *(const f32x4*)(hin + i * 256 + lane * 4);
    if (a.Y != nullptr && (lat || a.upd_ctx)) {
        if (lat || a.nslab == 0) {
#pragma unroll
            for (int i = 0; i < 4; ++i) { const u32x2 w = *(const u32x2*)((const bf16_t*)a.Y + (size_t)r * DM + i * 256 + lane * 4); v.y[i] = (f32x4){lo_bf(w.x), hi_bf(w.x), lo_bf(w.y), hi_bf(w.y)}; }
        } else {
#pragma unroll
            for (int i = 0; i < 4; ++i) v.y[i] = *(const f32x4*)(a.Ys + (size_t)rc * DM + i * 256 + lane * 4);
            for (int sl = 1; sl < a.nslab; ++sl) {
#pragma unroll
                for (int i = 0; i < 4; ++i) v.y[i] += *(const f32x4*)(a.Ys + ((size_t)sl * NCTX + rc) * DM + i * 256 + lane * 4); }
        }
    }
}
DEVINL void row_math(const RowArgs& a, int r, int lane, RowIn& v, f32x4 (&xo)[4]) {
    const bool lat = r < NLAT; const int rc = r - NLAT; const int mrow = lat ? (r >> 11) : 8;
    const float* hin = lat ? a.hin_l + (size_t)r * DM : a.hin_c + (size_t)rc * DM;
    float* hout = lat ? a.hout_l + (size_t)r * DM : a.hout_c + (size_t)rc * DM;
    const bool upd = a.Y != nullptr && (lat || a.upd_ctx);
    if (upd) {
        float ss = 0.f;
#pragma unroll
        for (int i = 0; i < 4; ++i)
#pragma unroll
            for (int j = 0; j < 4; ++j) ss += v.y[i][j] * v.y[i][j];
        ss = wave_sum_dpp(ss); const float rs = rsqrtf(ss * (1.f / 1024.f) + EPS) * a.coef;
        const float* gate = a.modp + (size_t)mrow * MODW + (a.subp * 3 + 2) * 1024;
#pragma unroll
        for (int i = 0; i < 4; ++i) { const int c = i * 256 + lane * 4; const f32x4 gt = *(const f32x4*)(gate + c), gp = *(const f32x4*)(a.gpost + c);
            v.h[i] += gt * (v.y[i] * gp) * rs; }
    }
    if (upd || hin != hout) {
#pragma unroll
        for (int i = 0; i < 4; ++i) *(f32x4*)(hout + i * 256 + lane * 4) = v.h[i];
    }
    if (a.modn) {
        float ss = 0.f;
#pragma unroll
        for (int i = 0; i < 4; ++i)
#pragma unroll
            for (int j = 0; j < 4; ++j) ss += v.h[i][j] * v.h[i][j];
        ss = wave_sum_dpp(ss); const float rs = rsqrtf(ss * (1.f / 1024.f) + EPS);
        const float* sh = a.modn + (size_t)mrow * MODW + (a.subn * 3 + 0) * 1024; const float* scl = sh + 1024;
#pragma unroll
        for (int i = 0; i < 4; ++i) { const int c = i * 256 + lane * 4; const f32x4 g = *(const f32x4*)(a.gpre + c), s1 = *(const f32x4*)(scl + c), s0 = *(const f32x4*)(sh + c);
            xo[i] = (v.h[i] * rs * g) * (s1 + 1.f) + s0; }
    }
}
DEVINL void row_core(const RowArgs& a, int r, int lane, f32x4 (&xo)[4]) { RowIn v; row_load(a, r, lane, v); row_math(a, r, lane, v, xo); }
DEVINL void phase_rows(const RowArgs& a) {
    const int lane = otid() & 63, gw = obid() * 8 + (otid() >> 6), nw = gridDim.x * 8;
    RowIn cur, n1, n2;
    if (gw < a.nrows) row_load(a, gw, lane, cur);
    if (gw + nw < a.nrows) row_load(a, gw + nw, lane, n1);
    for (int r = gw; r < a.nrows; r += nw) {
        if (r + 2 * nw < a.nrows) row_load(a, r + 2 * nw, lane, n2);
        f32x4 xo[4]; row_math(a, r, lane, cur, xo);
        if (a.modn) {
#pragma unroll
            for (int i = 0; i < 4; ++i) st_bf4(a.xn + (size_t)r * a.xn_ld + i * 256 + lane * 4, xo[i]);
        }
        cur = n1; n1 = n2;
    }
}
DEVINL void phase_rows_T(const RowArgs& a, unsigned char* sm, bf16_t* XT, bf16_t* XTc) {
    const int tid = otid(), wid = tid >> 6, lane = tid & 63;
    constexpr int RS = 2052;
    for (int tl = obid(); tl < NTOK / 64; tl += gridDim.x) {
        __syncthreads();
        RowIn cur, nxt; row_load(a, tl * 64 + wid * 8, lane, cur);
        for (int q = 0; q < 8; ++q) { const int lr = wid * 8 + q, r = tl * 64 + lr; f32x4 xo[4];
            if (q < 7) row_load(a, r + 1, lane, nxt);
            row_math(a, r, lane, cur, xo); cur = nxt;
#pragma unroll
            for (int i = 0; i < 4; ++i) { u32x2 w; w.x = pk2(xo[i][0], xo[i][1]); w.y = pk2(xo[i][2], xo[i][3]);
                unsigned* dp = (unsigned*)(sm + lr * RS + (i * 256 + lane * 4) * 2); dp[0] = w.x; dp[1] = w.y; } }
        __syncthreads();
        const int r0 = tl * 64; const bool lat = r0 < NLAT; const int b = lat ? (r0 >> 11) : ((r0 - NLAT) >> 8), t0 = lat ? (r0 & 2047) : ((r0 - NLAT) & 255), T = lat ? 2048 : 256;
        bf16_t* dstb = (lat ? XT : XTc) + (size_t)b * 1024 * T + t0;
        for (int it = tid; it < 1024 * 8; it += 512) { const int d = it >> 3, tc = it & 7; unsigned w[4];
#pragma unroll
            for (int q = 0; q < 4; ++q) { const unsigned lo = *(const bf16_t*)(sm + (tc * 8 + q * 2) * RS + d * 2), hi = *(const bf16_t*)(sm + (tc * 8 + q * 2 + 1) * RS + d * 2); w[q] = lo | (hi << 16); }
            *(u32x4*)(dstb + (size_t)d * T + tc * 8) = (u32x4){w[0], w[1], w[2], w[3]}; }
    }
    __syncthreads();
}

DEVINL void phase_mla_norm(const PV& p, int j, const float* raw, bf16_t* QN, bf16_t* CKVN, bf16_t* Kb) {
    const int lane = otid() & 63, gw = obid() * 8 + (otid() >> 6), nw = gridDim.x * 8;
    const float* qg = p.in(12) + j * 512; const float* kg = p.in(15) + j * 256;
    const float* ct = (const float*)(p.ws + WS_ROPE); const float* st = ct + 1024;
    for (int r = gw; r < NTOK; r += nw) {
        const float* row = raw + (size_t)r * 1024;
        f32x4 q0 = *(const f32x4*)(row + lane * 4), q1 = *(const f32x4*)(row + 256 + lane * 4), kv = *(const f32x4*)(row + 512 + lane * 4);
        const float kp = row[768 + lane];
        float sq = 0.f, sk = 0.f;
#pragma unroll
        for (int i = 0; i < 4; ++i) { sq += q0[i] * q0[i] + q1[i] * q1[i]; sk += kv[i] * kv[i]; }
        sq = wave_sum_dpp(sq); sk = wave_sum_dpp(sk);
        const float rq = rsqrtf(sq * (1.f / 512.f) + EPS), rk = rsqrtf(sk * (1.f / 256.f) + EPS);
        st_bf4(QN + (size_t)r * 512 + lane * 4, q0 * rq * *(const f32x4*)(qg + lane * 4));
        st_bf4(QN + (size_t)r * 512 + 256 + lane * 4, q1 * rq * *(const f32x4*)(qg + 256 + lane * 4));
        st_bf4(CKVN + (size_t)r * 256 + lane * 4, kv * rk * *(const f32x4*)(kg + lane * 4));
        int b, tk; bool lat; tok_of_row(r, b, tk, lat);
        const float other = __shfl_xor(kp, 16); float o = kp;
        if (lat) { const int axis = lane >> 5, half = (lane >> 4) & 1, pp = lane & 15, pos = axis == 0 ? (tk >> 6) : (tk & 63);
            const float c = ct[pos * 16 + pp], s = st[pos * 16 + pp];
            o = half == 0 ? kp * c - other * s : kp * c + other * s; }
        const bf16_t ob = f2bf(o);
#pragma unroll
        for (int h = 0; h < 8; ++h) Kb[((size_t)(b * 8 + h) * TKV + tk) * 192 + 128 + lane] = ob;
    }
}

constexpr int QBLK = 32, KVBLK = 64, NW = 8;
constexpr float ATT_SCALE = 0.07216878364870322f;
constexpr float ATT_THR = 8.f;
constexpr size_t SHM_V = KVBLK * 128 * 2, SHM_K = KVBLK * 192 * 2;
#define KSWZ(row, colB) ((row) * 384 + ((colB) ^ ((((row) >> 1) & 7) << 4)))
#define SBAR() __builtin_amdgcn_sched_barrier(0)
DEVINL int crow(int r, int hi) { return (r & 3) + 8 * (r >> 2) + 4 * hi; }
DEVINL void partialSM(f32x16& p0, f32x16& p1, float& m_reg, float& mn, float& alpha) {
    constexpr float C = ATT_SCALE * 1.4426950408889634f;
    float pmax = p0[0];
#pragma unroll
    for (int r = 1; r < 16; ++r) pmax = fmaxf(pmax, p0[r]);
#pragma unroll
    for (int r = 0; r < 16; ++r) pmax = fmaxf(pmax, p1[r]);
    { auto rr = __builtin_amdgcn_permlane32_swap(__float_as_uint(pmax), __float_as_uint(pmax), false, false);
      pmax = fmaxf(__uint_as_float(rr[0]), __uint_as_float(rr[1])); }
    if (__builtin_expect(__all(pmax - m_reg <= ATT_THR / ATT_SCALE), 1)) { mn = m_reg; alpha = 1.f; }
    else { mn = fmaxf(m_reg, pmax); alpha = __builtin_amdgcn_exp2f((m_reg - mn) * C); m_reg = mn; }
    const float mnC = -mn * C;
#pragma unroll
    for (int r = 0; r < 16; ++r) p0[r] = fmaf(p0[r], C, mnC);
#pragma unroll
    for (int r = 0; r < 16; ++r) p1[r] = fmaf(p1[r], C, mnC);
#pragma unroll
    for (int r = 0; r < 16; ++r) p0[r] = __builtin_amdgcn_exp2f(p0[r]);
}
DEVINL void finishSM(f32x16& p0, f32x16& p1, float alpha, float& l_reg, bf16x8& pa0, bf16x8& pa1, bf16x8& pa2, bf16x8& pa3) {
#pragma unroll
    for (int r = 0; r < 16; ++r) p1[r] = __builtin_amdgcn_exp2f(p1[r]);
    float ps = 0;
#pragma unroll
    for (int r = 0; r < 16; ++r) ps += p0[r];
#pragma unroll
    for (int r = 0; r < 16; ++r) ps += p1[r];
    { auto rr = __builtin_amdgcn_permlane32_swap(__float_as_uint(ps), __float_as_uint(ps), false, false);
      ps = __uint_as_float(rr[0]) + __uint_as_float(rr[1]); }
    l_reg = l_reg * alpha + ps;
#define PK4(P, BASE, OUT) do { unsigned a0 = pk2(P[BASE + 0], P[BASE + 1]), a1 = pk2(P[BASE + 2], P[BASE + 3]);   \
    unsigned b0 = pk2(P[BASE + 4], P[BASE + 5]), b1 = pk2(P[BASE + 6], P[BASE + 7]);                              \
    auto r0 = __builtin_amdgcn_permlane32_swap(a0, b0, false, false); auto r1 = __builtin_amdgcn_permlane32_swap(a1, b1, false, false); \
    u32x4 w = {r0[0], r1[0], r0[1], r1[1]}; OUT = *reinterpret_cast<bf16x8*>(&w); } while (0)
    PK4(p0, 0, pa0); PK4(p0, 8, pa1); PK4(p1, 0, pa2); PK4(p1, 8, pa3);
#undef PK4
}
DEVINL void qkt(f32x16& p0, f32x16& p1, const char* Ks, const bf16x8* qr, const char* qpe, int qsw, int r32, int hi) {
    p0 = f32x16{}; p1 = f32x16{};
#pragma unroll
    for (int d0 = 0; d0 < 12; ++d0) { const int cb = (d0 * 16 + hi * 8) * 2;
        const bf16x8 b0 = *reinterpret_cast<const bf16x8*>(Ks + KSWZ(r32, cb));
        const bf16x8 b1 = *reinterpret_cast<const bf16x8*>(Ks + KSWZ(32 + r32, cb));
        const bf16x8 q = d0 < 8 ? qr[d0 < 8 ? d0 : 0] : *reinterpret_cast<const bf16x8*>(qpe + (((((d0 - 8) * 2 + hi) ^ qsw) & 7) << 4));
        p0 = __builtin_amdgcn_mfma_f32_32x32x16_bf16(b0, q, p0, 0, 0, 0);
        p1 = __builtin_amdgcn_mfma_f32_32x32x16_bf16(b1, q, p1, 0, 0, 0); }
}
DEVINL int v_st(int k, int c) { const int kk = (k & ~0xC) | ((k & 4) << 1) | ((k & 8) >> 1); return ((kk >> 3) * 4 + (c >> 5)) * 512 + ((kk & 7) * 32 + (c & 31)) * 2; }
DEVINL int v_rd_base(int lane) { return ((lane & 3) << 3) | (((lane >> 2) & 3) << 6) | (((lane >> 4) & 1) << 5) | (((lane >> 5) & 1) << 8); }
constexpr int v_rd_off(int d0, int ks, int half) { return d0 * 512 + ks * 4096 + half * 2048; }
template <int OFF> DEVINL s16x4 tr_read(int vb) { s16x4 r; asm volatile("ds_read_b64_tr_b16 %0, %1 offset:%2" : "=&v"(r) : "v"(vb), "i"(OFF) : "memory"); return r; }
template <int D0> DEVINL void pv_one(f32x16& od, int vb, bf16x8 pa0, bf16x8 pa1, bf16x8 pa2, bf16x8 pa3) {
    const s16x4 l0 = tr_read<v_rd_off(D0, 0, 0)>(vb), h0 = tr_read<v_rd_off(D0, 0, 1)>(vb), l1 = tr_read<v_rd_off(D0, 1, 0)>(vb), h1 = tr_read<v_rd_off(D0, 1, 1)>(vb);
    const s16x4 l2 = tr_read<v_rd_off(D0, 2, 0)>(vb), h2 = tr_read<v_rd_off(D0, 2, 1)>(vb), l3 = tr_read<v_rd_off(D0, 3, 0)>(vb), h3 = tr_read<v_rd_off(D0, 3, 1)>(vb);
    asm volatile("s_waitcnt lgkmcnt(0)" ::: "memory"); SBAR();
#define PK(L, H) (bf16x8){L[0], L[1], L[2], L[3], H[0], H[1], H[2], H[3]}
    od = __builtin_amdgcn_mfma_f32_32x32x16_bf16(pa0, PK(l0, h0), od, 0, 0, 0);
    od = __builtin_amdgcn_mfma_f32_32x32x16_bf16(pa1, PK(l1, h1), od, 0, 0, 0);
    od = __builtin_amdgcn_mfma_f32_32x32x16_bf16(pa2, PK(l2, h2), od, 0, 0, 0);
    od = __builtin_amdgcn_mfma_f32_32x32x16_bf16(pa3, PK(l3, h3), od, 0, 0, 0);
#undef PK
}
DEVINL void pv_d0(f32x16* o, int vb, bf16x8 pa0, bf16x8 pa1, bf16x8 pa2, bf16x8 pa3) {
    pv_one<0>(o[0], vb, pa0, pa1, pa2, pa3); pv_one<1>(o[1], vb, pa0, pa1, pa2, pa3); pv_one<2>(o[2], vb, pa0, pa1, pa2, pa3); pv_one<3>(o[3], vb, pa0, pa1, pa2, pa3);
}
DEVINL void attn_body(const bf16_t* __restrict__ Qb, const bf16_t* __restrict__ Kh, const bf16_t* __restrict__ Vh, bf16_t* __restrict__ Ob, int seq, char* lds) {
    const int tid = otid(), wid = tid >> 6, lane = tid & 63, r32 = lane & 31, hi = lane >> 5;
    char* V_lds = lds; char* K_lds = lds + 2 * SHM_V;
    float* wsm = (float*)(lds + 2 * SHM_V + 2 * SHM_K) + wid * 64; float* li_l = wsm; float* al_l = wsm + 32;
    float m_reg = -1e30f, l_reg = 0; f32x16 o[4] = {}; bf16x8 qr[8];
    const bf16_t* Qw = Qb + (long)(wid * QBLK + r32) * 192 + hi * 8;
    char* qpe = lds + 2 * SHM_V + 2 * SHM_K + 2048 + wid * 4096 + r32 * 128; const int qsw = (r32 >> 1) & 7;
#pragma unroll
    for (int d0 = 0; d0 < 8; ++d0) qr[d0] = *reinterpret_cast<const bf16x8*>(Qw + d0 * 16);
#pragma unroll
    for (int d0 = 8; d0 < 12; ++d0) *reinterpret_cast<bf16x8*>(qpe + (((((d0 - 8) * 2 + hi) ^ qsw) & 7) << 4)) = *reinterpret_cast<const bf16x8*>(Qw + d0 * 16);
    const int sr = tid >> 4, sc = (tid & 15) * 8, vst0 = v_st(sr, sc), vst1 = v_st(32 + sr, sc);
    int kst[3];
#pragma unroll
    for (int i = 0; i < 3; ++i) { const int id = tid + 512 * i, row = id / 24, ch = id % 24; kst[i] = KSWZ(row, ch * 16); }
    const int vb0 = (int)(uintptr_t)V_lds + v_rd_base(lane);
    bf16x8 vs0, vs1, ks0, ks1, ks2;
#define SLOAD(k0) do { vs0 = *reinterpret_cast<const bf16x8*>(&Vh[(long)((k0) + sr) * 128 + sc]); vs1 = *reinterpret_cast<const bf16x8*>(&Vh[(long)((k0) + 32 + sr) * 128 + sc]); \
    const bf16_t* kp_ = Kh + (long)(k0) * 192 + tid * 8; ks0 = *reinterpret_cast<const bf16x8*>(kp_); ks1 = *reinterpret_cast<const bf16x8*>(kp_ + 4096); ks2 = *reinterpret_cast<const bf16x8*>(kp_ + 8192); } while (0)
#define SWRITE(b) do { *(bf16x8*)(V_lds + (b) * SHM_V + vst0) = vs0; *(bf16x8*)(V_lds + (b) * SHM_V + vst1) = vs1; \
    *(bf16x8*)(K_lds + (b) * SHM_K + kst[0]) = ks0; *(bf16x8*)(K_lds + (b) * SHM_K + kst[1]) = ks1; *(bf16x8*)(K_lds + (b) * SHM_K + kst[2]) = ks2; } while (0)
#define RESC(a) do { if (__any((a) < 1.f)) { if (hi == 0) al_l[r32] = (a); asm volatile("s_waitcnt lgkmcnt(0)" ::: "memory"); \
    _Pragma("unroll") for (int d = 0; d < 4; ++d) _Pragma("unroll") for (int r = 0; r < 16; ++r) o[d][r] *= al_l[crow(r, hi)]; } } while (0)
    f32x16 pA0, pA1, pB0, pB1; float mnA, mnB, alA, alB; bf16x8 pa0, pa1, pa2, pa3; const int NT = seq / KVBLK;
    __syncthreads();
    SLOAD(0); WAIT_V0(); SWRITE(0); __syncthreads();
    qkt(pA0, pA1, K_lds, qr, qpe, qsw, r32, hi); partialSM(pA0, pA1, m_reg, mnA, alA);
    SLOAD(KVBLK);
    WAIT_V0(); SWRITE(1); __syncthreads();
    for (int j = 1; j + 1 < NT; j += 2) {
        SBAR(); qkt(pB0, pB1, K_lds + SHM_K, qr, qpe, qsw, r32, hi);
        finishSM(pA0, pA1, alA, l_reg, pa0, pa1, pa2, pa3); SBAR();
        SLOAD((j + 1) * KVBLK); SBAR();
        pv_d0(o, vb0, pa0, pa1, pa2, pa3); partialSM(pB0, pB1, m_reg, mnB, alB);
        __syncthreads(); WAIT_V0(); SWRITE(0);
        RESC(alB); __syncthreads();
        SBAR(); qkt(pA0, pA1, K_lds, qr, qpe, qsw, r32, hi);
        finishSM(pB0, pB1, alB, l_reg, pa0, pa1, pa2, pa3); SBAR();
        SLOAD((j + 2) * KVBLK); SBAR();
        pv_d0(o, vb0 + (int)SHM_V, pa0, pa1, pa2, pa3); partialSM(pA0, pA1, m_reg, mnA, alA);
        __syncthreads(); WAIT_V0(); SWRITE(1);
        RESC(alA); __syncthreads();
    }
    SBAR(); qkt(pB0, pB1, K_lds + SHM_K, qr, qpe, qsw, r32, hi);
    finishSM(pA0, pA1, alA, l_reg, pa0, pa1, pa2, pa3); SBAR();
    pv_d0(o, vb0, pa0, pa1, pa2, pa3); partialSM(pB0, pB1, m_reg, mnB, alB);
    __syncthreads(); RESC(alB);
    finishSM(pB0, pB1, alB, l_reg, pa0, pa1, pa2, pa3); SBAR();
    pv_d0(o, vb0 + (int)SHM_V, pa0, pa1, pa2, pa3);
    if (hi == 0) li_l[r32] = l_reg; asm volatile("s_waitcnt lgkmcnt(0)" ::: "memory");
    float rli[16];
#pragma unroll
    for (int r = 0; r < 16; ++r) rli[r] = __builtin_amdgcn_rcpf(li_l[crow(r, hi)]);
    bf16_t* Ow = Ob + (long)(wid * QBLK) * 1024;
#pragma unroll
    for (int r = 0; r < 16; ++r) { const int orow = crow(r, hi);
#pragma unroll
        for (int d0 = 0; d0 < 4; ++d0) Ow[(long)orow * 1024 + d0 * 32 + r32] = f2bf(o[d0][r] * rli[r]); }
#undef SLOAD
#undef SWRITE
#undef RESC
}
DEVINL void phase_attn(const bf16_t* Q, const bf16_t* K, const bf16_t* V, bf16_t* O, bool with_ctx, char* lds) {
    const int nu = 512 + (with_ctx ? 64 : 0);
    for (int u = obid(); u < nu; u += gridDim.x) {
        if (u < 512) {
            int bh = u >> 3, qb = u & 7;
            if (gridDim.x == 256) { const int x = u & 7, l = (u >> 8) * 32 + ((u & 255) >> 3); bh = x * 8 + (l >> 3); qb = l & 7; }
            const int b = bh >> 3, h = bh & 7;
            attn_body(Q + ((size_t)bh * TKV + qb * 256) * 192, K + (size_t)bh * TKV * 192, V + (size_t)bh * TKV * 128, O + ((size_t)(b * SEQ + qb * 256)) * 1024 + h * 128, TKV, lds); }
        else { const int bh = u - 512, b = bh >> 3, h = bh & 7;
            attn_body(Q + ((size_t)bh * TKV + SEQ) * 192, K + ((size_t)bh * TKV + SEQ) * 192, V + ((size_t)bh * TKV + SEQ) * 128, O + ((size_t)(NLAT + b * CTX)) * 1024 + h * 128, CTX, lds); }
    }
    __syncthreads();
}

DEVINL void phase_rwkv_shift(bf16_t* XN) {
    for (size_t it = (size_t)obid() * 512 + otid(); it < (size_t)NTOK * 128; it += (size_t)gridDim.x * 512) {
        const int r = (int)(it >> 7), c = (int)(it & 127) * 8; int b, tk; bool lat; tok_of_row(r, b, tk, lat);
        const int t = lat ? tk : tk - SEQ, T = lat ? SEQ : CTX;
        const bf16_t* up = XN + (size_t)r * 2048 + c;
        const u32x4 u0 = *(const u32x4*)up; u32x4 um = {0, 0, 0, 0}, upl = {0, 0, 0, 0};
        if (t > 0) um = *(const u32x4*)(up - 2048);
        if (t < T - 1) upl = *(const u32x4*)(up + 2048);
        u32x4 o;
#pragma unroll
        for (int q = 0; q < 4; ++q) { const float a = 0.5f * (lo_bf(um[q]) + lo_bf(upl[q])) - lo_bf(u0[q]), bq = 0.5f * (hi_bf(um[q]) + hi_bf(upl[q])) - hi_bf(u0[q]); o[q] = pk2(a, bq); }
        *(u32x4*)(XN + (size_t)r * 2048 + 1024 + c) = o;
    }
}
DEVINL void zero_f32(float* p, size_t n4) { for (size_t i = (size_t)obid() * 512 + otid(); i < n4; i += (size_t)gridDim.x * 512) ((f32x4*)p)[i] = (f32x4){0.f, 0.f, 0.f, 0.f}; }

DEVINL float red8(float v) {
    v += __builtin_bit_cast(float, __builtin_amdgcn_update_dpp(0, __builtin_bit_cast(int, v), 0xB1, 0xF, 0xF, false));
    v += __builtin_bit_cast(float, __builtin_amdgcn_update_dpp(0, __builtin_bit_cast(int, v), 0x4E, 0xF, 0xF, false));
    v += __builtin_bit_cast(float, __builtin_amdgcn_update_dpp(0, __builtin_bit_cast(int, v), 0x141, 0xF, 0xF, false));
    return v;
}
typedef float f32x2 __attribute__((ext_vector_type(2)));
struct StepOps { f32x4 a0, a1, q0, q1, w0, w1, b0, b1, k0, k1; float viA, viB; f32x2 sc2; };
DEVINL void phase_scan(const PV& p, const bf16_t* R, const bf16_t* Kf, const bf16_t* Vf, const bf16_t* AA, const bf16_t* LW, float* Y0, bf16_t* Y1, unsigned char* sm) {
    constexpr int TC = 32, NCH = (CTX + SEQ) / TC;
    const int tid = otid(), wid = __builtin_amdgcn_readfirstlane(tid >> 6), lane = tid & 63;
    float* Fb = (float*)sm;
    float* ybb = Fb + 2 * TC * 384;
    float* sclb = ybb + 2 * TC * 64;
    const float* kkp = p.in(32); const float* kap = p.in(33);
    for (int it = obid(); it < 256; it += gridDim.x) {
        const int e = it >> 7, b = (it >> 4) & 7, h = it & 15, ch = h * 64 + lane;
        __syncthreads();
        if (wid >= 4) {
            const int hw = wid - 4;
            const float k_k = kkp[ch], k_a = kap[ch];
            const bf16_t* Ae = AA + (size_t)e * NTOK * DM; const bf16_t* Le = LW + (size_t)e * NTOK * DM;
            bf16_t pr[8], pk[8], pv[8], pa[8], pl[8];
#define SC_ROW(c_, s_) ({ const int g_ = (c_) * TC + (s_); const bool cx_ = g_ < CTX; const int sl_ = cx_ ? g_ : g_ - CTX, T_ = cx_ ? CTX : SEQ; \
            (cx_ ? NLAT + b * CTX : b * SEQ) + (e == 0 ? sl_ : T_ - 1 - sl_); })
#define SC_LOAD(c_) do { _Pragma("unroll") for (int q = 0; q < 8; ++q) { const size_t o_ = (size_t)SC_ROW(c_, hw + 4 * q) * DM + ch; \
            pr[q] = R[o_]; pk[q] = Kf[o_]; pv[q] = Vf[o_]; pa[q] = Ae[o_]; pl[q] = Le[o_]; } } while (0)
#define SC_DERIVE(c_) do { float* F_ = Fb + ((c_) & 1) * TC * 384; float* scl_ = sclb + ((c_) & 1) * TC * 2; _Pragma("unroll") for (int q = 0; q < 8; ++q) { const int s = hw + 4 * q; \
            const float r = bf2f(pr[q]), k = bf2f(pk[q]), v = bf2f(pv[q]), a = sigm_f(bf2f(pa[q])), nx = -bf2f(pl[q]); \
            const float sp = fmaxf(nx, 0.f) + __logf(1.f + __expf(-fabsf(nx))), w = __expf(-__expf(-sp - 0.5f)); \
            const float kv = k * k_k; const float n2 = wave_sum_dpp(kv * kv); const float kk = kv * __builtin_amdgcn_rsqf(fmaxf(n2, 1e-24f)); \
            const float bb = kk * a, kd = k * (1.f + (a - 1.f) * k_a); \
            const float br = wave_sum_dpp(bb * r), kr = wave_sum_dpp(kd * r); \
            float* f = F_ + s * 384 + lane; \
            f[0] = -kk; f[64] = bb; f[128] = w; f[192] = kd; f[256] = w * r; f[320] = v; \
            if (lane == 0) { scl_[s * 2] = br; scl_[s * 2 + 1] = kr; } } } while (0)
#define SC_FLUSH(c_) do { const float* yb_ = ybb + ((c_) & 1) * TC * 64; _Pragma("unroll") for (int q = 0; q < 8; ++q) { const int s = hw + 4 * q; const size_t o_ = (size_t)SC_ROW(c_, s) * DM + ch; \
            const float yv = yb_[s * 64 + lane]; if (e == 0) Y0[o_] = yv; else Y1[o_] = f2bf(yv); } } while (0)
            SC_LOAD(0); SC_DERIVE(0); SC_LOAD(1);
            __syncthreads();
            for (int c = 0; c < NCH; ++c) {
                if (c + 1 < NCH) { SC_DERIVE(c + 1); if (c + 2 < NCH) SC_LOAD(c + 2); }
                if (c >= 1) SC_FLUSH(c - 1);
                __syncthreads();
            }
            SC_FLUSH(NCH - 1);
#undef SC_LOAD
#undef SC_DERIVE
#undef SC_FLUSH
#undef SC_ROW
        } else {
            f32x2 SA[4], SB[4];
#pragma unroll
            for (int j = 0; j < 4; ++j) { SA[j] = (f32x2){0.f, 0.f}; SB[j] = (f32x2){0.f, 0.f}; }
            const int iA = wid * 16 + (lane >> 3), iB = iA + 8, cg8 = (lane & 7) * 8;
            __syncthreads();
            for (int c = 0; c < NCH; ++c) {
                const float* F = Fb + (c & 1) * TC * 384; float* yb = ybb + (c & 1) * TC * 64; const float* scl = sclb + (c & 1) * TC * 2;
#define ST_LD(o, s_) do { const float* f_ = F + (s_) * 384 + cg8; o.a0 = *(const f32x4*)(f_); o.a1 = *(const f32x4*)(f_ + 4); o.q0 = *(const f32x4*)(f_ + 256); o.q1 = *(const f32x4*)(f_ + 260); \
                o.w0 = *(const f32x4*)(f_ + 128); o.w1 = *(const f32x4*)(f_ + 132); o.b0 = *(const f32x4*)(f_ + 64); o.b1 = *(const f32x4*)(f_ + 68); o.k0 = *(const f32x4*)(f_ + 192); o.k1 = *(const f32x4*)(f_ + 196); \
                o.viA = F[(s_) * 384 + 320 + iA]; o.viB = F[(s_) * 384 + 320 + iB]; o.sc2 = *(const f32x2*)(scl + (s_) * 2); } while (0)
#define P2(v, i) (f32x2){v[i], v[i + 1]}
#define ST_ROW(o, S, vi, irow, s_) do { \
                f32x2 da = S[0] * P2(o.a0, 0), dq = S[0] * P2(o.q0, 0); da += S[1] * P2(o.a0, 2); dq += S[1] * P2(o.q0, 2); \
                da += S[2] * P2(o.a1, 0); dq += S[2] * P2(o.q1, 0); da += S[3] * P2(o.a1, 2); dq += S[3] * P2(o.q1, 2); \
                float sa = da[0] + da[1], sy = dq[0] + dq[1]; \
                sa += DPPF(sa, 0xB1); sy += DPPF(sy, 0xB1); sa += DPPF(sa, 0x4E); sy += DPPF(sy, 0x4E); sa += DPPF(sa, 0x141); sy += DPPF(sy, 0x141); \
                const f32x2 sa2 = {sa, sa}, vi2 = {vi, vi}; \
                S[0] = S[0] * P2(o.w0, 0) + sa2 * P2(o.b0, 0) + vi2 * P2(o.k0, 0); S[1] = S[1] * P2(o.w0, 2) + sa2 * P2(o.b0, 2) + vi2 * P2(o.k0, 2); \
                S[2] = S[2] * P2(o.w1, 0) + sa2 * P2(o.b1, 0) + vi2 * P2(o.k1, 0); S[3] = S[3] * P2(o.w1, 2) + sa2 * P2(o.b1, 2) + vi2 * P2(o.k1, 2); \
                yb[(s_) * 64 + irow] = sy + sa * o.sc2[0] + vi * o.sc2[1]; } while (0)
                StepOps X, Z; ST_LD(X, 0);
#pragma unroll
                for (int s = 0; s < TC; s += 2) {
                    ST_LD(Z, s + 1);
                    ST_ROW(X, SA, X.viA, iA, s); ST_ROW(X, SB, X.viB, iB, s);
                    ST_LD(X, s + 2);
                    ST_ROW(Z, SA, Z.viA, iA, s + 1); ST_ROW(Z, SB, Z.viB, iB, s + 1);
                }
#undef ST_LD
#undef ST_ROW
#undef P2
                __syncthreads();
            }
        }
    }
    __syncthreads();
}
DEVINL void phase_rwkv_out(const PV& p, const float* Y, const bf16_t* Y1, const bf16_t* R, const bf16_t* Kf, const bf16_t* Vf, const bf16_t* AA, const bf16_t* Gg, bf16_t* XO) {
    const int lane = otid() & 63, gw = obid() * 8 + (otid() >> 6), nw = gridDim.x * 8;
    const float* k_a = p.in(33); const float* r_k = p.in(34); const float* lnw = p.in(35); const float* lnb = p.in(36);
    for (int r = gw; r < NTOK; r += nw) {
#pragma unroll
        for (int i = 0; i < 4; ++i) { const int c = i * 256 + lane * 4; const size_t o = (size_t)r * DM + c;
            const u32x2 y1w = *(const u32x2*)(Y1 + o);
            const f32x4 y = *(const f32x4*)(Y + o) + (f32x4){lo_bf(y1w.x), hi_bf(y1w.x), lo_bf(y1w.y), hi_bf(y1w.y)};
            const u32x2 rw = *(const u32x2*)(R + o), kw = *(const u32x2*)(Kf + o), vw = *(const u32x2*)(Vf + o), a0w = *(const u32x2*)(AA + o), a1w = *(const u32x2*)(AA + (size_t)NTOK * DM + o), gw2 = *(const u32x2*)(Gg + o);
            const f32x4 rr = {lo_bf(rw.x), hi_bf(rw.x), lo_bf(rw.y), hi_bf(rw.y)}, kk = {lo_bf(kw.x), hi_bf(kw.x), lo_bf(kw.y), hi_bf(kw.y)}, vv = {lo_bf(vw.x), hi_bf(vw.x), lo_bf(vw.y), hi_bf(vw.y)};
            const f32x4 a0 = {sigm_f(lo_bf(a0w.x)), sigm_f(hi_bf(a0w.x)), sigm_f(lo_bf(a0w.y)), sigm_f(hi_bf(a0w.y))}, a1 = {sigm_f(lo_bf(a1w.x)), sigm_f(hi_bf(a1w.x)), sigm_f(lo_bf(a1w.y)), sigm_f(hi_bf(a1w.y))}, gg = {lo_bf(gw2.x), hi_bf(gw2.x), lo_bf(gw2.y), hi_bf(gw2.y)};
            const f32x4 ka = *(const f32x4*)(k_a + c), rk = *(const f32x4*)(r_k + c), lw = *(const f32x4*)(lnw + c), lb = *(const f32x4*)(lnb + c);
            float s = y[0] + y[1] + y[2] + y[3]; s = sum16(s); const float mu = s * (1.f / 64.f);
            const f32x4 d = y - mu; float vs = d[0] * d[0] + d[1] * d[1] + d[2] * d[2] + d[3] * d[3]; vs = sum16(vs);
            const float rstd = rsqrtf(vs * (1.f / 64.f) + 64e-5f);
            const f32x4 kd = kk * ((a0 + a1 - 2.f) * ka + 2.f);
            const f32x4 cf = rr * kd * rk; float co = cf[0] + cf[1] + cf[2] + cf[3]; co = sum16(co);
            const f32x4 out = (d * rstd * lw + lb + vv * co) * gg;
            st_bf4(XO + o, out); }
    }
}

enum { OP_PREP, OP_ROW0, OP_ROW_A, OP_ROW_B, OP_ROW_C, OP_FFN_UP, OP_FFN_DN, OP_MLA_DQKV, OP_MLA_NORM, OP_MLA_UQ, OP_MLA_UKV, OP_MLA_ATTN, OP_MLA_WO,
       OP_FN_DFT, OP_FN_DFTC, OP_FN_OUT, OP_RW_SHIFT, OP_RW_G1, OP_RW_G2W, OP_RW_G2A, OP_RW_G2G, OP_RW_SCAN, OP_RW_OUT, OP_RW_WO };
#define OPC(op, layer, which, nosync) ((op) | ((layer) << 8) | ((which) << 12) | ((nosync) << 16))
#define FFN1(l) OPC(OP_FFN_UP, l, 0, 0), OPC(OP_FFN_DN, l, 0, 0), OPC(OP_ROW_A, l, 0, 0)
#define FFN2(l) OPC(OP_ROW_B, l, 0, 0), OPC(OP_FFN_UP, l, 1, 0), OPC(OP_FFN_DN, l, 1, 0), OPC(OP_ROW_C, l, 0, 0)
#define MLA(l) OPC(OP_MLA_DQKV, l, 0, 0), OPC(OP_MLA_NORM, l, 0, 0), OPC(OP_MLA_UQ, l, 0, 1), OPC(OP_MLA_UKV, l, 0, 0), OPC(OP_MLA_ATTN, l, 0, 0), OPC(OP_MLA_WO, l, 0, 0)
constexpr int PROG[] = {
    OPC(OP_PREP, 0, 0, 0), OPC(OP_ROW0, 0, 0, 0),
    FFN1(0), MLA(0), FFN2(0),
    FFN1(1), OPC(OP_FN_DFT, 1, 0, 1), OPC(OP_FN_DFTC, 1, 0, 0), OPC(OP_FN_OUT, 1, 0, 0), FFN2(1),
    FFN1(2), OPC(OP_RW_SHIFT, 2, 0, 0), OPC(OP_RW_G1, 2, 0, 0), OPC(OP_RW_G2W, 2, 0, 1), OPC(OP_RW_G2A, 2, 0, 1), OPC(OP_RW_G2G, 2, 0, 0), OPC(OP_RW_SCAN, 2, 0, 0),
             OPC(OP_RW_OUT, 2, 0, 0), OPC(OP_RW_WO, 2, 0, 0), FFN2(2),
    FFN1(3), MLA(3), FFN2(3) };
constexpr int NPROG = 2 + (3 + 6 + 4) + (3 + 3 + 4) + (3 + 8 + 4) + (3 + 6 + 4);

#define XB_TMO      128
#define XB_XCNT(j)  (256  + 64 * (j))
#define XB_XSUB(j)  (1280 + 64 * (j))
#define XB_XGEN(j)  (2304 + 64 * (j))
#define XB_TOP      3328
#define XB_TOPGEN   3392
#define XCD_BAR_WORDS 3456
#define XB_SPIN_CAP (1u << 20)
DEVINL unsigned xb_ld(unsigned* p)              { return __hip_atomic_load(p, __ATOMIC_RELAXED, __HIP_MEMORY_SCOPE_AGENT); }
DEVINL unsigned xb_add(unsigned* p, unsigned v) { return __hip_atomic_fetch_add(p, v, __ATOMIC_RELAXED, __HIP_MEMORY_SCOPE_AGENT); }
DEVINL unsigned xb_xcc_id() { return (unsigned)__builtin_amdgcn_s_getreg((3 << 11) | 20) & 0xFu; }
#define XB_SPIN(cond, bar) do { unsigned _sp = 0; while (cond) { __builtin_amdgcn_s_sleep(1); \
    if ((++_sp & 255u) == 0u) { if (xb_ld(&(bar)[XB_TMO])) break; if (_sp > XB_SPIN_CAP) { atomicAdd(&(bar)[XB_TMO], 1u); break; } } } } while (0)
DEVINL void xcd_barrier_post(unsigned* bar) { if (otid() == 0) (void)xb_add(&bar[XB_XCNT(xb_xcc_id())], 1u); }
DEVINL void xcd_barrier_complete(unsigned* bar, unsigned x, unsigned& nloc, unsigned& nx) {
    const unsigned G = gridDim.x;
    unsigned sum, cnt, mine, sp = 0u;
    for (;;) {
        sum = 0u; cnt = 0u; mine = 0u;
#pragma unroll
        for (unsigned j = 0; j < 16; ++j) { const unsigned c = xb_ld(&bar[XB_XCNT(j)]); sum += c; cnt += (c > 0u) ? 1u : 0u; mine = (j == x) ? c : mine; }
        if (sum == G) break;
        __builtin_amdgcn_s_sleep(1);
        if ((++sp & 255u) == 0u) { if (xb_ld(&bar[XB_TMO])) break; if (sp > XB_SPIN_CAP) { atomicAdd(&bar[XB_TMO], 1u); break; } }
    }
    nloc = mine > 0u ? mine : 1u; nx = cnt > 0u ? cnt : 1u;
}
DEVINL void xcd_barrier(unsigned* bar, volatile LAS unsigned* st) {
    asm volatile("s_waitcnt vmcnt(0)" ::: "memory");
    __syncthreads();
    if (otid() == 0) {
        const unsigned x = xb_xcc_id();
        __builtin_amdgcn_s_waitcnt(0);
        unsigned nloc = st[0], nx = st[1];
        if (nloc == 0u) { xcd_barrier_complete(bar, x, nloc, nx); st[0] = nloc; st[1] = nx; }
        const unsigned old = xb_add(&bar[XB_XSUB(x)], 1u);
        const unsigned gen = old / nloc;
        if (old + 1u == (gen + 1u) * nloc) {
            __builtin_amdgcn_fence(__ATOMIC_RELEASE, "agent");
            asm volatile("s_waitcnt vmcnt(0)" ::: "memory");
            const unsigned og = xb_add(&bar[XB_TOP], 1u);
            const unsigned tg = og / nx;
            if (og + 1u == (tg + 1u) * nx) xb_add(&bar[XB_TOPGEN], 1u);
            else XB_SPIN(xb_ld(&bar[XB_TOPGEN]) == tg, bar);
            __builtin_amdgcn_fence(__ATOMIC_ACQUIRE, "agent");
            xb_add(&bar[XB_XGEN(x)], 1u);
            asm volatile("s_waitcnt vmcnt(0)" ::: "memory");
        } else {
            XB_SPIN(xb_ld(&bar[XB_XGEN(x)]) == gen, bar);
            __builtin_amdgcn_fence(__ATOMIC_ACQUIRE, "agent");
            asm volatile("s_waitcnt vmcnt(0)" ::: "memory");
        }
    }
    __syncthreads();
}
constexpr int bar_ordinal(int pc) { int n = 0; for (int q = 1; q <= pc; ++q) if (!((PROG[q] >> 16) & 1)) ++n; return n; }
template <int PC>
DEVINL void run_prog(const Params& kp, unsigned char* smem, cg::grid_group& grid) {
    LAS unsigned char* lds = (LAS unsigned char*)smem;
    {
        constexpr int code = PROG[PC], op = code & 0xff, i = (code >> 8) & 0xf, which = (code >> 12) & 0xf, nosync = (code >> 16) & 1;
        unsigned char* ws = kp.ws;
        const int zz = 0;
        float* outp = kp.out;
        const PV p{kp, zz, ws, outp};
        float* MOD = (float*)(ws + WS_MOD); float* HC = (float*)(ws + WS_HC); bf16_t* XN = (bf16_t*)(ws + WS_XN); float* Y = (float*)(ws + WS_Y);
        bf16_t* WM = (bf16_t*)(ws + WS_WM); unsigned char* SCR = ws + WS_SCR;
        const float* npre = p.in(6); const float* npost = p.in(7);
        const int kind = i % 3, j = i / 3; const bool last = (i == 3);
        const float* modi = MOD + (size_t)i * 9 * MODW;
        bf16_t* slot = (bf16_t*)(ws + WS_WF) + (size_t)(i & 1) * FFN_SLOT;
        bf16_t* G = (bf16_t*)(SCR + S_G);
        bf16_t* M = WM + (j ? WM_MLA1 : WM_MLA0);
        switch (op) {
        case OP_PREP: phase_prep(p, smem); break;
        case OP_ROW0: case OP_ROW_A: case OP_ROW_B: case OP_ROW_C: {
            RowArgs a{}; a.hin_l = p.out; a.hin_c = HC; a.hout_l = p.out; a.hout_c = HC; a.Y = Y; a.modp = modi; a.xn = XN; a.xn_ld = 1024; a.nrows = NTOK; a.upd_ctx = 1; a.modn = modi;
            if (op == OP_ROW0) { a.hin_l = p.in(0); a.hin_c = p.in(2); a.Y = nullptr; a.subn = 0; a.gpre = npre; }
            else if (op == OP_ROW_A) { a.Ys = (const float*)(ws + WS_SLAB); a.nslab = NSLAB; a.subp = 0; a.gpost = npost + (i * 3 + 0) * 1024; a.coef = 0.5f; a.subn = 1; a.gpre = npre + (i * 3 + 1) * 1024; a.xn_ld = (kind == 2) ? 2048 : 1024; }
            else if (op == OP_ROW_B) { a.Ys = (const float*)(ws + WS_SLAB); a.nslab = last ? 0 : 4; a.subp = 1; a.gpost = npost + (i * 3 + 1) * 1024; a.coef = 1.0f; a.subn = 2; a.gpre = npre + (i * 3 + 2) * 1024; a.nrows = last ? NLAT : NTOK; }
            else { a.Ys = (const float*)(ws + WS_SLAB); a.nslab = last ? 0 : NSLAB; a.subp = 2; a.gpost = npost + (i * 3 + 2) * 1024; a.coef = 0.5f; a.nrows = last ? NLAT : NTOK;
                   if (last) a.modn = nullptr; else { a.modn = MOD + (size_t)(i + 1) * 9 * MODW; a.subn = 0; a.gpre = npre + ((i + 1) * 3 + 0) * 1024; } }
            if (op == OP_ROW_A && kind == 1) phase_rows_T(a, smem, (bf16_t*)(SCR + S_XT), (bf16_t*)(SCR + S_XTC)); else phase_rows(a);
        } break;
        case OP_FFN_UP: { Gemm g{XN, slot + (size_t)which * (FFN_WGU + FFN_WD), 1024, 1024, 1024, ((last && which) ? NLAT : NTOK) / 256, 2 * DFF / 256, 0, 0}; EpiSwiGLU E{G}; gemm_phase(lds, g, E);
            if (i < 3) { const int nbusy = (g.nM * g.nN) % (int)gridDim.x, bid = obid();
                if (bid >= nbusy) { __syncthreads(); conv_ffn_w((float*)smem, p, i + 1, which, (bf16_t*)(ws + WS_WF) + (size_t)((i + 1) & 1) * FFN_SLOT, bid - nbusy, (int)gridDim.x - nbusy); } } } break;
        case OP_MLA_DQKV: { Gemm g{XN, M + MLA_DQKV, 1024, 1024, 1024, NTOK / 256, 4, 0, 0}; EpiF32 E{Y, 1024, nullptr, nullptr}; gemm_phase(lds, g, E);
            if (i == 0) { const int nbusy = (g.nM * g.nN) % (int)gridDim.x, bid = obid(); if (bid >= nbusy) { __syncthreads(); prep_late(p, smem, bid - nbusy, (int)gridDim.x - nbusy); } } } break;
        case OP_FFN_DN: case OP_MLA_WO: case OP_FN_OUT: case OP_RW_WO: {
            Gemm g{XN, M + MLA_WO, 1024, 1024, 1024, NLAT / 256, 4, 0, 0}; EpiY E{(bf16_t*)Y, nullptr, (float*)(ws + WS_SLAB)};
            bool tail = true;
            if (op == OP_FFN_DN) { g.A = G; g.Bt = slot + (size_t)which * (FFN_WGU + FFN_WD) + FFN_WGU; g.lda = g.ldb = g.K = DFF; tail = !(last && which); g.KS = 512; g.nSl = NSLAB; }
            else if (op == OP_MLA_WO) { tail = !last; g.KS = 256; g.nSl = 4; }
            else if (op == OP_FN_OUT) { g.A = (bf16_t*)(SCR + S_P); g.Bt = WM + WM_W2T; g.lda = g.ldb = g.K = 2048; E.bias = p.in(19); g.KS = 512; g.nSl = 4; }
            else { g.Bt = WM + WM_RWO; g.KS = 256; g.nSl = 4; }
            if (tail) g.nTailM = NCTX / 256; else g.nSl = 0;
            gemm_phase(lds, g, E);
        } break;
        case OP_MLA_NORM: phase_mla_norm(p, j, Y, (bf16_t*)(SCR + S_QN), (bf16_t*)(SCR + S_CKVN), (bf16_t*)(SCR + S_K)); break;
        case OP_MLA_UQ: { Gemm g{(bf16_t*)(SCR + S_QN), M + MLA_UQ, 512, 512, 512, NTOK / 256, 6, 0, 0}; EpiUQ E{(bf16_t*)(SCR + S_Q), (const float*)(ws + WS_ROPE), (const float*)(ws + WS_ROPE) + 1024}; gemm_phase(lds, g, E); } break;
        case OP_MLA_UKV: { Gemm g{(bf16_t*)(SCR + S_CKVN), M + MLA_UKV, 256, 256, 256, NTOK / 256, 8, 0, 0}; EpiUKV E{(bf16_t*)(SCR + S_K), (bf16_t*)(SCR + S_V)}; gemm_phase(lds, g, E); } break;
        case OP_MLA_ATTN: phase_attn((bf16_t*)(SCR + S_Q), (bf16_t*)(SCR + S_K), (bf16_t*)(SCR + S_V), XN, !last, (char*)smem); break;
        case OP_FN_DFT: case OP_FN_DFTC: {
            Gemm g{WM + WM_DT2, (bf16_t*)(SCR + S_XT), 2048, 2048, 2048, 128, 4, 16, (size_t)1024 * 2048 * 2}; EpiDFT1 E{(bf16_t*)(SCR + S_P), 4, 2048, 0};
            if (op == OP_FN_DFTC) { g.A = WM + WM_DT2C; g.Bt = (bf16_t*)(SCR + S_XTC); g.lda = g.ldb = g.K = 256; g.nM = 16; g.amod = 2; g.bbatch = (size_t)1024 * 256 * 2; E.shift = 1; E.rpb = 256; E.rowbase = NLAT; }
            gemm_phase(lds, g, E);
        } break;
        case OP_RW_SHIFT: phase_rwkv_shift(XN); break;
        case OP_RW_G1: { Gemm g{XN, WM + WM_WCAT, 2048, 2048, 2048, NTOK / 256, 14, 0, 0}; EpiRwkv1 E{(bf16_t*)(SCR + S_R), (bf16_t*)(SCR + S_A2)}; gemm_phase(lds, g, E); } break;
        case OP_RW_G2W: case OP_RW_G2A: {
            Gemm g{(bf16_t*)(SCR + S_A2), WM + WM_BW, 512, 256, 256, NTOK / 256, 8, 0, 0};
            if (op == OP_RW_G2A) { g.Bt = WM + WM_BA; EpiRwkv2<1> E{(bf16_t*)(SCR + S_AA), p.in(27)}; gemm_phase(lds, g, E); }
            else { EpiRwkv2<0> E{XN, p.in(24)}; gemm_phase(lds, g, E); }
        } break;
        case OP_RW_G2G: { Gemm g{(bf16_t*)(SCR + S_A2) + 256, WM + WM_BG, 512, 256, 256, NTOK / 256, 4, 0, 0}; EpiBf16 E{(bf16_t*)(SCR + S_GG), 1024}; gemm_phase(lds, g, E); } break;
        case OP_RW_SCAN: phase_scan(p, (bf16_t*)(SCR + S_R), (bf16_t*)(SCR + S_KK), (bf16_t*)(SCR + S_VV), (bf16_t*)(SCR + S_AA), XN, Y, (bf16_t*)(ws + WS_SLAB), smem); break;
        case OP_RW_OUT: phase_rwkv_out(p, Y, (const bf16_t*)(ws + WS_SLAB), (bf16_t*)(SCR + S_R), (bf16_t*)(SCR + S_KK), (bf16_t*)(SCR + S_VV), (bf16_t*)(SCR + S_AA), (bf16_t*)(SCR + S_GG), XN); break;
        default: break;
        }
        if (!nosync && PC + 1 < NPROG) { if (PC == 0 && kp.ws == nullptr) grid.sync(); xcd_barrier((unsigned*)(kp.ws + WS_BAR), (volatile LAS unsigned*)(lds + LDS_BYTES - 16)); }
    }
    if constexpr (PC + 1 < NPROG) run_prog<PC + 1>(kp, smem, grid);
}
__global__ void __launch_bounds__(512) fwd_megakernel(Params kp) {
    extern __shared__ __attribute__((aligned(16))) unsigned char smem[];
    cg::grid_group grid = cg::this_grid();
    if (otid() < 4) ((volatile LAS unsigned*)((LAS unsigned char*)smem + LDS_BYTES - 16))[otid()] = 0u;
    __syncthreads();
    xcd_barrier_post((unsigned*)(kp.ws + WS_BAR));
    run_prog<0>(kp, smem, grid);
}

extern "C" void kernel_launch(void* const* d_in, const int* in_sizes, int n_in, void* d_out, int out_size, void* d_ws, size_t ws_size, hipStream_t stream) {
    static int grid = 0;
    if (grid == 0) {
        if (n_in != 38 || ws_size < WS_END) { fprintf(stderr, "kernel_launch: need 38 inputs and %zu bytes of workspace; got %d, %zu\n", (size_t)WS_END, n_in, ws_size); grid = -1; return; }
        int dev = 0, cus = 0, per_cu = 0;
        (void)hipGetDevice(&dev); (void)hipDeviceGetAttribute(&cus, hipDeviceAttributeMultiprocessorCount, dev);
        if (hipFuncSetAttribute((const void*)fwd_megakernel, hipFuncAttributeMaxDynamicSharedMemorySize, LDS_BYTES) != hipSuccess) { fprintf(stderr, "kernel_launch: hipFuncSetAttribute failed\n"); grid = -1; return; }
        if (hipOccupancyMaxActiveBlocksPerMultiprocessor(&per_cu, (const void*)fwd_megakernel, 512, LDS_BYTES) != hipSuccess || per_cu < 1) { fprintf(stderr, "kernel_launch: occupancy query says %d\n", per_cu); per_cu = 1; }
        (void)hipGetLastError();
        grid = cus * 1;
    }
    if (grid < 0) return;
    Params p{};
    for (int i = 0; i < 38; ++i) p.in[i] = (const float*)d_in[i];
    p.out = (float*)d_out; p.ws = (unsigned char*)d_ws;
    if (hipMemsetAsync((char*)d_ws + WS_BAR, 0, 16384, stream) != hipSuccess) { fprintf(stderr, "kernel_launch: memset failed\n"); return; }
    void* args[] = {&p};
    hipError_t e = hipLaunchCooperativeKernel((const void*)fwd_megakernel, dim3(grid), dim3(512), args, LDS_BYTES, stream);
    if (e != hipSuccess) fprintf(stderr, "cooperative launch failed: %s (grid %d)\n", hipGetErrorString(e), grid);
}
```

```cpp
#include <hip/hip_runtime.h>
#include <hip/hip_cooperative_groups.h>
#include <cstdio>
namespace cg = cooperative_groups;

#define LAS __attribute__((address_space(3)))
#define DEVINL __device__ __forceinline__
typedef unsigned short bf16_t;
typedef short bf16x8 __attribute__((ext_vector_type(8)));
typedef short s16x4 __attribute__((ext_vector_type(4)));
typedef float f32x4 __attribute__((ext_vector_type(4)));
typedef float f32x16 __attribute__((ext_vector_type(16)));
typedef unsigned u32x4 __attribute__((ext_vector_type(4)));
typedef unsigned u32x2 __attribute__((ext_vector_type(2)));

constexpr int DM = 1024, NB = 8, SEQ = 2048, CTX = 256, DFF = 2816, NLAT = NB * SEQ, NCTX = NB * CTX, NTOK = NLAT + NCTX, TKV = SEQ + CTX;
constexpr int MODW = 9 * DM;
constexpr float EPS = 1e-6f;

constexpr size_t al256(size_t x) { return (x + 255) / 256 * 256; }
constexpr size_t WS_MOD = 0;
constexpr size_t WS_ROPE = al256(WS_MOD + (size_t)4 * 9 * MODW * 4);
constexpr size_t WS_HC = al256(WS_ROPE + 2 * 64 * 16 * 4);
constexpr size_t WS_XN = al256(WS_HC + (size_t)NCTX * DM * 4);
constexpr size_t WS_Y = al256(WS_XN + (size_t)NTOK * 2048 * 2);
constexpr size_t FFN_WGU = (size_t)2 * DFF * DM;
constexpr size_t FFN_WD = (size_t)DM * DFF;
constexpr size_t FFN_SLOT = 2 * (FFN_WGU + FFN_WD);
constexpr size_t WS_WF = al256(WS_Y + (size_t)NTOK * DM * 4);
constexpr size_t WS_WM = al256(WS_WF + 2 * FFN_SLOT * 2);
constexpr size_t MLA_DQKV = 0, MLA_UQ = MLA_DQKV + 1024 * 1024, MLA_UKV = MLA_UQ + 1536 * 512, MLA_WO = MLA_UKV + 2048 * 256, MLA_SZ = MLA_WO + 1024 * 1024;
constexpr size_t WM_MLA0 = 0, WM_MLA1 = MLA_SZ;
constexpr size_t WM_W2T = 2 * MLA_SZ, WM_DT2 = WM_W2T + 1024 * 2048, WM_DT2C = WM_DT2 + (size_t)4096 * 2048;
constexpr size_t WM_WCAT = WM_DT2C + 512 * 256, WM_BW = WM_WCAT + (size_t)3584 * 2048, WM_BA = WM_BW + 2048 * 256, WM_BG = WM_BA + 2048 * 256, WM_RWO = WM_BG + 1024 * 256;
constexpr size_t WM_END = WM_RWO + 1024 * 1024;
constexpr size_t WS_SCR = al256(WS_WM + WM_END * 2);
constexpr size_t SCR_BYTES = 245366784;
constexpr size_t WS_BAR = WS_SCR + SCR_BYTES;
constexpr int NSLAB = 6;
constexpr size_t WS_SLAB = WS_BAR + 16384;
constexpr size_t WS_END = WS_SLAB + (size_t)NSLAB * NCTX * DM * 4;
constexpr size_t S_G = 0;
constexpr size_t S_QN = 0, S_CKVN = S_QN + (size_t)NTOK * 512 * 2, S_Q = S_CKVN + (size_t)NTOK * 256 * 2, S_K = S_Q + (size_t)64 * TKV * 192 * 2,
                 S_V = S_K + (size_t)64 * TKV * 192 * 2;
constexpr size_t S_XT = 0, S_XTC = S_XT + (size_t)8 * 1024 * 2048 * 2, S_P = al256(S_XTC + (size_t)8 * 1024 * 256 * 2);
constexpr size_t S_R = 0, S_KK = S_R + (size_t)NTOK * DM * 2, S_VV = S_KK + (size_t)NTOK * DM * 2, S_A2 = S_VV + (size_t)NTOK * DM * 2,
                 S_AA = S_A2 + (size_t)NTOK * 512 * 2, S_GG = S_AA + (size_t)2 * NTOK * DM * 2;
static_assert(S_GG + (size_t)NTOK * DM * 2 <= SCR_BYTES, "scratch");
static_assert(S_V + (size_t)64 * TKV * 128 * 2 <= SCR_BYTES, "scratch");
static_assert(S_P + (size_t)NTOK * 2048 * 2 <= SCR_BYTES, "scratch");

constexpr int LDS_BYTES = 135168;

struct Params { const float* in[38]; float* out; unsigned char* ws; };
struct PV { const Params& p; int z; unsigned char* ws; float* out;
    __device__ __forceinline__ const float* in(int k) const { return p.in[k + z]; } };

DEVINL int otid() { int t = threadIdx.x; asm volatile("" : "+v"(t)); return t; }
DEVINL int obid() { int b = blockIdx.x; asm volatile("" : "+s"(b)); return b; }
DEVINL float bf2f(bf16_t b) { return __uint_as_float(((unsigned)b) << 16); }
DEVINL bf16_t f2bf(float f) { unsigned u = __float_as_uint(f); u += 0x7FFFu + ((u >> 16) & 1u); return (bf16_t)(u >> 16); }
typedef float f32x2c __attribute__((ext_vector_type(2)));
typedef __bf16 bf16x2c __attribute__((ext_vector_type(2)));
DEVINL unsigned pk2(float lo, float hi) { const f32x2c v = {lo, hi}; const bf16x2c r = __builtin_convertvector(v, bf16x2c); return __builtin_bit_cast(unsigned, r); }
DEVINL float wave_sum(float v) {
#pragma unroll
    for (int o = 32; o > 0; o >>= 1) v += __shfl_xor(v, o);
    return v; }
#define DPPF(v, ctrl) __builtin_bit_cast(float, __builtin_amdgcn_update_dpp(0, __builtin_bit_cast(int, (v)), (ctrl), 0xF, 0xF, false))
DEVINL float wave_sum_dpp(float v) {
    v += DPPF(v, 0xB1); v += DPPF(v, 0x4E); v += DPPF(v, 0x141); v += DPPF(v, 0x140);
    const int vi_ = __builtin_bit_cast(int, v);
    return __builtin_bit_cast(float, __builtin_amdgcn_readlane(vi_, 0)) + __builtin_bit_cast(float, __builtin_amdgcn_readlane(vi_, 16)) + __builtin_bit_cast(float, __builtin_amdgcn_readlane(vi_, 32)) + __builtin_bit_cast(float, __builtin_amdgcn_readlane(vi_, 48));
}
DEVINL float sum16(float v) {
#pragma unroll
    for (int o = 8; o > 0; o >>= 1) v += __shfl_xor(v, o);
    return v; }
DEVINL float silu_f(float x) { return x * __builtin_amdgcn_rcpf(1.f + __expf(-x)); }
DEVINL float sigm_f(float x) { return __builtin_amdgcn_rcpf(1.f + __expf(-x)); }
DEVINL float lo_bf(unsigned w) { return __uint_as_float(w << 16); }
DEVINL float hi_bf(unsigned w) { return __uint_as_float(w & 0xFFFF0000u); }

constexpr int BM = 256, BK = 64, HALF = 128, HTB = HALF * BK * 2, NXCD = 8, WGM = 8;
DEVINL int lds_byte(int r, int c) { const int st = (r >> 4) * 2 + (c >> 5), rr = r & 15, cc = c & 31, ob = rr * 64 + cc * 2; return st * 1024 + (ob ^ (((ob >> 9) & 1) << 5)); }
DEVINL void stage_rc(int b, int& R, int& C) { const int st = b / 1024, sb = b % 1024, swz = sb ^ (((sb >> 9) & 1) << 5); R = (st >> 1) * 16 + swz / 64; C = (st & 1) * 32 + (swz % 64) / 2; }
DEVINL int perm32(int rho) { const int n = rho >> 4, i = rho & 15; return 8 * (i >> 2) + 4 * n + (i & 3); }
struct Unit { int pm, pn, ks; };
struct Gemm { const bf16_t* A; const bf16_t* Bt; int lda, ldb, K, nM, nN, amod; size_t bbatch; int nTailM, nSl, KS; };
struct Sched {
    int nM, nN, nwg, G, c, ntail, nSl;
    DEVINL void init(int nM_, int nN_, int nTailM, int nSl_) { nM = nM_; nN = nN_; nwg = nM * nN; G = gridDim.x; c = obid(); nSl = nSl_; ntail = nTailM * nN_ * nSl_; }
    DEVINL bool next(int i, Unit& u) const {
        const long L = (long)i * G + c; if (L >= nwg + ntail) return false;
        if (L >= nwg) { const int t = (int)L - nwg, rest = t / nSl; u.ks = t % nSl; u.pn = rest % nN; u.pm = nM + rest / nN; return true; }
        u.ks = -1;
        int wgid = (int)L; { const int q = nwg / NXCD, r = nwg % NXCD, xcd = wgid % NXCD, off = wgid / NXCD; wgid = (xcd < r ? xcd * (q + 1) : r * (q + 1) + (xcd - r) * q) + off; }
        const int nig = WGM * nN, gid = wgid / nig, fm = gid * WGM, gsz = (nM - fm) < WGM ? (nM - fm) : WGM;
        u.pm = fm + ((wgid % nig) % gsz); u.pn = (wgid % nig) / gsz; return true;
    }
};
typedef f32x4 Acc[2][2][4][2];

template <class Epi>
DEVINL void gemm_phase(LAS unsigned char* lds, const Gemm g, const Epi& E) {
    const int tid = otid(), wid = __builtin_amdgcn_readfirstlane(tid >> 6), lane = tid & 63, wr = wid >> 2, wc = wid & 3, fr = lane & 15, fq = lane >> 4;
    Sched S; S.init(g.nM, g.nN, g.nTailM, g.nSl);
    const int K = g.K;
    unsigned voffA[2], voffB[2];
#pragma unroll
    for (int i = 0; i < 2; ++i) { int R, C; stage_rc(tid * 16 + i * 8192, R, C);
        const int Rb = Epi::PERM ? ((R & ~31) + perm32(R & 31)) : R;
        voffA[i] = (unsigned)(R * g.lda + C) * 2u; voffB[i] = (unsigned)(Rb * g.ldb + C) * 2u; }
    const size_t kstep = (size_t)(BK * 2);
    const size_t hstepA = (size_t)HALF * g.lda * 2, hstepB = (size_t)HALF * g.ldb * 2;
    const size_t tstepA = 2 * hstepA, tstepB = 2 * hstepB;
    const unsigned ldsw = (unsigned)wid * 1024u;
    const int aoff = lds_byte(wr * 64 + fr, fq * 8), boff = lds_byte(wc * 32 + fr, fq * 8);
#define PG8_SA(b, h) (((b) * 2 + (h)) * HTB)
#define PG8_SB(b, h) ((4 + (b) * 2 + (h)) * HTB)
#define PG8_STAGE(bufoff, gbase, voff) do { _Pragma("unroll") for (int _i = 0; _i < 2; ++_i) \
        __builtin_amdgcn_global_load_lds((const unsigned*)((const char*)(gbase) + (voff)[_i]), (LAS unsigned*)(lds + (bufoff) + ldsw + _i * 8192), 16, 0, 0); } while (0)
#define PG8_LDA(dst, b, h) do { _Pragma("unroll") for (int m = 0; m < 4; ++m) _Pragma("unroll") for (int k = 0; k < 2; ++k) dst[m][k] = *(const LAS bf16x8*)(lds + PG8_SA(b, h) + aoff + m * 2048 + k * 1024); } while (0)
#define PG8_LDB(dst, b, h) do { _Pragma("unroll") for (int n = 0; n < 2; ++n) _Pragma("unroll") for (int k = 0; k < 2; ++k) dst[n][k] = *(const LAS bf16x8*)(lds + PG8_SB(b, h) + boff + n * 2048 + k * 1024); } while (0)
#define PG8_MMA(ai, bj, At, Bt) do { __builtin_amdgcn_s_setprio(1); _Pragma("unroll") for (int m = 0; m < 4; ++m) _Pragma("unroll") for (int n = 0; n < 2; ++n) _Pragma("unroll") for (int k = 0; k < 2; ++k) \
        acc[ai][bj][m][n] = __builtin_amdgcn_mfma_f32_16x16x32_bf16(Bt[n][k], At[m][k], acc[ai][bj][m][n], 0, 0, 0); __builtin_amdgcn_s_setprio(0); } while (0)
#define PG8_WAIT_V(n) asm volatile("s_waitcnt vmcnt(" #n ")" ::: "memory")
#define PG8_WAIT_L(n) asm volatile("s_waitcnt lgkmcnt(" #n ")" ::: "memory")
#define PG8_BAR __builtin_amdgcn_s_barrier()
#define PG8_SCHED __builtin_amdgcn_sched_barrier(0)
    Unit cur, nxt; int ui = 0;
    if (!S.next(0, cur)) return;
    Acc acc;
#pragma unroll
    for (int a = 0; a < 2; ++a)
#pragma unroll
        for (int b = 0; b < 2; ++b)
#pragma unroll
            for (int m = 0; m < 4; ++m)
#pragma unroll
                for (int n = 0; n < 2; ++n) acc[a][b][m][n] = (f32x4){0.f, 0.f, 0.f, 0.f};
    bf16x8 At[4][2], B0[2][2], B1[2][2];
#define PG8_KOFF(u) ((u).ks > 0 ? (size_t)(u).ks * g.KS * 2 : (size_t)0)
#define PG8_NT(u) ((u).ks < 0 ? K / BK : ((K - (u).ks * g.KS) < g.KS ? (K - (u).ks * g.KS) : g.KS) / BK)
#define PG8_APTR(u) ((const char*)g.A + (size_t)(g.amod ? (u).pm % g.amod : (u).pm) * tstepA + PG8_KOFF(u))
#define PG8_BPTR(u) ((const char*)g.Bt + (size_t)(u).pn * tstepB + (g.amod ? (size_t)((u).pm / g.amod) * g.bbatch : (size_t)0) + PG8_KOFF(u))
    const char* cA = PG8_APTR(cur); const char* cB = PG8_BPTR(cur); int nt = PG8_NT(cur);
    PG8_STAGE(PG8_SB(0, 0), cB, voffB); PG8_STAGE(PG8_SA(0, 0), cA, voffA); PG8_STAGE(PG8_SB(0, 1), cB + hstepB, voffB); PG8_STAGE(PG8_SA(0, 1), cA + hstepA, voffA);
    if (wr == 1) PG8_BAR;
    PG8_WAIT_V(4); PG8_BAR;
    PG8_STAGE(PG8_SB(1, 0), cB + kstep, voffB); PG8_STAGE(PG8_SA(1, 0), cA + kstep, voffA); PG8_STAGE(PG8_SB(1, 1), cB + hstepB + kstep, voffB);
    PG8_WAIT_V(6); PG8_BAR;
    for (;;) {
        const bool has_next = S.next(ui + 1, nxt);
        const char* nA = has_next ? PG8_APTR(nxt) : cA; const char* nB = has_next ? PG8_BPTR(nxt) : cB;
        for (int t = 0; t < nt; t += 2) {
            const bool last = (t == nt - 2);
            const char* a1 = cA + (size_t)(t + 1) * kstep;
            const char* a2 = last ? nA : cA + (size_t)(t + 2) * kstep; const char* b2 = last ? nB : cB + (size_t)(t + 2) * kstep;
            const char* a3 = a2 + kstep; const char* b3 = b2 + kstep;
            PG8_LDB(B0, 0, 0); PG8_SCHED; PG8_LDA(At, 0, 0); PG8_STAGE(PG8_SA(1, 1), a1 + hstepA, voffA);
            PG8_WAIT_L(8); PG8_BAR; PG8_WAIT_L(0); PG8_MMA(0, 0, At, B0); PG8_BAR; PG8_SCHED;
            PG8_LDB(B1, 0, 1); PG8_STAGE(PG8_SB(0, 0), b2, voffB);
            PG8_BAR; PG8_WAIT_L(0); PG8_MMA(0, 1, At, B1); PG8_BAR;
            PG8_LDA(At, 0, 1); PG8_STAGE(PG8_SA(0, 0), a2, voffA);
            PG8_BAR; PG8_WAIT_L(0); PG8_MMA(1, 0, At, B0); PG8_BAR; PG8_SCHED;
            PG8_STAGE(PG8_SB(0, 1), b2 + hstepB, voffB);
            PG8_WAIT_V(6); PG8_BAR; PG8_MMA(1, 1, At, B1); PG8_BAR;
            PG8_LDB(B0, 1, 0); PG8_SCHED; PG8_LDA(At, 1, 0); PG8_STAGE(PG8_SA(0, 1), a2 + hstepA, voffA);
            PG8_WAIT_L(8); PG8_BAR; PG8_WAIT_L(0); PG8_MMA(0, 0, At, B0); PG8_BAR; PG8_SCHED;
            PG8_LDB(B1, 1, 1); PG8_STAGE(PG8_SB(1, 0), b3, voffB);
            PG8_BAR; PG8_WAIT_L(0); PG8_MMA(0, 1, At, B1); PG8_BAR;
            PG8_LDA(At, 1, 1); PG8_STAGE(PG8_SA(1, 0), a3, voffA);
            PG8_BAR; PG8_WAIT_L(0); PG8_MMA(1, 0, At, B0); PG8_BAR; PG8_SCHED;
            PG8_STAGE(PG8_SB(1, 1), b3 + hstepB, voffB);
            PG8_WAIT_V(6); PG8_BAR; PG8_MMA(1, 1, At, B1); PG8_BAR;
        }
        E(acc, cur, wr, wc, fr, fq);
        if (!has_next) break;
#pragma unroll
        for (int a = 0; a < 2; ++a)
#pragma unroll
            for (int b = 0; b < 2; ++b)
#pragma unroll
                for (int m = 0; m < 4; ++m)
#pragma unroll
                    for (int n = 0; n < 2; ++n) acc[a][b][m][n] = (f32x4){0.f, 0.f, 0.f, 0.f};
        cur = nxt; cA = nA; cB = nB; ++ui; nt = PG8_NT(cur);
    }
    PG8_WAIT_V(0);
    if (wr == 0) PG8_BAR;
    PG8_BAR;
#undef PG8_SA
#undef PG8_SB
#undef PG8_STAGE
#undef PG8_LDA
#undef PG8_LDB
#undef PG8_MMA
#undef PG8_BAR
#undef PG8_SCHED
#undef PG8_APTR
#undef PG8_KOFF
#undef PG8_NT
#undef PG8_BPTR
}
#define WAIT_V0() asm volatile("s_waitcnt vmcnt(0)" ::: "memory")

#define EPI_LOOP_ROWS for (int ai = 0; ai < 2; ++ai) for (int m = 0; m < 4; ++m)
DEVINL void st_bf4(bf16_t* p, f32x4 v) { u32x2 w; w.x = pk2(v[0], v[1]); w.y = pk2(v[2], v[3]); *(u32x2*)p = w; }

DEVINL void st_bf8(bf16_t* p, f32x4 a, f32x4 b) { u32x4 w; w.x = pk2(a[0], a[1]); w.y = pk2(a[2], a[3]); w.z = pk2(b[0], b[1]); w.w = pk2(b[2], b[3]); *(u32x4*)p = w; }
struct EpiF32 { static constexpr bool PERM = false;
    float* C; int ldc; const float* bias; float* Cs;
    DEVINL void operator()(const Acc& acc, const Unit& u, int wr, int wc, int fr, int fq) const {
        const int row0 = u.pm * BM + wr * 64 + fr, col0 = u.pn * BM + wc * 32 + 4 * fq;
        float* base = u.ks < 0 ? C : Cs + ((long)u.ks * NCTX - NLAT) * 1024;
#pragma unroll
        for (int ai = 0; ai < 2; ++ai)
#pragma unroll
            for (int m = 0; m < 4; ++m) { float* rowp = base + (size_t)(row0 + ai * HALF + m * 16) * ldc + col0;
#pragma unroll
                for (int bj = 0; bj < 2; ++bj)
#pragma unroll
                    for (int n = 0; n < 2; ++n) { f32x4 v = acc[ai][bj][m][n];
                        if (bias) v += *(const f32x4*)(bias + col0 + bj * HALF + n * 16);
                        *(f32x4*)(rowp + bj * HALF + n * 16) = v; } }
    }
};
struct EpiY { static constexpr bool PERM = true;
    bf16_t* Yb; const float* bias; float* Cs;
    DEVINL void operator()(const Acc& acc, const Unit& u, int wr, int wc, int fr, int fq) const {
        const int row0 = u.pm * BM + wr * 64 + fr, col0 = u.pn * BM + wc * 32 + 8 * fq;
        const bool addb = bias != nullptr && u.ks <= 0;
        float* sbase = Cs + ((long)u.ks * NCTX - NLAT) * 1024;
#pragma unroll
        for (int ai = 0; ai < 2; ++ai)
#pragma unroll
            for (int m = 0; m < 4; ++m) { const size_t ro = (size_t)(row0 + ai * HALF + m * 16) * 1024 + col0;
#pragma unroll
                for (int bj = 0; bj < 2; ++bj) { f32x4 v0 = acc[ai][bj][m][0], v1 = acc[ai][bj][m][1];
                    if (addb) { v0 += *(const f32x4*)(bias + col0 + bj * HALF); v1 += *(const f32x4*)(bias + col0 + bj * HALF + 4); }
                    if (u.ks < 0) st_bf8(Yb + ro + bj * HALF, v0, v1); else { *(f32x4*)(sbase + ro + bj * HALF) = v0; *(f32x4*)(sbase + ro + bj * HALF + 4) = v1; } } }
    }
};
struct EpiBf16 { static constexpr bool PERM = true;
    bf16_t* O; int ldc;
    DEVINL void operator()(const Acc& acc, const Unit& u, int wr, int wc, int fr, int fq) const {
        const int row0 = u.pm * BM + wr * 64 + fr, col0 = u.pn * BM + wc * 32 + 8 * fq;
#pragma unroll
        for (int ai = 0; ai < 2; ++ai)
#pragma unroll
            for (int m = 0; m < 4; ++m) { bf16_t* rowp = O + (size_t)(row0 + ai * HALF + m * 16) * ldc + col0;
#pragma unroll
                for (int bj = 0; bj < 2; ++bj) st_bf8(rowp + bj * HALF, acc[ai][bj][m][0], acc[ai][bj][m][1]); }
    }
};
struct EpiSwiGLU { static constexpr bool PERM = true;
    bf16_t* G;
    DEVINL void operator()(const Acc& acc, const Unit& u, int wr, int wc, int fr, int fq) const {
        const int row0 = u.pm * BM + wr * 64 + fr, col0 = u.pn * HALF + wc * 32 + 8 * fq;
#pragma unroll
        for (int ai = 0; ai < 2; ++ai)
#pragma unroll
            for (int m = 0; m < 4; ++m) { bf16_t* rowp = G + (size_t)(row0 + ai * HALF + m * 16) * DFF + col0;
                f32x4 o[2];
#pragma unroll
                for (int n = 0; n < 2; ++n) { const f32x4 gt = acc[ai][0][m][n], up = acc[ai][1][m][n];
#pragma unroll
                    for (int j = 0; j < 4; ++j) o[n][j] = silu_f(gt[j]) * up[j]; }
                st_bf8(rowp, o[0], o[1]); }
    }
};
DEVINL void tok_of_row(int r, int& b, int& tk, bool& lat) { lat = r < NLAT; if (lat) { b = r >> 11; tk = r & 2047; } else { const int rc = r - NLAT; b = rc >> 8; tk = SEQ + (rc & 255); } }
struct EpiUQ { static constexpr bool PERM = false;
    bf16_t* Q; const float* cosT; const float* sinT;
    DEVINL void operator()(const Acc& acc, const Unit& u, int wr, int wc, int fr, int fq) const {
#pragma unroll
        for (int ai = 0; ai < 2; ++ai)
#pragma unroll
            for (int m = 0; m < 4; ++m) { const int r = u.pm * BM + ai * HALF + wr * 64 + m * 16 + fr; int b, tq; bool lat; tok_of_row(r, b, tq, lat);
#pragma unroll
                for (int bj = 0; bj < 2; ++bj) { const int col32 = u.pn * BM + bj * HALF + wc * 32, head = col32 / 192, off = col32 % 192;
                    f32x4 v0 = acc[ai][bj][m][0], v1 = acc[ai][bj][m][1];
                    if (off >= 128 && lat) { const int axis = (off - 128) >> 5, pos = axis == 0 ? (tq >> 6) : (tq & 63);
                        const f32x4 c = *(const f32x4*)(cosT + pos * 16 + fq * 4), s = *(const f32x4*)(sinT + pos * 16 + fq * 4);
                        const f32x4 o0 = v0 * c - v1 * s, o1 = v1 * c + v0 * s; v0 = o0; v1 = o1; }
                    bf16_t* dst = Q + ((size_t)(b * 8 + head) * TKV + tq) * 192 + off + fq * 4;
                    st_bf4(dst, v0); st_bf4(dst + 16, v1); } }
    }
};
struct EpiUKV { static constexpr bool PERM = true;
    bf16_t* Kb; bf16_t* Vb;
    DEVINL void operator()(const Acc& acc, const Unit& u, int wr, int wc, int fr, int fq) const {
#pragma unroll
        for (int ai = 0; ai < 2; ++ai)
#pragma unroll
            for (int m = 0; m < 4; ++m) { const int r = u.pm * BM + ai * HALF + wr * 64 + m * 16 + fr; int b, tk; bool lat; tok_of_row(r, b, tk, lat);
                const size_t tokidx = (size_t)(b * 8 + u.pn) * TKV + tk; const int c = wc * 32 + fq * 8;
                st_bf8(Kb + tokidx * 192 + c, acc[ai][0][m][0], acc[ai][0][m][1]); st_bf8(Vb + tokidx * 128 + c, acc[ai][1][m][0], acc[ai][1][m][1]); }
    }
};
struct EpiDFT1 { static constexpr bool PERM = true;
    bf16_t* P; int shift, rpb, rowbase;
    DEVINL void operator()(const Acc& acc, const Unit& u, int wr, int wc, int fr, int fq) const {
        const int b = u.pm >> shift, tile = u.pm & ((1 << shift) - 1), cs = tile >> (shift - 1), t0 = (tile & ((1 << (shift - 1)) - 1)) * 256;
        const int row0 = rowbase + b * rpb + t0 + wr * 64 + fr, col0 = cs * 1024 + u.pn * BM + wc * 32 + 8 * fq;
#pragma unroll
        for (int ai = 0; ai < 2; ++ai)
#pragma unroll
            for (int m = 0; m < 4; ++m) { bf16_t* rowp = P + (size_t)(row0 + ai * HALF + m * 16) * 2048 + col0;
#pragma unroll
                for (int bj = 0; bj < 2; ++bj) st_bf8(rowp + bj * HALF, acc[ai][bj][m][0], acc[ai][bj][m][1]); }
    }
};
struct EpiRwkv1 { static constexpr bool PERM = true;
    bf16_t* R; bf16_t* A2;
    DEVINL void operator()(const Acc& acc, const Unit& u, int wr, int wc, int fr, int fq) const {
        const int row0 = u.pm * BM + wr * 64 + fr;
#pragma unroll
        for (int ai = 0; ai < 2; ++ai)
#pragma unroll
            for (int m = 0; m < 4; ++m) { const size_t r = (size_t)(row0 + ai * HALF + m * 16);
#pragma unroll
                for (int bj = 0; bj < 2; ++bj) { f32x4 v0 = acc[ai][bj][m][0], v1 = acc[ai][bj][m][1]; const int c = bj * HALF + wc * 32 + fq * 8;
                    if (u.pn < 12) { st_bf8(R + (size_t)(u.pn >> 2) * NTOK * DM + r * DM + (u.pn & 3) * 256 + c, v0, v1); }
                    else if (u.pn == 12) { if (bj == 0) {
#pragma unroll
                            for (int j = 0; j < 4; ++j) { const float e0 = __expf(-2.f * fabsf(v0[j])), t0 = (1.f - e0) / (1.f + e0); v0[j] = v0[j] < 0.f ? -t0 : t0;
                                const float e1 = __expf(-2.f * fabsf(v1[j])), t1 = (1.f - e1) / (1.f + e1); v1[j] = v1[j] < 0.f ? -t1 : t1; } }
                        st_bf8(A2 + r * 512 + c, v0, v1); }
                    else {
#pragma unroll
                        for (int j = 0; j < 4; ++j) { v0[j] = (c + j < 160) ? sigm_f(v0[j]) : 0.f; v1[j] = (c + 4 + j < 160) ? sigm_f(v1[j]) : 0.f; }
                        st_bf8(A2 + r * 512 + 256 + c, v0, v1); } } }
    }
};
template <int mode> struct EpiRwkv2 { static constexpr bool PERM = true;
    bf16_t* O; const float* bias;
    DEVINL void operator()(const Acc& acc, const Unit& u, int wr, int wc, int fr, int fq) const {
        const int row0 = u.pm * BM + wr * 64 + fr, e = u.pn >> 2, d0 = (u.pn & 3) * 256 + wc * 32 + 8 * fq;
#pragma unroll
        for (int ai = 0; ai < 2; ++ai)
#pragma unroll
            for (int m = 0; m < 4; ++m) { bf16_t* rowp = O + (size_t)e * NTOK * DM + (size_t)(row0 + ai * HALF + m * 16) * DM + d0;
#pragma unroll
                for (int bj = 0; bj < 2; ++bj) { const int d = d0 + bj * HALF;
                    st_bf8(rowp + bj * HALF, acc[ai][bj][m][0] + *(const f32x4*)(bias + e * DM + d), acc[ai][bj][m][1] + *(const f32x4*)(bias + e * DM + d + 4)); } }
    }
};

DEVINL void convT(float* tile, const float* src, int ldsrc, int K, int N, bf16_t* dst, int ldd, int drow0, int dcol0, const float* rs, int rdiv, int rmul, int bid = -1, int nb = 0) {
    const int tid = otid(), tK = (K + 63) / 64, tN = (N + 63) / 64;
    if (bid < 0) { bid = obid(); nb = gridDim.x; }
    for (int t = bid; t < tK * tN; t += nb) {
        const int k0 = (t / tN) * 64, n0 = (t % tN) * 64;
        __syncthreads();
#pragma unroll
        for (int p = 0; p < 8; ++p) { const int i = (tid >> 6) + 8 * p, j = tid & 63; float v = 0.f;
            if (k0 + i < K && n0 + j < N) { v = src[(size_t)(k0 + i) * ldsrc + n0 + j]; if (rs) v *= rs[k0 + i]; }
            tile[i * 65 + j] = v; }
        __syncthreads();
#pragma unroll
        for (int p = 0; p < 4; ++p) { const int j = (tid >> 5) + 16 * p, i = (tid & 31) * 2, n = n0 + j;
            if (n < N && k0 + i < K) { const int row = (n / rdiv) * rmul + (n % rdiv) + drow0;
                *(unsigned*)(dst + (size_t)row * ldd + dcol0 + k0 + i) = pk2(tile[i * 65 + j], tile[(i + 1) * 65 + j]); } }
    }
}
DEVINL void zero2d(bf16_t* dst, int ld, int r0, int r1, int c0, int c1, int bid = -1, int nb = 0) {
    const int w = (c1 - c0) / 2, n = (r1 - r0) * w;
    if (bid < 0) { bid = obid(); nb = gridDim.x; }
    for (int i = bid * 512 + otid(); i < n; i += nb * 512) { const int r = r0 + i / w, c = c0 + (i % w) * 2; *(unsigned*)(dst + (size_t)r * ld + c) = 0u; }
}
DEVINL void conv_ffn_w(float* tile, const PV& p, int layer, int w, bf16_t* slot, int bid, int nb) {
    const size_t o = (size_t)(layer * 2 + w) * DM * DFF;
    bf16_t* gu = slot + w * (FFN_WGU + FFN_WD); bf16_t* wd = gu + FFN_WGU;
    convT(tile, p.in(8) + o, DFF, DM, DFF, gu, DM, 0, 0, nullptr, 128, 256, bid, nb);
    convT(tile, p.in(9) + o, DFF, DM, DFF, gu, DM, 128, 0, nullptr, 128, 256, bid, nb);
    convT(tile, p.in(10) + o, DM, DFF, DM, wd, DFF, 0, 0, nullptr, 1 << 30, 0, bid, nb);
}
DEVINL void conv_ffn(float* tile, const PV& p, int layer, bf16_t* slot) { conv_ffn_w(tile, p, layer, 0, slot, obid(), gridDim.x); conv_ffn_w(tile, p, layer, 1, slot, obid(), gridDim.x); }

DEVINL void phase_prep(const PV& p, unsigned char* sm) {
    const int tid = otid(), wid = tid >> 6, lane = tid & 63;
    unsigned char* ws = p.ws;
    float* tile = (float*)sm;
    bf16_t* WM = (bf16_t*)(ws + WS_WM);
    {
        float* sc = (float*)sm; float* part = sc + 9 * 1024;
        for (int i = tid; i < 9 * 1024; i += 512) { const float v = i < 8192 ? p.in(1)[i] : p.in(3)[i - 8192]; sc[i] = silu_f(v); }
        __syncthreads();
        float* MOD = (float*)(ws + WS_MOD);
        for (int it = obid(); it < 4 * 144; it += gridDim.x) {
            const int layer = it / 144, col = (it % 144) * 64 + lane;
            const float* W = p.in(4) + (size_t)layer * DM * MODW + col;
            float a[9];
#pragma unroll
            for (int r = 0; r < 9; ++r) a[r] = 0.f;
            const int kb = wid * 128;
#pragma unroll 16
            for (int k = 0; k < 128; ++k) { const float w = W[(size_t)(kb + k) * MODW];
#pragma unroll
                for (int r = 0; r < 9; ++r) a[r] += sc[r * 1024 + kb + k] * w; }
#pragma unroll
            for (int r = 0; r < 9; ++r) part[(wid * 9 + r) * 64 + lane] = a[r];
            __syncthreads();
            for (int o = tid; o < 9 * 64; o += 512) { const int r = o >> 6, l = o & 63; float s = 0.f;
#pragma unroll
                for (int w = 0; w < 8; ++w) s += part[(w * 9 + r) * 64 + l];
                const int c = (it % 144) * 64 + l;
                MOD[((size_t)layer * 9 + r) * MODW + c] = s + p.in(5)[(size_t)layer * MODW + c]; }
            __syncthreads();
        }
    }
    { float* ct = (float*)(ws + WS_ROPE); float* st = ct + 1024;
      for (int i = obid() * 512 + tid; i < 1024; i += gridDim.x * 512) { const int pos = i >> 4, pp = i & 15;
          const float inv = exp2f(-(float)pp * (13.287712379549449f / 16.f)); const float ang = (float)pos * inv; ct[i] = cosf(ang); st[i] = sinf(ang); } }
    conv_ffn(tile, p, 0, (bf16_t*)(ws + WS_WF));
    for (int j = 0; j < 1; ++j) {
        bf16_t* M = WM + (j ? WM_MLA1 : WM_MLA0);
        convT(tile, p.in(11) + (size_t)j * 1024 * 512, 512, 1024, 512, M + MLA_DQKV, 1024, 0, 0, nullptr, 1 << 30, 0);
        convT(tile, p.in(14) + (size_t)j * 1024 * 320, 320, 1024, 320, M + MLA_DQKV, 1024, 512, 0, nullptr, 1 << 30, 0);
        zero2d(M + MLA_DQKV, 1024, 832, 1024, 0, 1024);
        convT(tile, p.in(13) + (size_t)j * 512 * 1536, 1536, 512, 1536, M + MLA_UQ, 512, 0, 0, nullptr, 1 << 30, 0);
        convT(tile, p.in(16) + (size_t)j * 256 * 2048, 2048, 256, 2048, M + MLA_UKV, 256, 0, 0, nullptr, 1 << 30, 0);
        convT(tile, p.in(17) + (size_t)j * 1024 * 1024, 1024, 1024, 1024, M + MLA_WO, 1024, 0, 0, nullptr, 1 << 30, 0);
    }
    __syncthreads();
}

DEVINL void prep_late(const PV& p, unsigned char* sm, int bid, int nb) {
    const int tid = otid(), wid = tid >> 6, lane = tid & 63;
    unsigned char* ws = p.ws;
    float* tile = (float*)sm;
    bf16_t* WM = (bf16_t*)(ws + WS_WM);
    (void)wid; (void)lane;
    { bf16_t* DT = WM + WM_DT2;
      for (size_t i = (size_t)bid * 512 + tid; i < (size_t)4096 * 1024; i += (size_t)nb * 512) {
          const int row = (int)(i >> 10), t = (int)(i & 1023) * 2, cs = row >> 11, to = row & 2047;
          float v[2];
#pragma unroll
          for (int q = 0; q < 2; ++q) { const int mm = (to * (t + q)) & 2047; const float x = (float)mm * (1.f / 1024.f); v[q] = (cs ? sinpif(x) : cospif(x)) * 0.022097086912079608f; }
          *(unsigned*)(DT + (size_t)row * 2048 + t) = pk2(v[0], v[1]); }
      bf16_t* DC = WM + WM_DT2C;
      for (int i = bid * 512 + tid; i < 512 * 128; i += nb * 512) {
          const int row = i >> 7, t = (i & 127) * 2, cs = row >> 8, to = row & 255;
          float v[2];
#pragma unroll
          for (int q = 0; q < 2; ++q) { const int mm = (to * (t + q)) & 255; const float x = (float)mm * (1.f / 128.f); v[q] = (cs ? sinpif(x) : cospif(x)) * 0.0625f; }
          *(unsigned*)(DC + (size_t)row * 256 + t) = pk2(v[0], v[1]); } }
    {
        __syncthreads();
        float* ctab = (float*)sm; float* stab = ctab + 128; float* wt = ctab + 256;
        if (tid < 128) { const float x = (float)tid * (1.f / 64.f); ctab[tid] = cospif(x) * 0.08838834764831845f; stab[tid] = -sinpif(x) * 0.08838834764831845f; }
        bf16_t* W2 = WM + WM_W2T; const float* wo = p.in(18);
        for (int it = bid; it < 128; it += nb) {
            const int g = it >> 4, n0 = (it & 15) * 64;
            __syncthreads();
            for (int q = tid; q < 128 * 64; q += 512) wt[q] = wo[(size_t)(g * 128 + (q >> 6)) * DM + n0 + (q & 63)];
            __syncthreads();
            const int k = tid & 127, cs = (tid >> 7) & 1, ng = tid >> 8; const float* tab = cs ? stab : ctab;
            float acc[32];
#pragma unroll
            for (int q = 0; q < 32; ++q) acc[q] = 0.f;
            for (int j = 0; j < 128; ++j) { const float t = tab[(k * j) & 127]; const float* wr = wt + j * 64 + ng * 32;
#pragma unroll
                for (int q = 0; q < 32; q += 4) { const f32x4 w4 = *(const f32x4*)(wr + q); acc[q] += t * w4[0]; acc[q + 1] += t * w4[1]; acc[q + 2] += t * w4[2]; acc[q + 3] += t * w4[3]; } }
#pragma unroll
            for (int q = 0; q < 32; ++q) W2[(size_t)(n0 + ng * 32 + q) * 2048 + cs * 1024 + g * 128 + k] = f2bf(acc[q]);
        }
        __syncthreads();
    }
    for (int j = 1; j < 2; ++j) {
        bf16_t* M = WM + (j ? WM_MLA1 : WM_MLA0);
        convT(tile, p.in(11) + (size_t)j * 1024 * 512, 512, 1024, 512, M + MLA_DQKV, 1024, 0, 0, nullptr, 1 << 30, 0, bid, nb);
        convT(tile, p.in(14) + (size_t)j * 1024 * 320, 320, 1024, 320, M + MLA_DQKV, 1024, 512, 0, nullptr, 1 << 30, 0, bid, nb);
        zero2d(M + MLA_DQKV, 1024, 832, 1024, 0, 1024, bid, nb);
        convT(tile, p.in(13) + (size_t)j * 512 * 1536, 1536, 512, 1536, M + MLA_UQ, 512, 0, 0, nullptr, 1 << 30, 0, bid, nb);
        convT(tile, p.in(16) + (size_t)j * 256 * 2048, 2048, 256, 2048, M + MLA_UKV, 256, 0, 0, nullptr, 1 << 30, 0, bid, nb);
        convT(tile, p.in(17) + (size_t)j * 1024 * 1024, 1024, 1024, 1024, M + MLA_WO, 1024, 0, 0, nullptr, 1 << 30, 0, bid, nb);
    }
    {
        bf16_t* WC = WM + WM_WCAT; const float* mix = p.in(20);
        for (int h = 0; h < 2; ++h) { const int dc = h * 1024;
            convT(tile, p.in(21), 1024, 1024, 1024, WC, 2048, 0, dc, h ? mix + 0 * 1024 : nullptr, 1 << 30, 0, bid, nb);
            convT(tile, p.in(22), 1024, 1024, 1024, WC, 2048, 1024, dc, h ? mix + 2 * 1024 : nullptr, 1 << 30, 0, bid, nb);
            convT(tile, p.in(23), 1024, 1024, 1024, WC, 2048, 2048, dc, h ? mix + 3 * 1024 : nullptr, 1 << 30, 0, bid, nb);
            for (int e = 0; e < 2; ++e) {
                convT(tile, p.in(25) + (size_t)e * 1024 * 64, 64, 1024, 64, WC, 2048, 3072 + e * 64, dc, h ? mix + 1 * 1024 : nullptr, 1 << 30, 0, bid, nb);
                convT(tile, p.in(28) + (size_t)e * 1024 * 64, 64, 1024, 64, WC, 2048, 3200 + e * 64, dc, h ? mix + 4 * 1024 : nullptr, 1 << 30, 0, bid, nb); }
            convT(tile, p.in(30), 160, 1024, 160, WC, 2048, 3328, dc, h ? mix + 5 * 1024 : nullptr, 1 << 30, 0, bid, nb); }
        zero2d(WC, 2048, 3488, 3584, 0, 2048, bid, nb);
        bf16_t* BW = WM + WM_BW; bf16_t* BA = WM + WM_BA; bf16_t* BG = WM + WM_BG;
        for (int e = 0; e < 2; ++e) {
            convT(tile, p.in(26) + (size_t)e * 64 * 1024, 1024, 64, 1024, BW, 256, e * 1024, e * 64, nullptr, 1 << 30, 0, bid, nb);
            convT(tile, p.in(29) + (size_t)e * 64 * 1024, 1024, 64, 1024, BA, 256, e * 1024, 128 + e * 64, nullptr, 1 << 30, 0, bid, nb);
            zero2d(BW, 256, e * 1024, e * 1024 + 1024, (1 - e) * 64, (1 - e) * 64 + 64, bid, nb); zero2d(BW, 256, e * 1024, e * 1024 + 1024, 128, 256, bid, nb);
            zero2d(BA, 256, e * 1024, e * 1024 + 1024, 128 + (1 - e) * 64, 128 + (1 - e) * 64 + 64, bid, nb); zero2d(BA, 256, e * 1024, e * 1024 + 1024, 0, 128, bid, nb); }
        convT(tile, p.in(31), 1024, 160, 1024, BG, 256, 0, 0, nullptr, 1 << 30, 0, bid, nb);
        zero2d(BG, 256, 0, 1024, 160, 256, bid, nb);
        convT(tile, p.in(37), 1024, 1024, 1024, WM + WM_RWO, 1024, 0, 0, nullptr, 1 << 30, 0, bid, nb);
    }
    __syncthreads();
}

struct RowArgs {
    const float* hin_l; const float* hin_c; float* hout_l; float* hout_c;
    const float* Y; const float* modp; int subp; const float* gpost; float coef;
    const float* modn; int subn; const float* gpre;
    bf16_t* xn; int xn_ld; int nrows; int upd_ctx; const float* Ys; int nslab;
    int pad_;
};
struct RowIn { f32x4 h[4], y[4]; };
DEVINL void row_load(const RowArgs& a, int r, int lane, RowIn& v) {
    const bool lat = r < NLAT; const int rc = r - NLAT;
    const float* hin = lat ? a.hin_l + (size_t)r * DM : a.hin_c + (size_t)rc * DM;
#pragma unroll
    for (int i = 0; i < 4; ++i) v.h[i] = *(const f32x4*)(hin + i * 256 + lane * 4);
    if (a.Y != nullptr && (lat || a.upd_ctx)) {
        if (lat || a.nslab == 0) {
#pragma unroll
            for (int i = 0; i < 4; ++i) { const u32x2 w = *(const u32x2*)((const bf16_t*)a.Y + (size_t)r * DM + i * 256 + lane * 4); v.y[i] = (f32x4){lo_bf(w.x), hi_bf(w.x), lo_bf(w.y), hi_bf(w.y)}; }
        } else {
#pragma unroll
            for (int i = 0; i < 4; ++i) v.y[i] = *(const f32x4*)(a.Ys + (size_t)rc * DM + i * 256 + lane * 4);
            for (int sl = 1; sl < a.nslab; ++sl) {
#pragma unroll
                for (int i = 0; i < 4; ++i) v.y[i] += *(const f32x4*)(a.Ys + ((size_t)sl * NCTX + rc) * DM + i * 256 + lane * 4); }
        }
    }
}
DEVINL void row_math(const RowArgs& a, int r, int lane, RowIn& v, f32x4 (&xo)[4]) {
    const bool lat = r < NLAT; const int rc = r - NLAT; const int mrow = lat ? (r >> 11) : 8;
    const float* hin = lat ? a.hin_l + (size_t)r * DM : a.hin_c + (size_t)rc * DM;
    float* hout = lat ? a.hout_l + (size_t)r * DM : a.hout_c + (size_t)rc * DM;
    const bool upd = a.Y != nullptr && (lat || a.upd_ctx);
    if (upd) {
        float ss = 0.f;
#pragma unroll
        for (int i = 0; i < 4; ++i)
#pragma unroll
            for (int j = 0; j < 4; ++j) ss += v.y[i][j] * v.y[i][j];
        ss = wave_sum_dpp(ss); const float rs = rsqrtf(ss * (1.f / 1024.f) + EPS) * a.coef;
        const float* gate = a.modp + (size_t)mrow * MODW + (a.subp * 3 + 2) * 1024;
#pragma unroll
        for (int i = 0; i < 4; ++i) { const int c = i * 256 + lane * 4; const f32x4 gt = *(const f32x4*)(gate + c), gp = *(const f32x4*)(a.gpost + c);
            v.h[i] += gt * (v.y[i] * gp) * rs; }
    }
    if (upd || hin != hout) {
#pragma unroll
        for (int i = 0; i < 4; ++i) *(f32x4*)(hout + i * 256 + lane * 4) = v.h[i];
    }
    if (a.modn) {
        float ss = 0.f;
#pragma unroll
        for (int i = 0; i < 4; ++i)
#pragma unroll
            for (int j = 0; j < 4; ++j) ss += v.h[i][j] * v.h[i][j];
        ss = wave_sum_dpp(ss); const float rs = rsqrtf(ss * (1.f / 1024.f) + EPS);
        const float* sh = a.modn + (size_t)mrow * MODW + (a.subn * 3 + 0) * 1024; const float* scl = sh + 1024;
#pragma unroll
        for (int i = 0; i < 4; ++i) { const int c = i * 256 + lane * 4; const f32x4 g = *(const f32x4*)(a.gpre + c), s1 = *(const f32x4*)(scl + c), s0 = *(const f32x4*)(sh + c);
            xo[i] = (v.h[i] * rs * g) * (s1 + 1.f) + s0; }
    }
}
DEVINL void row_core(const RowArgs& a, int r, int lane, f32x4 (&xo)[4]) { RowIn v; row_load(a, r, lane, v); row_math(a, r, lane, v, xo); }
DEVINL void phase_rows(const RowArgs& a) {
    const int lane = otid() & 63, gw = obid() * 8 + (otid() >> 6), nw = gridDim.x * 8;
    RowIn cur, n1, n2;
    if (gw < a.nrows) row_load(a, gw, lane, cur);
    if (gw + nw < a.nrows) row_load(a, gw + nw, lane, n1);
    for (int r = gw; r < a.nrows; r += nw) {
        if (r + 2 * nw < a.nrows) row_load(a, r + 2 * nw, lane, n2);
        f32x4 xo[4]; row_math(a, r, lane, cur, xo);
        if (a.modn) {
#pragma unroll
            for (int i = 0; i < 4; ++i) st_bf4(a.xn + (size_t)r * a.xn_ld + i * 256 + lane * 4, xo[i]);
        }
        cur = n1; n1 = n2;
    }
}
DEVINL void phase_rows_T(const RowArgs& a, unsigned char* sm, bf16_t* XT, bf16_t* XTc) {
    const int tid = otid(), wid = tid >> 6, lane = tid & 63;
    constexpr int RS = 2052;
    for (int tl = obid(); tl < NTOK / 64; tl += gridDim.x) {
        __syncthreads();
        RowIn cur, nxt; row_load(a, tl * 64 + wid * 8, lane, cur);
        for (int q = 0; q < 8; ++q) { const int lr = wid * 8 + q, r = tl * 64 + lr; f32x4 xo[4];
            if (q < 7) row_load(a, r + 1, lane, nxt);
            row_math(a, r, lane, cur, xo); cur = nxt;
#pragma unroll
            for (int i = 0; i < 4; ++i) { u32x2 w; w.x = pk2(xo[i][0], xo[i][1]); w.y = pk2(xo[i][2], xo[i][3]);
                unsigned* dp = (unsigned*)(sm + lr * RS + (i * 256 + lane * 4) * 2); dp[0] = w.x; dp[1] = w.y; } }
        __syncthreads();
        const int r0 = tl * 64; const bool lat = r0 < NLAT; const int b = lat ? (r0 >> 11) : ((r0 - NLAT) >> 8), t0 = lat ? (r0 & 2047) : ((r0 - NLAT) & 255), T = lat ? 2048 : 256;
        bf16_t* dstb = (lat ? XT : XTc) + (size_t)b * 1024 * T + t0;
        for (int it = tid; it < 1024 * 8; it += 512) { const int d = it >> 3, tc = it & 7; unsigned w[4];
#pragma unroll
            for (int q = 0; q < 4; ++q) { const unsigned lo = *(const bf16_t*)(sm + (tc * 8 + q * 2) * RS + d * 2), hi = *(const bf16_t*)(sm + (tc * 8 + q * 2 + 1) * RS + d * 2); w[q] = lo | (hi << 16); }
            *(u32x4*)(dstb + (size_t)d * T + tc * 8) = (u32x4){w[0], w[1], w[2], w[3]}; }
    }
    __syncthreads();
}

DEVINL void phase_mla_norm(const PV& p, int j, const float* raw, bf16_t* QN, bf16_t* CKVN, bf16_t* Kb) {
    const int lane = otid() & 63, gw = obid() * 8 + (otid() >> 6), nw = gridDim.x * 8;
    const float* qg = p.in(12) + j * 512; const float* kg = p.in(15) + j * 256;
    const float* ct = (const float*)(p.ws + WS_ROPE); const float* st = ct + 1024;
    for (int r = gw; r < NTOK; r += nw) {
        const float* row = raw + (size_t)r * 1024;
        f32x4 q0 = *(const f32x4*)(row + lane * 4), q1 = *(const f32x4*)(row + 256 + lane * 4), kv = *(const f32x4*)(row + 512 + lane * 4);
        const float kp = row[768 + lane];
        float sq = 0.f, sk = 0.f;
#pragma unroll
        for (int i = 0; i < 4; ++i) { sq += q0[i] * q0[i] + q1[i] * q1[i]; sk += kv[i] * kv[i]; }
        sq = wave_sum_dpp(sq); sk = wave_sum_dpp(sk);
        const float rq = rsqrtf(sq * (1.f / 512.f) + EPS), rk = rsqrtf(sk * (1.f / 256.f) + EPS);
        st_bf4(QN + (size_t)r * 512 + lane * 4, q0 * rq * *(const f32x4*)(qg + lane * 4));
        st_bf4(QN + (size_t)r * 512 + 256 + lane * 4, q1 * rq * *(const f32x4*)(qg + 256 + lane * 4));
        st_bf4(CKVN + (size_t)r * 256 + lane * 4, kv * rk * *(const f32x4*)(kg + lane * 4));
        int b, tk; bool lat; tok_of_row(r, b, tk, lat);
        const float other = __shfl_xor(kp, 16); float o = kp;
        if (lat) { const int axis = lane >> 5, half = (lane >> 4) & 1, pp = lane & 15, pos = axis == 0 ? (tk >> 6) : (tk & 63);
            const float c = ct[pos * 16 + pp], s = st[pos * 16 + pp];
            o = half == 0 ? kp * c - other * s : kp * c + other * s; }
        const bf16_t ob = f2bf(o);
#pragma unroll
        for (int h = 0; h < 8; ++h) Kb[((size_t)(b * 8 + h) * TKV + tk) * 192 + 128 + lane] = ob;
    }
}

constexpr int QBLK = 32, KVBLK = 64, NW = 8;
constexpr float ATT_SCALE = 0.07216878364870322f;
constexpr float ATT_THR = 8.f;
constexpr size_t SHM_V = KVBLK * 128 * 2, SHM_K = KVBLK * 192 * 2;
#define KSWZ(row, colB) ((row) * 384 + ((colB) ^ ((((row) >> 1) & 7) << 4)))
#define SBAR() __builtin_amdgcn_sched_barrier(0)
DEVINL int crow(int r, int hi) { return (r & 3) + 8 * (r >> 2) + 4 * hi; }
DEVINL void partialSM(f32x16& p0, f32x16& p1, float& m_reg, float& mn, float& alpha) {
    constexpr float C = ATT_SCALE * 1.4426950408889634f;
    float pmax = p0[0];
#pragma unroll
    for (int r = 1; r < 16; ++r) pmax = fmaxf(pmax, p0[r]);
#pragma unroll
    for (int r = 0; r < 16; ++r) pmax = fmaxf(pmax, p1[r]);
    { auto rr = __builtin_amdgcn_permlane32_swap(__float_as_uint(pmax), __float_as_uint(pmax), false, false);
      pmax = fmaxf(__uint_as_float(rr[0]), __uint_as_float(rr[1])); }
    if (__builtin_expect(__all(pmax - m_reg <= ATT_THR / ATT_SCALE), 1)) { mn = m_reg; alpha = 1.f; }
    else { mn = fmaxf(m_reg, pmax); alpha = __builtin_amdgcn_exp2f((m_reg - mn) * C); m_reg = mn; }
    const float mnC = -mn * C;
#pragma unroll
    for (int r = 0; r < 16; ++r) p0[r] = fmaf(p0[r], C, mnC);
#pragma unroll
    for (int r = 0; r < 16; ++r) p1[r] = fmaf(p1[r], C, mnC);
#pragma unroll
    for (int r = 0; r < 16; ++r) p0[r] = __builtin_amdgcn_exp2f(p0[r]);
}
DEVINL void finishSM(f32x16& p0, f32x16& p1, float alpha, float& l_reg, bf16x8& pa0, bf16x8& pa1, bf16x8& pa2, bf16x8& pa3) {
#pragma unroll
    for (int r = 0; r < 16; ++r) p1[r] = __builtin_amdgcn_exp2f(p1[r]);
    float ps = 0;
#pragma unroll
    for (int r = 0; r < 16; ++r) ps += p0[r];
#pragma unroll
    for (int r = 0; r < 16; ++r) ps += p1[r];
    { auto rr = __builtin_amdgcn_permlane32_swap(__float_as_uint(ps), __float_as_uint(ps), false, false);
      ps = __uint_as_float(rr[0]) + __uint_as_float(rr[1]); }
    l_reg = l_reg * alpha + ps;
#define PK4(P, BASE, OUT) do { unsigned a0 = pk2(P[BASE + 0], P[BASE + 1]), a1 = pk2(P[BASE + 2], P[BASE + 3]);   \
    unsigned b0 = pk2(P[BASE + 4], P[BASE + 5]), b1 = pk2(P[BASE + 6], P[BASE + 7]);                              \
    auto r0 = __builtin_amdgcn_permlane32_swap(a0, b0, false, false); auto r1 = __builtin_amdgcn_permlane32_swap(a1, b1, false, false); \
    u32x4 w = {r0[0], r1[0], r0[1], r1[1]}; OUT = *reinterpret_cast<bf16x8*>(&w); } while (0)
    PK4(p0, 0, pa0); PK4(p0, 8, pa1); PK4(p1, 0, pa2); PK4(p1, 8, pa3);
#undef PK4
}
DEVINL void qkt(f32x16& p0, f32x16& p1, const char* Ks, const bf16x8* qr, const char* qpe, int qsw, int r32, int hi) {
    p0 = f32x16{}; p1 = f32x16{};
#pragma unroll
    for (int d0 = 0; d0 < 12; ++d0) { const int cb = (d0 * 16 + hi * 8) * 2;
        const bf16x8 b0 = *reinterpret_cast<const bf16x8*>(Ks + KSWZ(r32, cb));
        const bf16x8 b1 = *reinterpret_cast<const bf16x8*>(Ks + KSWZ(32 + r32, cb));
        const bf16x8 q = d0 < 8 ? qr[d0 < 8 ? d0 : 0] : *reinterpret_cast<const bf16x8*>(qpe + (((((d0 - 8) * 2 + hi) ^ qsw) & 7) << 4));
        p0 = __builtin_amdgcn_mfma_f32_32x32x16_bf16(b0, q, p0, 0, 0, 0);
        p1 = __builtin_amdgcn_mfma_f32_32x32x16_bf16(b1, q, p1, 0, 0, 0); }
}
DEVINL int v_st(int k, int c) { const int kk = (k & ~0xC) | ((k & 4) << 1) | ((k & 8) >> 1); return ((kk >> 3) * 4 + (c >> 5)) * 512 + ((kk & 7) * 32 + (c & 31)) * 2; }
DEVINL int v_rd_base(int lane) { return ((lane & 3) << 3) | (((lane >> 2) & 3) << 6) | (((lane >> 4) & 1) << 5) | (((lane >> 5) & 1) << 8); }
constexpr int v_rd_off(int d0, int ks, int half) { return d0 * 512 + ks * 4096 + half * 2048; }
template <int OFF> DEVINL s16x4 tr_read(int vb) { s16x4 r; asm volatile("ds_read_b64_tr_b16 %0, %1 offset:%2" : "=&v"(r) : "v"(vb), "i"(OFF) : "memory"); return r; }
template <int D0> DEVINL void pv_one(f32x16& od, int vb, bf16x8 pa0, bf16x8 pa1, bf16x8 pa2, bf16x8 pa3) {
    const s16x4 l0 = tr_read<v_rd_off(D0, 0, 0)>(vb), h0 = tr_read<v_rd_off(D0, 0, 1)>(vb), l1 = tr_read<v_rd_off(D0, 1, 0)>(vb), h1 = tr_read<v_rd_off(D0, 1, 1)>(vb);
    const s16x4 l2 = tr_read<v_rd_off(D0, 2, 0)>(vb), h2 = tr_read<v_rd_off(D0, 2, 1)>(vb), l3 = tr_read<v_rd_off(D0, 3, 0)>(vb), h3 = tr_read<v_rd_off(D0, 3, 1)>(vb);
    asm volatile("s_waitcnt lgkmcnt(0)" ::: "memory"); SBAR();
#define PK(L, H) (bf16x8){L[0], L[1], L[2], L[3], H[0], H[1], H[2], H[3]}
    od = __builtin_amdgcn_mfma_f32_32x32x16_bf16(pa0, PK(l0, h0), od, 0, 0, 0);
    od = __builtin_amdgcn_mfma_f32_32x32x16_bf16(pa1, PK(l1, h1), od, 0, 0, 0);
    od = __builtin_amdgcn_mfma_f32_32x32x16_bf16(pa2, PK(l2, h2), od, 0, 0, 0);
    od = __builtin_amdgcn_mfma_f32_32x32x16_bf16(pa3, PK(l3, h3), od, 0, 0, 0);
#undef PK
}
DEVINL void pv_d0(f32x16* o, int vb, bf16x8 pa0, bf16x8 pa1, bf16x8 pa2, bf16x8 pa3) {
    pv_one<0>(o[0], vb, pa0, pa1, pa2, pa3); pv_one<1>(o[1], vb, pa0, pa1, pa2, pa3); pv_one<2>(o[2], vb, pa0, pa1, pa2, pa3); pv_one<3>(o[3], vb, pa0, pa1, pa2, pa3);
}
DEVINL void attn_body(const bf16_t* __restrict__ Qb, const bf16_t* __restrict__ Kh, const bf16_t* __restrict__ Vh, bf16_t* __restrict__ Ob, int seq, char* lds) {
    const int tid = otid(), wid = tid >> 6, lane = tid & 63, r32 = lane & 31, hi = lane >> 5;
    char* V_lds = lds; char* K_lds = lds + 2 * SHM_V;
    float* wsm = (float*)(lds + 2 * SHM_V + 2 * SHM_K) + wid * 64; float* li_l = wsm; float* al_l = wsm + 32;
    float m_reg = -1e30f, l_reg = 0; f32x16 o[4] = {}; bf16x8 qr[8];
    const bf16_t* Qw = Qb + (long)(wid * QBLK + r32) * 192 + hi * 8;
    char* qpe = lds + 2 * SHM_V + 2 * SHM_K + 2048 + wid * 4096 + r32 * 128; const int qsw = (r32 >> 1) & 7;
#pragma unroll
    for (int d0 = 0; d0 < 8; ++d0) qr[d0] = *reinterpret_cast<const bf16x8*>(Qw + d0 * 16);
#pragma unroll
    for (int d0 = 8; d0 < 12; ++d0) *reinterpret_cast<bf16x8*>(qpe + (((((d0 - 8) * 2 + hi) ^ qsw) & 7) << 4)) = *reinterpret_cast<const bf16x8*>(Qw + d0 * 16);
    const int sr = tid >> 4, sc = (tid & 15) * 8, vst0 = v_st(sr, sc), vst1 = v_st(32 + sr, sc);
    int kst[3];
#pragma unroll
    for (int i = 0; i < 3; ++i) { const int id = tid + 512 * i, row = id / 24, ch = id % 24; kst[i] = KSWZ(row, ch * 16); }
    const int vb0 = (int)(uintptr_t)V_lds + v_rd_base(lane);
    bf16x8 vs0, vs1, ks0, ks1, ks2;
#define SLOAD(k0) do { vs0 = *reinterpret_cast<const bf16x8*>(&Vh[(long)((k0) + sr) * 128 + sc]); vs1 = *reinterpret_cast<const bf16x8*>(&Vh[(long)((k0) + 32 + sr) * 128 + sc]); \
    const bf16_t* kp_ = Kh + (long)(k0) * 192 + tid * 8; ks0 = *reinterpret_cast<const bf16x8*>(kp_); ks1 = *reinterpret_cast<const bf16x8*>(kp_ + 4096); ks2 = *reinterpret_cast<const bf16x8*>(kp_ + 8192); } while (0)
#define SWRITE(b) do { *(bf16x8*)(V_lds + (b) * SHM_V + vst0) = vs0; *(bf16x8*)(V_lds + (b) * SHM_V + vst1) = vs1; \
    *(bf16x8*)(K_lds + (b) * SHM_K + kst[0]) = ks0; *(bf16x8*)(K_lds + (b) * SHM_K + kst[1]) = ks1; *(bf16x8*)(K_lds + (b) * SHM_K + kst[2]) = ks2; } while (0)
#define RESC(a) do { if (__any((a) < 1.f)) { if (hi == 0) al_l[r32] = (a); asm volatile("s_waitcnt lgkmcnt(0)" ::: "memory"); \
    _Pragma("unroll") for (int d = 0; d < 4; ++d) _Pragma("unroll") for (int r = 0; r < 16; ++r) o[d][r] *= al_l[crow(r, hi)]; } } while (0)
    f32x16 pA0, pA1, pB0, pB1; float mnA, mnB, alA, alB; bf16x8 pa0, pa1, pa2, pa3; const int NT = seq / KVBLK;
    __syncthreads();
    SLOAD(0); WAIT_V0(); SWRITE(0); __syncthreads();
    qkt(pA0, pA1, K_lds, qr, qpe, qsw, r32, hi); partialSM(pA0, pA1, m_reg, mnA, alA);
    SLOAD(KVBLK);
    WAIT_V0(); SWRITE(1); __syncthreads();
    for (int j = 1; j + 1 < NT; j += 2) {
        SBAR(); qkt(pB0, pB1, K_lds + SHM_K, qr, qpe, qsw, r32, hi);
        finishSM(pA0, pA1, alA, l_reg, pa0, pa1, pa2, pa3); SBAR();
        SLOAD((j + 1) * KVBLK); SBAR();
        pv_d0(o, vb0, pa0, pa1, pa2, pa3); partialSM(pB0, pB1, m_reg, mnB, alB);
        __syncthreads(); WAIT_V0(); SWRITE(0);
        RESC(alB); __syncthreads();
        SBAR(); qkt(pA0, pA1, K_lds, qr, qpe, qsw, r32, hi);
        finishSM(pB0, pB1, alB, l_reg, pa0, pa1, pa2, pa3); SBAR();
        SLOAD((j + 2) * KVBLK); SBAR();
        pv_d0(o, vb0 + (int)SHM_V, pa0, pa1, pa2, pa3); partialSM(pA0, pA1, m_reg, mnA, alA);
        __syncthreads(); WAIT_V0(); SWRITE(1);
        RESC(alA); __syncthreads();
    }
    SBAR(); qkt(pB0, pB1, K_lds + SHM_K, qr, qpe, qsw, r32, hi);
    finishSM(pA0, pA1, alA, l_reg, pa0, pa1, pa2, pa3); SBAR();
    pv_d0(o, vb0, pa0, pa1, pa2, pa3); partialSM(pB0, pB1, m_reg, mnB, alB);
    __syncthreads(); RESC(alB);
    finishSM(pB0, pB1, alB, l_reg, pa0, pa1, pa2, pa3); SBAR();
    pv_d0(o, vb0 + (int)SHM_V, pa0, pa1, pa2, pa3);
    if (hi == 0) li_l[r32] = l_reg; asm volatile("s_waitcnt lgkmcnt(0)" ::: "memory");
    float rli[16];
#pragma unroll
    for (int r = 0; r < 16; ++r) rli[r] = __builtin_amdgcn_rcpf(li_l[crow(r, hi)]);
    bf16_t* Ow = Ob + (long)(wid * QBLK) * 1024;
#pragma unroll
    for (int r = 0; r < 16; ++r) { const int orow = crow(r, hi);
#pragma unroll
        for (int d0 = 0; d0 < 4; ++d0) Ow[(long)orow * 1024 + d0 * 32 + r32] = f2bf(o[d0][r] * rli[r]); }
#undef SLOAD
#undef SWRITE
#undef RESC
}
DEVINL void phase_attn(const bf16_t* Q, const bf16_t* K, const bf16_t* V, bf16_t* O, bool with_ctx, char* lds) {
    const int nu = 512 + (with_ctx ? 64 : 0);
    for (int u = obid(); u < nu; u += gridDim.x) {
        if (u < 512) {
            int bh = u >> 3, qb = u & 7;
            if (gridDim.x == 256) { const int x = u & 7, l = (u >> 8) * 32 + ((u & 255) >> 3); bh = x * 8 + (l >> 3); qb = l & 7; }
            const int b = bh >> 3, h = bh & 7;
            attn_body(Q + ((size_t)bh * TKV + qb * 256) * 192, K + (size_t)bh * TKV * 192, V + (size_t)bh * TKV * 128, O + ((size_t)(b * SEQ + qb * 256)) * 1024 + h * 128, TKV, lds); }
        else { const int bh = u - 512, b = bh >> 3, h = bh & 7;
            attn_body(Q + ((size_t)bh * TKV + SEQ) * 192, K + ((size_t)bh * TKV + SEQ) * 192, V + ((size_t)bh * TKV + SEQ) * 128, O + ((size_t)(NLAT + b * CTX)) * 1024 + h * 128, CTX, lds); }
    }
    __syncthreads();
}

DEVINL void phase_rwkv_shift(bf16_t* XN) {
    for (size_t it = (size_t)obid() * 512 + otid(); it < (size_t)NTOK * 128; it += (size_t)gridDim.x * 512) {
        const int r = (int)(it >> 7), c = (int)(it & 127) * 8; int b, tk; bool lat; tok_of_row(r, b, tk, lat);
        const int t = lat ? tk : tk - SEQ, T = lat ? SEQ : CTX;
        const bf16_t* up = XN + (size_t)r * 2048 + c;
        const u32x4 u0 = *(const u32x4*)up; u32x4 um = {0, 0, 0, 0}, upl = {0, 0, 0, 0};
        if (t > 0) um = *(const u32x4*)(up - 2048);
        if (t < T - 1) upl = *(const u32x4*)(up + 2048);
        u32x4 o;
#pragma unroll
        for (int q = 0; q < 4; ++q) { const float a = 0.5f * (lo_bf(um[q]) + lo_bf(upl[q])) - lo_bf(u0[q]), bq = 0.5f * (hi_bf(um[q]) + hi_bf(upl[q])) - hi_bf(u0[q]); o[q] = pk2(a, bq); }
        *(u32x4*)(XN + (size_t)r * 2048 + 1024 + c) = o;
    }
}
DEVINL void zero_f32(float* p, size_t n4) { for (size_t i = (size_t)obid() * 512 + otid(); i < n4; i += (size_t)gridDim.x * 512) ((f32x4*)p)[i] = (f32x4){0.f, 0.f, 0.f, 0.f}; }

DEVINL float red8(float v) {
    v += __builtin_bit_cast(float, __builtin_amdgcn_update_dpp(0, __builtin_bit_cast(int, v), 0xB1, 0xF, 0xF, false));
    v += __builtin_bit_cast(float, __builtin_amdgcn_update_dpp(0, __builtin_bit_cast(int, v), 0x4E, 0xF, 0xF, false));
    v += __builtin_bit_cast(float, __builtin_amdgcn_update_dpp(0, __builtin_bit_cast(int, v), 0x141, 0xF, 0xF, false));
    return v;
}
typedef float f32x2 __attribute__((ext_vector_type(2)));
struct StepOps { f32x4 a0, a1, q0, q1, w0, w1, b0, b1, k0, k1; float viA, viB; f32x2 sc2; };
DEVINL void phase_scan(const PV& p, const bf16_t* R, const bf16_t* Kf, const bf16_t* Vf, const bf16_t* AA, const bf16_t* LW, float* Y0, bf16_t* Y1, unsigned char* sm) {
    constexpr int TC = 32, NCH = (CTX + SEQ) / TC;
    const int tid = otid(), wid = __builtin_amdgcn_readfirstlane(tid >> 6), lane = tid & 63;
    float* Fb = (float*)sm;
    float* ybb = Fb + 2 * TC * 384;
    float* sclb = ybb + 2 * TC * 64;
    const float* kkp = p.in(32); const float* kap = p.in(33);
    for (int it = obid(); it < 256; it += gridDim.x) {
        const int e = it >> 7, b = (it >> 4) & 7, h = it & 15, ch = h * 64 + lane;
        __syncthreads();
        if (wid >= 4) {
            const int hw = wid - 4;
            const float k_k = kkp[ch], k_a = kap[ch];
            const bf16_t* Ae = AA + (size_t)e * NTOK * DM; const bf16_t* Le = LW + (size_t)e * NTOK * DM;
            bf16_t pr[8], pk[8], pv[8], pa[8], pl[8];
#define SC_ROW(c_, s_) ({ const int g_ = (c_) * TC + (s_); const bool cx_ = g_ < CTX; const int sl_ = cx_ ? g_ : g_ - CTX, T_ = cx_ ? CTX : SEQ; \
            (cx_ ? NLAT + b * CTX : b * SEQ) + (e == 0 ? sl_ : T_ - 1 - sl_); })
#define SC_LOAD(c_) do { _Pragma("unroll") for (int q = 0; q < 8; ++q) { const size_t o_ = (size_t)SC_ROW(c_, hw + 4 * q) * DM + ch; \
            pr[q] = R[o_]; pk[q] = Kf[o_]; pv[q] = Vf[o_]; pa[q] = Ae[o_]; pl[q] = Le[o_]; } } while (0)
#define SC_DERIVE(c_) do { float* F_ = Fb + ((c_) & 1) * TC * 384; float* scl_ = sclb + ((c_) & 1) * TC * 2; _Pragma("unroll") for (int q = 0; q < 8; ++q) { const int s = hw + 4 * q; \
            const float r = bf2f(pr[q]), k = bf2f(pk[q]), v = bf2f(pv[q]), a = sigm_f(bf2f(pa[q])), nx = -bf2f(pl[q]); \
            const float sp = fmaxf(nx, 0.f) + __logf(1.f + __expf(-fabsf(nx))), w = __expf(-__expf(-sp - 0.5f)); \
            const float kv = k * k_k; const float n2 = wave_sum_dpp(kv * kv); const float kk = kv * __builtin_amdgcn_rsqf(fmaxf(n2, 1e-24f)); \
            const float bb = kk * a, kd = k * (1.f + (a - 1.f) * k_a); \
            const float br = wave_sum_dpp(bb * r), kr = wave_sum_dpp(kd * r); \
            float* f = F_ + s * 384 + lane; \
            f[0] = -kk; f[64] = bb; f[128] = w; f[192] = kd; f[256] = w * r; f[320] = v; \
            if (lane == 0) { scl_[s * 2] = br; scl_[s * 2 + 1] = kr; } } } while (0)
#define SC_FLUSH(c_) do { const float* yb_ = ybb + ((c_) & 1) * TC * 64; _Pragma("unroll") for (int q = 0; q < 8; ++q) { const int s = hw + 4 * q; const size_t o_ = (size_t)SC_ROW(c_, s) * DM + ch; \
            const float yv = yb_[s * 64 + lane]; if (e == 0) Y0[o_] = yv; else Y1[o_] = f2bf(yv); } } while (0)
            SC_LOAD(0); SC_DERIVE(0); SC_LOAD(1);
            __syncthreads();
            for (int c = 0; c < NCH; ++c) {
                if (c + 1 < NCH) { SC_DERIVE(c + 1); if (c + 2 < NCH) SC_LOAD(c + 2); }
                if (c >= 1) SC_FLUSH(c - 1);
                __syncthreads();
            }
            SC_FLUSH(NCH - 1);
#undef SC_LOAD
#undef SC_DERIVE
#undef SC_FLUSH
#undef SC_ROW
        } else {
            f32x2 SA[4], SB[4];
#pragma unroll
            for (int j = 0; j < 4; ++j) { SA[j] = (f32x2){0.f, 0.f}; SB[j] = (f32x2){0.f, 0.f}; }
            const int iA = wid * 16 + (lane >> 3), iB = iA + 8, cg8 = (lane & 7) * 8;
            __syncthreads();
            for (int c = 0; c < NCH; ++c) {
                const float* F = Fb + (c & 1) * TC * 384; float* yb = ybb + (c & 1) * TC * 64; const float* scl = sclb + (c & 1) * TC * 2;
#define ST_LD(o, s_) do { const float* f_ = F + (s_) * 384 + cg8; o.a0 = *(const f32x4*)(f_); o.a1 = *(const f32x4*)(f_ + 4); o.q0 = *(const f32x4*)(f_ + 256); o.q1 = *(const f32x4*)(f_ + 260); \
                o.w0 = *(const f32x4*)(f_ + 128); o.w1 = *(const f32x4*)(f_ + 132); o.b0 = *(const f32x4*)(f_ + 64); o.b1 = *(const f32x4*)(f_ + 68); o.k0 = *(const f32x4*)(f_ + 192); o.k1 = *(const f32x4*)(f_ + 196); \
                o.viA = F[(s_) * 384 + 320 + iA]; o.viB = F[(s_) * 384 + 320 + iB]; o.sc2 = *(const f32x2*)(scl + (s_) * 2); } while (0)
#define P2(v, i) (f32x2){v[i], v[i + 1]}
#define ST_ROW(o, S, vi, irow, s_) do { \
                f32x2 da = S[0] * P2(o.a0, 0), dq = S[0] * P2(o.q0, 0); da += S[1] * P2(o.a0, 2); dq += S[1] * P2(o.q0, 2); \
                da += S[2] * P2(o.a1, 0); dq += S[2] * P2(o.q1, 0); da += S[3] * P2(o.a1, 2); dq += S[3] * P2(o.q1, 2); \
                float sa = da[0] + da[1], sy = dq[0] + dq[1]; \
                sa += DPPF(sa, 0xB1); sy += DPPF(sy, 0xB1); sa += DPPF(sa, 0x4E); sy += DPPF(sy, 0x4E); sa += DPPF(sa, 0x141); sy += DPPF(sy, 0x141); \
                const f32x2 sa2 = {sa, sa}, vi2 = {vi, vi}; \
                S[0] = S[0] * P2(o.w0, 0) + sa2 * P2(o.b0, 0) + vi2 * P2(o.k0, 0); S[1] = S[1] * P2(o.w0, 2) + sa2 * P2(o.b0, 2) + vi2 * P2(o.k0, 2); \
                S[2] = S[2] * P2(o.w1, 0) + sa2 * P2(o.b1, 0) + vi2 * P2(o.k1, 0); S[3] = S[3] * P2(o.w1, 2) + sa2 * P2(o.b1, 2) + vi2 * P2(o.k1, 2); \
                yb[(s_) * 64 + irow] = sy + sa * o.sc2[0] + vi * o.sc2[1]; } while (0)
                StepOps X, Z; ST_LD(X, 0);
#pragma unroll
                for (int s = 0; s < TC; s += 2) {
                    ST_LD(Z, s + 1);
                    ST_ROW(X, SA, X.viA, iA, s); ST_ROW(X, SB, X.viB, iB, s);
                    ST_LD(X, s + 2);
                    ST_ROW(Z, SA, Z.viA, iA, s + 1); ST_ROW(Z, SB, Z.viB, iB, s + 1);
                }
#undef ST_LD
#undef ST_ROW
#undef P2
                __syncthreads();
            }
        }
    }
    __syncthreads();
}
DEVINL void phase_rwkv_out(const PV& p, const float* Y, const bf16_t* Y1, const bf16_t* R, const bf16_t* Kf, const bf16_t* Vf, const bf16_t* AA, const bf16_t* Gg, bf16_t* XO) {
    const int lane = otid() & 63, gw = obid() * 8 + (otid() >> 6), nw = gridDim.x * 8;
    const float* k_a = p.in(33); const float* r_k = p.in(34); const float* lnw = p.in(35); const float* lnb = p.in(36);
    for (int r = gw; r < NTOK; r += nw) {
#pragma unroll
        for (int i = 0; i < 4; ++i) { const int c = i * 256 + lane * 4; const size_t o = (size_t)r * DM + c;
            const u32x2 y1w = *(const u32x2*)(Y1 + o);
            const f32x4 y = *(const f32x4*)(Y + o) + (f32x4){lo_bf(y1w.x), hi_bf(y1w.x), lo_bf(y1w.y), hi_bf(y1w.y)};
            const u32x2 rw = *(const u32x2*)(R + o), kw = *(const u32x2*)(Kf + o), vw = *(const u32x2*)(Vf + o), a0w = *(const u32x2*)(AA + o), a1w = *(const u32x2*)(AA + (size_t)NTOK * DM + o), gw2 = *(const u32x2*)(Gg + o);
            const f32x4 rr = {lo_bf(rw.x), hi_bf(rw.x), lo_bf(rw.y), hi_bf(rw.y)}, kk = {lo_bf(kw.x), hi_bf(kw.x), lo_bf(kw.y), hi_bf(kw.y)}, vv = {lo_bf(vw.x), hi_bf(vw.x), lo_bf(vw.y), hi_bf(vw.y)};
            const f32x4 a0 = {sigm_f(lo_bf(a0w.x)), sigm_f(hi_bf(a0w.x)), sigm_f(lo_bf(a0w.y)), sigm_f(hi_bf(a0w.y))}, a1 = {sigm_f(lo_bf(a1w.x)), sigm_f(hi_bf(a1w.x)), sigm_f(lo_bf(a1w.y)), sigm_f(hi_bf(a1w.y))}, gg = {lo_bf(gw2.x), hi_bf(gw2.x), lo_bf(gw2.y), hi_bf(gw2.y)};
            const f32x4 ka = *(const f32x4*)(k_a + c), rk = *(const f32x4*)(r_k + c), lw = *(const f32x4*)(lnw + c), lb = *(const f32x4*)(lnb + c);
            float s = y[0] + y[1] + y[2] + y[3]; s = sum16(s); const float mu = s * (1.f / 64.f);
            const f32x4 d = y - mu; float vs = d[0] * d[0] + d[1] * d[1] + d[2] * d[2] + d[3] * d[3]; vs = sum16(vs);
            const float rstd = rsqrtf(vs * (1.f / 64.f) + 64e-5f);
            const f32x4 kd = kk * ((a0 + a1 - 2.f) * ka + 2.f);
            const f32x4 cf = rr * kd * rk; float co = cf[0] + cf[1] + cf[2] + cf[3]; co = sum16(co);
            const f32x4 out = (d * rstd * lw + lb + vv * co) * gg;
            st_bf4(XO + o, out); }
    }
}

enum { OP_PREP, OP_ROW0, OP_ROW_A, OP_ROW_B, OP_ROW_C, OP_FFN_UP, OP_FFN_DN, OP_MLA_DQKV, OP_MLA_NORM, OP_MLA_UQ, OP_MLA_UKV, OP_MLA_ATTN, OP_MLA_WO,
       OP_FN_DFT, OP_FN_DFTC, OP_FN_OUT, OP_RW_SHIFT, OP_RW_G1, OP_RW_G2W, OP_RW_G2A, OP_RW_G2G, OP_RW_SCAN, OP_RW_OUT, OP_RW_WO };
#define OPC(op, layer, which, nosync) ((op) | ((layer) << 8) | ((which) << 12) | ((nosync) << 16))
#define FFN1(l) OPC(OP_FFN_UP, l, 0, 0), OPC(OP_FFN_DN, l, 0, 0), OPC(OP_ROW_A, l, 0, 0)
#define FFN2(l) OPC(OP_ROW_B, l, 0, 0), OPC(OP_FFN_UP, l, 1, 0), OPC(OP_FFN_DN, l, 1, 0), OPC(OP_ROW_C, l, 0, 0)
#define MLA(l) OPC(OP_MLA_DQKV, l, 0, 0), OPC(OP_MLA_NORM, l, 0, 0), OPC(OP_MLA_UQ, l, 0, 1), OPC(OP_MLA_UKV, l, 0, 0), OPC(OP_MLA_ATTN, l, 0, 0), OPC(OP_MLA_WO, l, 0, 0)
constexpr int PROG[] = {
    OPC(OP_PREP, 0, 0, 0), OPC(OP_ROW0, 0, 0, 0),
    FFN1(0), MLA(0), FFN2(0),
    FFN1(1), OPC(OP_FN_DFT, 1, 0, 1), OPC(OP_FN_DFTC, 1, 0, 0), OPC(OP_FN_OUT, 1, 0, 0), FFN2(1),
    FFN1(2), OPC(OP_RW_SHIFT, 2, 0, 0), OPC(OP_RW_G1, 2, 0, 0), OPC(OP_RW_G2W, 2, 0, 1), OPC(OP_RW_G2A, 2, 0, 1), OPC(OP_RW_G2G, 2, 0, 0), OPC(OP_RW_SCAN, 2, 0, 0),
             OPC(OP_RW_OUT, 2, 0, 0), OPC(OP_RW_WO, 2, 0, 0), FFN2(2),
    FFN1(3), MLA(3), FFN2(3) };
constexpr int NPROG = 2 + (3 + 6 + 4) + (3 + 3 + 4) + (3 + 8 + 4) + (3 + 6 + 4);

#define XB_TMO      128
#define XB_XCNT(j)  (256  + 64 * (j))
#define XB_XSUB(j)  (1280 + 64 * (j))
#define XB_XGEN(j)  (2304 + 64 * (j))
#define XB_TOP      3328
#define XB_TOPGEN   3392
#define XCD_BAR_WORDS 3456
#define XB_SPIN_CAP (1u << 20)
DEVINL unsigned xb_ld(unsigned* p)              { return __hip_atomic_load(p, __ATOMIC_RELAXED, __HIP_MEMORY_SCOPE_AGENT); }
DEVINL unsigned xb_add(unsigned* p, unsigned v) { return __hip_atomic_fetch_add(p, v, __ATOMIC_RELAXED, __HIP_MEMORY_SCOPE_AGENT); }
DEVINL unsigned xb_xcc_id() { return (unsigned)__builtin_amdgcn_s_getreg((3 << 11) | 20) & 0xFu; }
#define XB_SPIN(cond, bar) do { unsigned _sp = 0; while (cond) { __builtin_amdgcn_s_sleep(1); \
    if ((++_sp & 255u) == 0u) { if (xb_ld(&(bar)[XB_TMO])) break; if (_sp > XB_SPIN_CAP) { atomicAdd(&(bar)[XB_TMO], 1u); break; } } } } while (0)
DEVINL void xcd_barrier_post(unsigned* bar) { if (otid() == 0) (void)xb_add(&bar[XB_XCNT(xb_xcc_id())], 1u); }
DEVINL void xcd_barrier_complete(unsigned* bar, unsigned x, unsigned& nloc, unsigned& nx) {
    const unsigned G = gridDim.x;
    unsigned sum, cnt, mine, sp = 0u;
    for (;;) {
        sum = 0u; cnt = 0u; mine = 0u;
#pragma unroll
        for (unsigned j = 0; j < 16; ++j) { const unsigned c = xb_ld(&bar[XB_XCNT(j)]); sum += c; cnt += (c > 0u) ? 1u : 0u; mine = (j == x) ? c : mine; }
        if (sum == G) break;
        __builtin_amdgcn_s_sleep(1);
        if ((++sp & 255u) == 0u) { if (xb_ld(&bar[XB_TMO])) break; if (sp > XB_SPIN_CAP) { atomicAdd(&bar[XB_TMO], 1u); break; } }
    }
    nloc = mine > 0u ? mine : 1u; nx = cnt > 0u ? cnt : 1u;
}
DEVINL void xcd_barrier(unsigned* bar, volatile LAS unsigned* st) {
    asm volatile("s_waitcnt vmcnt(0)" ::: "memory");
    __syncthreads();
    if (otid() == 0) {
        const unsigned x = xb_xcc_id();
        __builtin_amdgcn_s_waitcnt(0);
        unsigned nloc = st[0], nx = st[1];
        if (nloc == 0u) { xcd_barrier_complete(bar, x, nloc, nx); st[0] = nloc; st[1] = nx; }
        const unsigned old = xb_add(&bar[XB_XSUB(x)], 1u);
        const unsigned gen = old / nloc;
        if (old + 1u == (gen + 1u) * nloc) {
            __builtin_amdgcn_fence(__ATOMIC_RELEASE, "agent");
            asm volatile("s_waitcnt vmcnt(0)" ::: "memory");
            const unsigned og = xb_add(&bar[XB_TOP], 1u);
            const unsigned tg = og / nx;
            if (og + 1u == (tg + 1u) * nx) xb_add(&bar[XB_TOPGEN], 1u);
            else XB_SPIN(xb_ld(&bar[XB_TOPGEN]) == tg, bar);
            __builtin_amdgcn_fence(__ATOMIC_ACQUIRE, "agent");
            xb_add(&bar[XB_XGEN(x)], 1u);
            asm volatile("s_waitcnt vmcnt(0)" ::: "memory");
        } else {
            XB_SPIN(xb_ld(&bar[XB_XGEN(x)]) == gen, bar);
            __builtin_amdgcn_fence(__ATOMIC_ACQUIRE, "agent");
            asm volatile("s_waitcnt vmcnt(0)" ::: "memory");
        }
    }
    __syncthreads();
}
constexpr int bar_ordinal(int pc) { int n = 0; for (int q = 1; q <= pc; ++q) if (!((PROG[q] >> 16) & 1)) ++n; return n; }
template <int PC>
DEVINL void run_prog(const Params& kp, unsigned char* smem, cg::grid_group& grid) {
    LAS unsigned char* lds = (LAS unsigned char*)smem;
    {
        constexpr int code = PROG[PC], op = code & 0xff, i = (code >> 8) & 0xf, which = (code >> 12) & 0xf, nosync = (code >> 16) & 1;
        unsigned char* ws = kp.ws;
        const int zz = 0;
        float* outp = kp.out;
        const PV p{kp, zz, ws, outp};
        float* MOD = (float*)(ws + WS_MOD); float* HC = (float*)(ws + WS_HC); bf16_t* XN = (bf16_t*)(ws + WS_XN); float* Y = (float*)(ws + WS_Y);
        bf16_t* WM = (bf16_t*)(ws + WS_WM); unsigned char* SCR = ws + WS_SCR;
        const float* npre = p.in(6); const float* npost = p.in(7);
        const int kind = i % 3, j = i / 3; const bool last = (i == 3);
        const float* modi = MOD + (size_t)i * 9 * MODW;
        bf16_t* slot = (bf16_t*)(ws + WS_WF) + (size_t)(i & 1) * FFN_SLOT;
        bf16_t* G = (bf16_t*)(SCR + S_G);
        bf16_t* M = WM + (j ? WM_MLA1 : WM_MLA0);
        switch (op) {
        case OP_PREP: phase_prep(p, smem); break;
        case OP_ROW0: case OP_ROW_A: case OP_ROW_B: case OP_ROW_C: {
            RowArgs a{}; a.hin_l = p.out; a.hin_c = HC; a.hout_l = p.out; a.hout_c = HC; a.Y = Y; a.modp = modi; a.xn = XN; a.xn_ld = 1024; a.nrows = NTOK; a.upd_ctx = 1; a.modn = modi;
            if (op == OP_ROW0) { a.hin_l = p.in(0); a.hin_c = p.in(2); a.Y = nullptr; a.subn = 0; a.gpre = npre; }
            else if (op == OP_ROW_A) { a.Ys = (const float*)(ws + WS_SLAB); a.nslab = NSLAB; a.subp = 0; a.gpost = npost + (i * 3 + 0) * 1024; a.coef = 0.5f; a.subn = 1; a.gpre = npre + (i * 3 + 1) * 1024; a.xn_ld = (kind == 2) ? 2048 : 1024; }
            else if (op == OP_ROW_B) { a.Ys = (const float*)(ws + WS_SLAB); a.nslab = last ? 0 : 4; a.subp = 1; a.gpost = npost + (i * 3 + 1) * 1024; a.coef = 1.0f; a.subn = 2; a.gpre = npre + (i * 3 + 2) * 1024; a.nrows = last ? NLAT : NTOK; }
            else { a.Ys = (const float*)(ws + WS_SLAB); a.nslab = last ? 0 : NSLAB; a.subp = 2; a.gpost = npost + (i * 3 + 2) * 1024; a.coef = 0.5f; a.nrows = last ? NLAT : NTOK;
                   if (last) a.modn = nullptr; else { a.modn = MOD + (size_t)(i + 1) * 9 * MODW; a.subn = 0; a.gpre = npre + ((i + 1) * 3 + 0) * 1024; } }
            if (op == OP_ROW_A && kind == 1) phase_rows_T(a, smem, (bf16_t*)(SCR + S_XT), (bf16_t*)(SCR + S_XTC)); else phase_rows(a);
        } break;
        case OP_FFN_UP: { Gemm g{XN, slot + (size_t)which * (FFN_WGU + FFN_WD), 1024, 1024, 1024, ((last && which) ? NLAT : NTOK) / 256, 2 * DFF / 256, 0, 0}; EpiSwiGLU E{G}; gemm_phase(lds, g, E);
            if (i < 3) { const int nbusy = (g.nM * g.nN) % (int)gridDim.x, bid = obid();
                if (bid >= nbusy) { __syncthreads(); conv_ffn_w((float*)smem, p, i + 1, which, (bf16_t*)(ws + WS_WF) + (size_t)((i + 1) & 1) * FFN_SLOT, bid - nbusy, (int)gridDim.x - nbusy); } } } break;
        case OP_MLA_DQKV: { Gemm g{XN, M + MLA_DQKV, 1024, 1024, 1024, NTOK / 256, 4, 0, 0}; EpiF32 E{Y, 1024, nullptr, nullptr}; gemm_phase(lds, g, E);
            if (i == 0) { const int nbusy = (g.nM * g.nN) % (int)gridDim.x, bid = obid(); if (bid >= nbusy) { __syncthreads(); prep_late(p, smem, bid - nbusy, (int)gridDim.x - nbusy); } } } break;
        case OP_FFN_DN: case OP_MLA_WO: case OP_FN_OUT: case OP_RW_WO: {
            Gemm g{XN, M + MLA_WO, 1024, 1024, 1024, NLAT / 256, 4, 0, 0}; EpiY E{(bf16_t*)Y, nullptr, (float*)(ws + WS_SLAB)};
            bool tail = true;
            if (op == OP_FFN_DN) { g.A = G; g.Bt = slot + (size_t)which * (FFN_WGU + FFN_WD) + FFN_WGU; g.lda = g.ldb = g.K = DFF; tail = !(last && which); g.KS = 512; g.nSl = NSLAB; }
            else if (op == OP_MLA_WO) { tail = !last; g.KS = 256; g.nSl = 4; }
            else if (op == OP_FN_OUT) { g.A = (bf16_t*)(SCR + S_P); g.Bt = WM + WM_W2T; g.lda = g.ldb = g.K = 2048; E.bias = p.in(19); g.KS = 512; g.nSl = 4; }
            else { g.Bt = WM + WM_RWO; g.KS = 256; g.nSl = 4; }
            if (tail) g.nTailM = NCTX / 256; else g.nSl = 0;
            gemm_phase(lds, g, E);
        } break;
        case OP_MLA_NORM: phase_mla_norm(p, j, Y, (bf16_t*)(SCR + S_QN), (bf16_t*)(SCR + S_CKVN), (bf16_t*)(SCR + S_K)); break;
        case OP_MLA_UQ: { Gemm g{(bf16_t*)(SCR + S_QN), M + MLA_UQ, 512, 512, 512, NTOK / 256, 6, 0, 0}; EpiUQ E{(bf16_t*)(SCR + S_Q), (const float*)(ws + WS_ROPE), (const float*)(ws + WS_ROPE) + 1024}; gemm_phase(lds, g, E); } break;
        case OP_MLA_UKV: { Gemm g{(bf16_t*)(SCR + S_CKVN), M + MLA_UKV, 256, 256, 256, NTOK / 256, 8, 0, 0}; EpiUKV E{(bf16_t*)(SCR + S_K), (bf16_t*)(SCR + S_V)}; gemm_phase(lds, g, E); } break;
        case OP_MLA_ATTN: phase_attn((bf16_t*)(SCR + S_Q), (bf16_t*)(SCR + S_K), (bf16_t*)(SCR + S_V), XN, !last, (char*)smem); break;
        case OP_FN_DFT: case OP_FN_DFTC: {
            Gemm g{WM + WM_DT2, (bf16_t*)(SCR + S_XT), 2048, 2048, 2048, 128, 4, 16, (size_t)1024 * 2048 * 2}; EpiDFT1 E{(bf16_t*)(SCR + S_P), 4, 2048, 0};
            if (op == OP_FN_DFTC) { g.A = WM + WM_DT2C; g.Bt = (bf16_t*)(SCR + S_XTC); g.lda = g.ldb = g.K = 256; g.nM = 16; g.amod = 2; g.bbatch = (size_t)1024 * 256 * 2; E.shift = 1; E.rpb = 256; E.rowbase = NLAT; }
            gemm_phase(lds, g, E);
        } break;
        case OP_RW_SHIFT: phase_rwkv_shift(XN); break;
        case OP_RW_G1: { Gemm g{XN, WM + WM_WCAT, 2048, 2048, 2048, NTOK / 256, 14, 0, 0}; EpiRwkv1 E{(bf16_t*)(SCR + S_R), (bf16_t*)(SCR + S_A2)}; gemm_phase(lds, g, E); } break;
        case OP_RW_G2W: case OP_RW_G2A: {
            Gemm g{(bf16_t*)(SCR + S_A2), WM + WM_BW, 512, 256, 256, NTOK / 256, 8, 0, 0};
            if (op == OP_RW_G2A) { g.Bt = WM + WM_BA; EpiRwkv2<1> E{(bf16_t*)(SCR + S_AA), p.in(27)}; gemm_phase(lds, g, E); }
            else { EpiRwkv2<0> E{XN, p.in(24)}; gemm_phase(lds, g, E); }
        } break;
        case OP_RW_G2G: { Gemm g{(bf16_t*)(SCR + S_A2) + 256, WM + WM_BG, 512, 256, 256, NTOK / 256, 4, 0, 0}; EpiBf16 E{(bf16_t*)(SCR + S_GG), 1024}; gemm_phase(lds, g, E); } break;
        case OP_RW_SCAN: phase_scan(p, (bf16_t*)(SCR + S_R), (bf16_t*)(SCR + S_KK), (bf16_t*)(SCR + S_VV), (bf16_t*)(SCR + S_AA), XN, Y, (bf16_t*)(ws + WS_SLAB), smem); break;
        case OP_RW_OUT: phase_rwkv_out(p, Y, (const bf16_t*)(ws + WS_SLAB), (bf16_t*)(SCR + S_R), (bf16_t*)(SCR + S_KK), (bf16_t*)(SCR + S_VV), (bf16_t*)(SCR + S_AA), (bf16_t*)(SCR + S_GG), XN); break;
        default: break;
        }
        if (!nosync && PC + 1 < NPROG) { if (PC == 0 && kp.ws == nullptr) grid.sync(); xcd_barrier((unsigned*)(kp.ws + WS_BAR), (volatile LAS unsigned*)(lds + LDS_BYTES - 16)); }
    }
    if constexpr (PC + 1 < NPROG) run_prog<PC + 1>(kp, smem, grid);
}
__global__ void __launch_bounds__(512) fwd_megakernel(Params kp) {
    extern __shared__ __attribute__((aligned(16))) unsigned char smem[];
    cg::grid_group grid = cg::this_grid();
    if (otid() < 4) ((volatile LAS unsigned*)((LAS unsigned char*)smem + LDS_BYTES - 16))[otid()] = 0u;
    __syncthreads();
    xcd_barrier_post((unsigned*)(kp.ws + WS_BAR));
    run_prog<0>(kp, smem, grid);
}

extern "C" void kernel_launch(void* const* d_in, const int* in_sizes, int n_in, void* d_out, int out_size, void* d_ws, size_t ws_size, hipStream_t stream) {
    static int grid = 0;
    if (grid == 0) {
        if (n_in != 38 || ws_size < WS_END) { fprintf(stderr, "kernel_launch: need 38 inputs and %zu bytes of workspace; got %d, %zu\n", (size_t)WS_END, n_in, ws_size); grid = -1; return; }
        int dev = 0, cus = 0, per_cu = 0;
        (void)hipGetDevice(&dev); (void)hipDeviceGetAttribute(&cus, hipDeviceAttributeMultiprocessorCount, dev);
        if (hipFuncSetAttribute((const void*)fwd_megakernel, hipFuncAttributeMaxDynamicSharedMemorySize, LDS_BYTES) != hipSuccess) { fprintf(stderr, "kernel_launch: hipFuncSetAttribute failed\n"); grid = -1; return; }
        if (hipOccupancyMaxActiveBlocksPerMultiprocessor(&per_cu, (const void*)fwd_megakernel, 512, LDS_BYTES) != hipSuccess || per_cu < 1) { fprintf(stderr, "kernel_launch: occupancy query says %d\n", per_cu); per_cu = 1; }
        (void)hipGetLastError();
        grid = cus * 1;
    }
    if (grid < 0) return;
    Params p{};
    for (int i = 0; i < 38; ++i) p.in[i] = (const float*)d_in[i];
    p.out = (float*)d_out; p.ws = (unsigned char*)d_ws;
    if (hipMemsetAsync((char*)d_ws + WS_BAR, 0, 16384, stream) != hipSuccess) { fprintf(stderr, "kernel_launch: memset failed\n"); return; }
    void* args[] = {&p};
    hipError_t e = hipLaunchCooperativeKernel((const void*)fwd_megakernel, dim3(grid), dim3(512), args, LDS_BYTES, stream);
    if (e != hipSuccess) fprintf(stderr, "cooperative launch failed: %s (grid %d)\n", hipGetErrorString(e), grid);
}
```

```cpp
#include <hip/hip_runtime.h>
#include <hip/hip_cooperative_groups.h>
#include <cstdio>
namespace cg = cooperative_groups;

#define LAS __attribute__((address_space(3)))
#define DEVINL __device__ __forceinline__
typedef unsigned short bf16_t;
typedef short bf16x8 __attribute__((ext_vector_type(8)));
typedef short s16x4 __attribute__((ext_vector_type(4)));
typedef float f32x4 __attribute__((ext_vector_type(4)));
typedef float f32x16 __attribute__((ext_vector_type(16)));
typedef unsigned u32x4 __attribute__((ext_vector_type(4)));
typedef unsigned u32x2 __attribute__((ext_vector_type(2)));

constexpr int DM = 1024, NB = 8, SEQ = 2048, CTX = 256, DFF = 2816, NLAT = NB * SEQ, NCTX = NB * CTX, NTOK = NLAT + NCTX, TKV = SEQ + CTX;
constexpr int MODW = 9 * DM;
constexpr float EPS = 1e-6f;

constexpr size_t al256(size_t x) { return (x + 255) / 256 * 256; }
constexpr size_t WS_MOD = 0;
constexpr size_t WS_ROPE = al256(WS_MOD + (size_t)4 * 9 * MODW * 4);
constexpr size_t WS_HC = al256(WS_ROPE + 2 * 64 * 16 * 4);
constexpr size_t WS_XN = al256(WS_HC + (size_t)NCTX * DM * 4);
constexpr size_t WS_Y = al256(WS_XN + (size_t)NTOK * 2048 * 2);
constexpr size_t FFN_WGU = (size_t)2 * DFF * DM;
constexpr size_t FFN_WD = (size_t)DM * DFF;
constexpr size_t FFN_SLOT = 2 * (FFN_WGU + FFN_WD);
constexpr size_t WS_WF = al256(WS_Y + (size_t)NTOK * DM * 4);
constexpr size_t WS_WM = al256(WS_WF + 2 * FFN_SLOT * 2);
constexpr size_t MLA_DQKV = 0, MLA_UQ = MLA_DQKV + 1024 * 1024, MLA_UKV = MLA_UQ + 1536 * 512, MLA_WO = MLA_UKV + 2048 * 256, MLA_SZ = MLA_WO + 1024 * 1024;
constexpr size_t WM_MLA0 = 0, WM_MLA1 = MLA_SZ;
constexpr size_t WM_W2T = 2 * MLA_SZ, WM_DT2 = WM_W2T + 1024 * 2048, WM_DT2C = WM_DT2 + (size_t)4096 * 2048;
constexpr size_t WM_WCAT = WM_DT2C + 512 * 256, WM_BW = WM_WCAT + (size_t)3584 * 2048, WM_BA = WM_BW + 2048 * 256, WM_BG = WM_BA + 2048 * 256, WM_RWO = WM_BG + 1024 * 256;
constexpr size_t WM_END = WM_RWO + 1024 * 1024;
constexpr size_t WS_SCR = al256(WS_WM + WM_END * 2);
constexpr size_t SCR_BYTES = 245366784;
constexpr size_t WS_BAR = WS_SCR + SCR_BYTES;
constexpr int NSLAB = 6;
constexpr size_t WS_SLAB = WS_BAR + 16384;
constexpr size_t WS_END = WS_SLAB + (size_t)NSLAB * NCTX * DM * 4;
constexpr size_t S_G = 0;
constexpr size_t S_QN = 0, S_CKVN = S_QN + (size_t)NTOK * 512 * 2, S_Q = S_CKVN + (size_t)NTOK * 256 * 2, S_K = S_Q + (size_t)64 * TKV * 192 * 2,
                 S_V = S_K + (size_t)64 * TKV * 192 * 2;
constexpr size_t S_XT = 0, S_XTC = S_XT + (size_t)8 * 1024 * 2048 * 2, S_P = al256(S_XTC + (size_t)8 * 1024 * 256 * 2);
constexpr size_t S_R = 0, S_KK = S_R + (size_t)NTOK * DM * 2, S_VV = S_KK + (size_t)NTOK * DM * 2, S_A2 = S_VV + (size_t)NTOK * DM * 2,
                 S_AA = S_A2 + (size_t)NTOK * 512 * 2, S_GG = S_AA + (size_t)2 * NTOK * DM * 2;
static_assert(S_GG + (size_t)NTOK * DM * 2 <= SCR_BYTES, "scratch");
static_assert(S_V + (size_t)64 * TKV * 128 * 2 <= SCR_BYTES, "scratch");
static_assert(S_P + (size_t)NTOK * 2048 * 2 <= SCR_BYTES, "scratch");

constexpr int LDS_BYTES = 135168;

struct Params { const float* in[38]; float* out; unsigned char* ws; };
struct PV { const Params& p; int z; unsigned char* ws; float* out;
    __device__ __forceinline__ const float* in(int k) const { return p.in[k + z]; } };

DEVINL int otid() { int t = threadIdx.x; asm volatile("" : "+v"(t)); return t; }
DEVINL int obid() { int b = blockIdx.x; asm volatile("" : "+s"(b)); return b; }
DEVINL float bf2f(bf16_t b) { return __uint_as_float(((unsigned)b) << 16); }
DEVINL bf16_t f2bf(float f) { unsigned u = __float_as_uint(f); u += 0x7FFFu + ((u >> 16) & 1u); return (bf16_t)(u >> 16); }
typedef float f32x2c __attribute__((ext_vector_type(2)));
typedef __bf16 bf16x2c __attribute__((ext_vector_type(2)));
DEVINL unsigned pk2(float lo, float hi) { const f32x2c v = {lo, hi}; const bf16x2c r = __builtin_convertvector(v, bf16x2c); return __builtin_bit_cast(unsigned, r); }
DEVINL float wave_sum(float v) {
#pragma unroll
    for (int o = 32; o > 0; o >>= 1) v += __shfl_xor(v, o);
    return v; }
#define DPPF(v, ctrl) __builtin_bit_cast(float, __builtin_amdgcn_update_dpp(0, __builtin_bit_cast(int, (v)), (ctrl), 0xF, 0xF, false))
DEVINL float wave_sum_dpp(float v) {
    v += DPPF(v, 0xB1); v += DPPF(v, 0x4E); v += DPPF(v, 0x141); v += DPPF(v, 0x140);
    const int vi_ = __builtin_bit_cast(int, v);
    return __builtin_bit_cast(float, __builtin_amdgcn_readlane(vi_, 0)) + __builtin_bit_cast(float, __builtin_amdgcn_readlane(vi_, 16)) + __builtin_bit_cast(float, __builtin_amdgcn_readlane(vi_, 32)) + __builtin_bit_cast(float, __builtin_amdgcn_readlane(vi_, 48));
}
DEVINL float sum16(float v) {
    v += DPPF(v, 0xB1); v += DPPF(v, 0x4E); v += DPPF(v, 0x141); v += DPPF(v, 0x140);
    return v; }
DEVINL float silu_f(float x) { return x * __builtin_amdgcn_rcpf(1.f + __expf(-x)); }
DEVINL float sigm_f(float x) { return __builtin_amdgcn_rcpf(1.f + __expf(-x)); }
DEVINL float lo_bf(unsigned w) { return __uint_as_float(w << 16); }
DEVINL float hi_bf(unsigned w) { return __uint_as_float(w & 0xFFFF0000u); }

constexpr int BM = 256, BK = 64, HALF = 128, HTB = HALF * BK * 2, NXCD = 8, WGM = 8;
DEVINL int lds_byte(int r, int c) { const int st = (r >> 4) * 2 + (c >> 5), rr = r & 15, cc = c & 31, ob = rr * 64 + cc * 2; return st * 1024 + (ob ^ (((ob >> 9) & 1) << 5)); }
DEVINL void stage_rc(int b, int& R, int& C) { const int st = b / 1024, sb = b % 1024, swz = sb ^ (((sb >> 9) & 1) << 5); R = (st >> 1) * 16 + swz / 64; C = (st & 1) * 32 + (swz % 64) / 2; }
DEVINL int perm32(int rho) { const int n = rho >> 4, i = rho & 15; return 8 * (i >> 2) + 4 * n + (i & 3); }
struct Unit { int pm, pn, ks; };
struct Gemm { const bf16_t* A; const bf16_t* Bt; int lda, ldb, K, nM, nN, amod; size_t bbatch; int nTailM, nSl, KS; };
struct Sched {
    int nM, nN, nwg, G, c, ntail, nSl;
    DEVINL void init(int nM_, int nN_, int nTailM, int nSl_) { nM = nM_; nN = nN_; nwg = nM * nN; G = gridDim.x; c = obid(); nSl = nSl_; ntail = nTailM * nN_ * nSl_; }
    DEVINL bool next(int i, Unit& u) const {
        const long L = (long)i * G + c; if (L >= nwg + ntail) return false;
        if (L >= nwg) { const int t = (int)L - nwg, rest = t / nSl; u.ks = t % nSl; u.pn = rest % nN; u.pm = nM + rest / nN; return true; }
        u.ks = -1;
        int wgid = (int)L; { const int q = nwg / NXCD, r = nwg % NXCD, xcd = wgid % NXCD, off = wgid / NXCD; wgid = (xcd < r ? xcd * (q + 1) : r * (q + 1) + (xcd - r) * q) + off; }
        const int nig = WGM * nN, gid = wgid / nig, fm = gid * WGM, gsz = (nM - fm) < WGM ? (nM - fm) : WGM;
        u.pm = fm + ((wgid % nig) % gsz); u.pn = (wgid % nig) / gsz; return true;
    }
};
typedef f32x4 Acc[2][2][4][2];

template <class Epi>
DEVINL void gemm_phase(LAS unsigned char* lds, const Gemm g, const Epi& E) {
    const int tid = otid(), wid = __builtin_amdgcn_readfirstlane(tid >> 6), lane = tid & 63, wr = wid >> 2, wc = wid & 3, fr = lane & 15, fq = lane >> 4;
    Sched S; S.init(g.nM, g.nN, g.nTailM, g.nSl);
    const int K = g.K;
    unsigned voffA[2], voffB[2];
#pragma unroll
    for (int i = 0; i < 2; ++i) { int R, C; stage_rc(tid * 16 + i * 8192, R, C);
        const int Rb = Epi::PERM ? ((R & ~31) + perm32(R & 31)) : R;
        voffA[i] = (unsigned)(R * g.lda + C) * 2u; voffB[i] = (unsigned)(Rb * g.ldb + C) * 2u; }
    const size_t kstep = (size_t)(BK * 2);
    const size_t hstepA = (size_t)HALF * g.lda * 2, hstepB = (size_t)HALF * g.ldb * 2;
    const size_t tstepA = 2 * hstepA, tstepB = 2 * hstepB;
    const unsigned ldsw = (unsigned)wid * 1024u;
    const int aoff = lds_byte(wr * 64 + fr, fq * 8), boff = lds_byte(wc * 32 + fr, fq * 8);
#define PG8_SA(b, h) (((b) * 2 + (h)) * HTB)
#define PG8_SB(b, h) ((4 + (b) * 2 + (h)) * HTB)
#define PG8_STAGE(bufoff, gbase, voff) do { _Pragma("unroll") for (int _i = 0; _i < 2; ++_i) \
        __builtin_amdgcn_global_load_lds((const unsigned*)((const char*)(gbase) + (voff)[_i]), (LAS unsigned*)(lds + (bufoff) + ldsw + _i * 8192), 16, 0, 0); } while (0)
#define PG8_LDA(dst, b, h) do { _Pragma("unroll") for (int m = 0; m < 4; ++m) _Pragma("unroll") for (int k = 0; k < 2; ++k) dst[m][k] = *(const LAS bf16x8*)(lds + PG8_SA(b, h) + aoff + m * 2048 + k * 1024); } while (0)
#define PG8_LDB(dst, b, h) do { _Pragma("unroll") for (int n = 0; n < 2; ++n) _Pragma("unroll") for (int k = 0; k < 2; ++k) dst[n][k] = *(const LAS bf16x8*)(lds + PG8_SB(b, h) + boff + n * 2048 + k * 1024); } while (0)
#define PG8_MMA(ai, bj, At, Bt) do { __builtin_amdgcn_s_setprio(1); _Pragma("unroll") for (int m = 0; m < 4; ++m) _Pragma("unroll") for (int n = 0; n < 2; ++n) _Pragma("unroll") for (int k = 0; k < 2; ++k) \
        acc[ai][bj][m][n] = __builtin_amdgcn_mfma_f32_16x16x32_bf16(Bt[n][k], At[m][k], acc[ai][bj][m][n], 0, 0, 0); __builtin_amdgcn_s_setprio(0); } while (0)
#define PG8_WAIT_V(n) asm volatile("s_waitcnt vmcnt(" #n ")" ::: "memory")
#define PG8_WAIT_L(n) asm volatile("s_waitcnt lgkmcnt(" #n ")" ::: "memory")
#define PG8_BAR __builtin_amdgcn_s_barrier()
#define PG8_SCHED __builtin_amdgcn_sched_barrier(0)
    Unit cur, nxt; int ui = 0;
    if (!S.next(0, cur)) return;
    Acc acc;
#pragma unroll
    for (int a = 0; a < 2; ++a)
#pragma unroll
        for (int b = 0; b < 2; ++b)
#pragma unroll
            for (int m = 0; m < 4; ++m)
#pragma unroll
                for (int n = 0; n < 2; ++n) acc[a][b][m][n] = (f32x4){0.f, 0.f, 0.f, 0.f};
    bf16x8 At[4][2], B0[2][2], B1[2][2];
#define PG8_KOFF(u) ((u).ks > 0 ? (size_t)(u).ks * g.KS * 2 : (size_t)0)
#define PG8_NT(u) ((u).ks < 0 ? K / BK : ((K - (u).ks * g.KS) < g.KS ? (K - (u).ks * g.KS) : g.KS) / BK)
#define PG8_APTR(u) ((const char*)g.A + (size_t)(g.amod ? (u).pm % g.amod : (u).pm) * tstepA + PG8_KOFF(u))
#define PG8_BPTR(u) ((const char*)g.Bt + (size_t)(u).pn * tstepB + (g.amod ? (size_t)((u).pm / g.amod) * g.bbatch : (size_t)0) + PG8_KOFF(u))
    const char* cA = PG8_APTR(cur); const char* cB = PG8_BPTR(cur); int nt = PG8_NT(cur);
    PG8_STAGE(PG8_SB(0, 0), cB, voffB); PG8_STAGE(PG8_SA(0, 0), cA, voffA); PG8_STAGE(PG8_SB(0, 1), cB + hstepB, voffB); PG8_STAGE(PG8_SA(0, 1), cA + hstepA, voffA);
    if (wr == 1) PG8_BAR;
    PG8_WAIT_V(4); PG8_BAR;
    PG8_STAGE(PG8_SB(1, 0), cB + kstep, voffB); PG8_STAGE(PG8_SA(1, 0), cA + kstep, voffA); PG8_STAGE(PG8_SB(1, 1), cB + hstepB + kstep, voffB);
    PG8_WAIT_V(6); PG8_BAR;
    for (;;) {
        const bool has_next = S.next(ui + 1, nxt);
        const char* nA = has_next ? PG8_APTR(nxt) : cA; const char* nB = has_next ? PG8_BPTR(nxt) : cB;
        for (int t = 0; t < nt; t += 2) {
            const bool last = (t == nt - 2);
            const char* a1 = cA + (size_t)(t + 1) * kstep;
            const char* a2 = last ? nA : cA + (size_t)(t + 2) * kstep; const char* b2 = last ? nB : cB + (size_t)(t + 2) * kstep;
            const char* a3 = a2 + kstep; const char* b3 = b2 + kstep;
            PG8_LDB(B0, 0, 0); PG8_SCHED; PG8_LDA(At, 0, 0); PG8_STAGE(PG8_SA(1, 1), a1 + hstepA, voffA);
            PG8_WAIT_L(8); PG8_BAR; PG8_WAIT_L(0); PG8_MMA(0, 0, At, B0); PG8_BAR; PG8_SCHED;
            PG8_LDB(B1, 0, 1); PG8_STAGE(PG8_SB(0, 0), b2, voffB);
            PG8_BAR; PG8_WAIT_L(0); PG8_MMA(0, 1, At, B1); PG8_BAR;
            PG8_LDA(At, 0, 1); PG8_STAGE(PG8_SA(0, 0), a2, voffA);
            PG8_BAR; PG8_WAIT_L(0); PG8_MMA(1, 0, At, B0); PG8_BAR; PG8_SCHED;
            PG8_STAGE(PG8_SB(0, 1), b2 + hstepB, voffB);
            PG8_WAIT_V(6); PG8_BAR; PG8_MMA(1, 1, At, B1); PG8_BAR;
            PG8_LDB(B0, 1, 0); PG8_SCHED; PG8_LDA(At, 1, 0); PG8_STAGE(PG8_SA(0, 1), a2 + hstepA, voffA);
            PG8_WAIT_L(8); PG8_BAR; PG8_WAIT_L(0); PG8_MMA(0, 0, At, B0); PG8_BAR; PG8_SCHED;
            PG8_LDB(B1, 1, 1); PG8_STAGE(PG8_SB(1, 0), b3, voffB);
            PG8_BAR; PG8_WAIT_L(0); PG8_MMA(0, 1, At, B1); PG8_BAR;
            PG8_LDA(At, 1, 1); PG8_STAGE(PG8_SA(1, 0), a3, voffA);
            PG8_BAR; PG8_WAIT_L(0); PG8_MMA(1, 0, At, B0); PG8_BAR; PG8_SCHED;
            PG8_STAGE(PG8_SB(1, 1), b3 + hstepB, voffB);
            PG8_WAIT_V(6); PG8_BAR; PG8_MMA(1, 1, At, B1); PG8_BAR;
        }
        E(acc, cur, wr, wc, fr, fq);
        if (!has_next) break;
#pragma unroll
        for (int a = 0; a < 2; ++a)
#pragma unroll
            for (int b = 0; b < 2; ++b)
#pragma unroll
                for (int m = 0; m < 4; ++m)
#pragma unroll
                    for (int n = 0; n < 2; ++n) acc[a][b][m][n] = (f32x4){0.f, 0.f, 0.f, 0.f};
        cur = nxt; cA = nA; cB = nB; ++ui; nt = PG8_NT(cur);
    }
    PG8_WAIT_V(0);
    if (wr == 0) PG8_BAR;
    PG8_BAR;
#undef PG8_SA
#undef PG8_SB
#undef PG8_STAGE
#undef PG8_LDA
#undef PG8_LDB
#undef PG8_MMA
#undef PG8_BAR
#undef PG8_SCHED
#undef PG8_APTR
#undef PG8_KOFF
#undef PG8_NT
#undef PG8_BPTR
}
#define WAIT_V0() asm volatile("s_waitcnt vmcnt(0)" ::: "memory")

#define EPI_LOOP_ROWS for (int ai = 0; ai < 2; ++ai) for (int m = 0; m < 4; ++m)
DEVINL void st_bf4(bf16_t* p, f32x4 v) { u32x2 w; w.x = pk2(v[0], v[1]); w.y = pk2(v[2], v[3]); *(u32x2*)p = w; }

DEVINL void st_bf8(bf16_t* p, f32x4 a, f32x4 b) { u32x4 w; w.x = pk2(a[0], a[1]); w.y = pk2(a[2], a[3]); w.z = pk2(b[0], b[1]); w.w = pk2(b[2], b[3]); *(u32x4*)p = w; }
struct EpiF32 { static constexpr bool PERM = false;
    float* C; int ldc; const float* bias; float* Cs;
    DEVINL void operator()(const Acc& acc, const Unit& u, int wr, int wc, int fr, int fq) const {
        const int row0 = u.pm * BM + wr * 64 + fr, col0 = u.pn * BM + wc * 32 + 4 * fq;
        float* base = u.ks < 0 ? C : Cs + ((long)u.ks * NCTX - NLAT) * 1024;
#pragma unroll
        for (int ai = 0; ai < 2; ++ai)
#pragma unroll
            for (int m = 0; m < 4; ++m) { float* rowp = base + (size_t)(row0 + ai * HALF + m * 16) * ldc + col0;
#pragma unroll
                for (int bj = 0; bj < 2; ++bj)
#pragma unroll
                    for (int n = 0; n < 2; ++n) { f32x4 v = acc[ai][bj][m][n];
                        if (bias) v += *(const f32x4*)(bias + col0 + bj * HALF + n * 16);
                        *(f32x4*)(rowp + bj * HALF + n * 16) = v; } }
    }
};
struct EpiY { static constexpr bool PERM = true;
    bf16_t* Yb; const float* bias; float* Cs;
    DEVINL void operator()(const Acc& acc, const Unit& u, int wr, int wc, int fr, int fq) const {
        const int row0 = u.pm * BM + wr * 64 + fr, col0 = u.pn * BM + wc * 32 + 8 * fq;
        const bool addb = bias != nullptr && u.ks <= 0;
        float* sbase = Cs + ((long)u.ks * NCTX - NLAT) * 1024;
#pragma unroll
        for (int ai = 0; ai < 2; ++ai)
#pragma unroll
            for (int m = 0; m < 4; ++m) { const size_t ro = (size_t)(row0 + ai * HALF + m * 16) * 1024 + col0;
#pragma unroll
                for (int bj = 0; bj < 2; ++bj) { f32x4 v0 = acc[ai][bj][m][0], v1 = acc[ai][bj][m][1];
                    if (addb) { v0 += *(const f32x4*)(bias + col0 + bj * HALF); v1 += *(const f32x4*)(bias + col0 + bj * HALF + 4); }
                    if (u.ks < 0) st_bf8(Yb + ro + bj * HALF, v0, v1); else { *(f32x4*)(sbase + ro + bj * HALF) = v0; *(f32x4*)(sbase + ro + bj * HALF + 4) = v1; } } }
    }
};
struct EpiBf16 { static constexpr bool PERM = true;
    bf16_t* O; int ldc;
    DEVINL void operator()(const Acc& acc, const Unit& u, int wr, int wc, int fr, int fq) const {
        const int row0 = u.pm * BM + wr * 64 + fr, col0 = u.pn * BM + wc * 32 + 8 * fq;
#pragma unroll
        for (int ai = 0; ai < 2; ++ai)
#pragma unroll
            for (int m = 0; m < 4; ++m) { bf16_t* rowp = O + (size_t)(row0 + ai * HALF + m * 16) * ldc + col0;
#pragma unroll
                for (int bj = 0; bj < 2; ++bj) st_bf8(rowp + bj * HALF, acc[ai][bj][m][0], acc[ai][bj][m][1]); }
    }
};
struct EpiSwiGLU { static constexpr bool PERM = true;
    bf16_t* G;
    DEVINL void operator()(const Acc& acc, const Unit& u, int wr, int wc, int fr, int fq) const {
        const int row0 = u.pm * BM + wr * 64 + fr, col0 = u.pn * HALF + wc * 32 + 8 * fq;
#pragma unroll
        for (int ai = 0; ai < 2; ++ai)
#pragma unroll
            for (int m = 0; m < 4; ++m) { bf16_t* rowp = G + (size_t)(row0 + ai * HALF + m * 16) * DFF + col0;
                f32x4 o[2];
#pragma unroll
                for (int n = 0; n < 2; ++n) { const f32x4 gt = acc[ai][0][m][n], up = acc[ai][1][m][n];
#pragma unroll
                    for (int j = 0; j < 4; ++j) o[n][j] = silu_f(gt[j]) * up[j]; }
                st_bf8(rowp, o[0], o[1]); }
    }
};
DEVINL void tok_of_row(int r, int& b, int& tk, bool& lat) { lat = r < NLAT; if (lat) { b = r >> 11; tk = r & 2047; } else { const int rc = r - NLAT; b = rc >> 8; tk = SEQ + (rc & 255); } }
struct EpiUQ { static constexpr bool PERM = false;
    bf16_t* Q; const float* cosT; const float* sinT;
    DEVINL void operator()(const Acc& acc, const Unit& u, int wr, int wc, int fr, int fq) const {
#pragma unroll
        for (int ai = 0; ai < 2; ++ai)
#pragma unroll
            for (int m = 0; m < 4; ++m) { const int r = u.pm * BM + ai * HALF + wr * 64 + m * 16 + fr; int b, tq; bool lat; tok_of_row(r, b, tq, lat);
#pragma unroll
                for (int bj = 0; bj < 2; ++bj) { const int col32 = u.pn * BM + bj * HALF + wc * 32, head = col32 / 192, off = col32 % 192;
                    f32x4 v0 = acc[ai][bj][m][0], v1 = acc[ai][bj][m][1];
                    if (off >= 128 && lat) { const int axis = (off - 128) >> 5, pos = axis == 0 ? (tq >> 6) : (tq & 63);
                        const f32x4 c = *(const f32x4*)(cosT + pos * 16 + fq * 4), s = *(const f32x4*)(sinT + pos * 16 + fq * 4);
                        const f32x4 o0 = v0 * c - v1 * s, o1 = v1 * c + v0 * s; v0 = o0; v1 = o1; }
                    bf16_t* dst = Q + ((size_t)(b * 8 + head) * TKV + tq) * 192 + off + fq * 4;
                    st_bf4(dst, v0); st_bf4(dst + 16, v1); } }
    }
};
struct EpiUKV { static constexpr bool PERM = true;
    bf16_t* Kb; bf16_t* Vb;
    DEVINL void operator()(const Acc& acc, const Unit& u, int wr, int wc, int fr, int fq) const {
#pragma unroll
        for (int ai = 0; ai < 2; ++ai)
#pragma unroll
            for (int m = 0; m < 4; ++m) { const int r = u.pm * BM + ai * HALF + wr * 64 + m * 16 + fr; int b, tk; bool lat; tok_of_row(r, b, tk, lat);
                const size_t tokidx = (size_t)(b * 8 + u.pn) * TKV + tk; const int c = wc * 32 + fq * 8;
                st_bf8(Kb + tokidx * 192 + c, acc[ai][0][m][0], acc[ai][0][m][1]); st_bf8(Vb + tokidx * 128 + c, acc[ai][1][m][0], acc[ai][1][m][1]); }
    }
};
struct EpiDFT1 { static constexpr bool PERM = true;
    bf16_t* P; int shift, rpb, rowbase;
    DEVINL void operator()(const Acc& acc, const Unit& u, int wr, int wc, int fr, int fq) const {
        const int b = u.pm >> shift, tile = u.pm & ((1 << shift) - 1), cs = tile >> (shift - 1), t0 = (tile & ((1 << (shift - 1)) - 1)) * 256;
        const int row0 = rowbase + b * rpb + t0 + wr * 64 + fr, col0 = cs * 1024 + u.pn * BM + wc * 32 + 8 * fq;
#pragma unroll
        for (int ai = 0; ai < 2; ++ai)
#pragma unroll
            for (int m = 0; m < 4; ++m) { bf16_t* rowp = P + (size_t)(row0 + ai * HALF + m * 16) * 2048 + col0;
#pragma unroll
                for (int bj = 0; bj < 2; ++bj) st_bf8(rowp + bj * HALF, acc[ai][bj][m][0], acc[ai][bj][m][1]); }
    }
};
struct EpiRwkv1 { static constexpr bool PERM = true;
    bf16_t* R; bf16_t* A2;
    DEVINL void operator()(const Acc& acc, const Unit& u, int wr, int wc, int fr, int fq) const {
        const int row0 = u.pm * BM + wr * 64 + fr;
#pragma unroll
        for (int ai = 0; ai < 2; ++ai)
#pragma unroll
            for (int m = 0; m < 4; ++m) { const size_t r = (size_t)(row0 + ai * HALF + m * 16);
#pragma unroll
                for (int bj = 0; bj < 2; ++bj) { f32x4 v0 = acc[ai][bj][m][0], v1 = acc[ai][bj][m][1]; const int c = bj * HALF + wc * 32 + fq * 8;
                    if (u.pn < 12) { st_bf8(R + (size_t)(u.pn >> 2) * NTOK * DM + r * DM + (u.pn & 3) * 256 + c, v0, v1); }
                    else if (u.pn == 12) { if (bj == 0) {
#pragma unroll
                            for (int j = 0; j < 4; ++j) { const float e0 = __expf(-2.f * fabsf(v0[j])), t0 = (1.f - e0) / (1.f + e0); v0[j] = v0[j] < 0.f ? -t0 : t0;
                                const float e1 = __expf(-2.f * fabsf(v1[j])), t1 = (1.f - e1) / (1.f + e1); v1[j] = v1[j] < 0.f ? -t1 : t1; } }
                        st_bf8(A2 + r * 512 + c, v0, v1); }
                    else {
#pragma unroll
                        for (int j = 0; j < 4; ++j) { v0[j] = (c + j < 160) ? sigm_f(v0[j]) : 0.f; v1[j] = (c + 4 + j < 160) ? sigm_f(v1[j]) : 0.f; }
                        st_bf8(A2 + r * 512 + 256 + c, v0, v1); } } }
    }
};
template <int mode> struct EpiRwkv2 { static constexpr bool PERM = true;
    bf16_t* O; const float* bias;
    DEVINL void operator()(const Acc& acc, const Unit& u, int wr, int wc, int fr, int fq) const {
        const int row0 = u.pm * BM + wr * 64 + fr, e = u.pn >> 2, d0 = (u.pn & 3) * 256 + wc * 32 + 8 * fq;
#pragma unroll
        for (int ai = 0; ai < 2; ++ai)
#pragma unroll
            for (int m = 0; m < 4; ++m) { bf16_t* rowp = O + (size_t)e * NTOK * DM + (size_t)(row0 + ai * HALF + m * 16) * DM + d0;
#pragma unroll
                for (int bj = 0; bj < 2; ++bj) { const int d = d0 + bj * HALF;
                    st_bf8(rowp + bj * HALF, acc[ai][bj][m][0] + *(const f32x4*)(bias + e * DM + d), acc[ai][bj][m][1] + *(const f32x4*)(bias + e * DM + d + 4)); } }
    }
};

DEVINL void convT(float* tile, const float* src, int ldsrc, int K, int N, bf16_t* dst, int ldd, int drow0, int dcol0, const float* rs, int rdiv, int rmul, int bid = -1, int nb = 0) {
    const int tid = otid(), tK = (K + 63) / 64, tN = (N + 63) / 64;
    if (bid < 0) { bid = obid(); nb = gridDim.x; }
    for (int t = bid; t < tK * tN; t += nb) {
        const int k0 = (t / tN) * 64, n0 = (t % tN) * 64;
        __syncthreads();
#pragma unroll
        for (int p = 0; p < 8; ++p) { const int i = (tid >> 6) + 8 * p, j = tid & 63; float v = 0.f;
            if (k0 + i < K && n0 + j < N) { v = src[(size_t)(k0 + i) * ldsrc + n0 + j]; if (rs) v *= rs[k0 + i]; }
            tile[i * 65 + j] = v; }
        __syncthreads();
#pragma unroll
        for (int p = 0; p < 4; ++p) { const int j = (tid >> 5) + 16 * p, i = (tid & 31) * 2, n = n0 + j;
            if (n < N && k0 + i < K) { const int row = (n / rdiv) * rmul + (n % rdiv) + drow0;
                *(unsigned*)(dst + (size_t)row * ldd + dcol0 + k0 + i) = pk2(tile[i * 65 + j], tile[(i + 1) * 65 + j]); } }
    }
}
DEVINL void zero2d(bf16_t* dst, int ld, int r0, int r1, int c0, int c1, int bid = -1, int nb = 0) {
    const int w = (c1 - c0) / 2, n = (r1 - r0) * w;
    if (bid < 0) { bid = obid(); nb = gridDim.x; }
    for (int i = bid * 512 + otid(); i < n; i += nb * 512) { const int r = r0 + i / w, c = c0 + (i % w) * 2; *(unsigned*)(dst + (size_t)r * ld + c) = 0u; }
}
DEVINL void conv_ffn_w(float* tile, const PV& p, int layer, int w, bf16_t* slot, int bid, int nb) {
    const size_t o = (size_t)(layer * 2 + w) * DM * DFF;
    bf16_t* gu = slot + w * (FFN_WGU + FFN_WD); bf16_t* wd = gu + FFN_WGU;
    convT(tile, p.in(8) + o, DFF, DM, DFF, gu, DM, 0, 0, nullptr, 128, 256, bid, nb);
    convT(tile, p.in(9) + o, DFF, DM, DFF, gu, DM, 128, 0, nullptr, 128, 256, bid, nb);
    convT(tile, p.in(10) + o, DM, DFF, DM, wd, DFF, 0, 0, nullptr, 1 << 30, 0, bid, nb);
}
DEVINL void conv_ffn(float* tile, const PV& p, int layer, bf16_t* slot) { conv_ffn_w(tile, p, layer, 0, slot, obid(), gridDim.x); conv_ffn_w(tile, p, layer, 1, slot, obid(), gridDim.x); }

DEVINL void phase_prep(const PV& p, unsigned char* sm) {
    const int tid = otid(), wid = tid >> 6, lane = tid & 63;
    unsigned char* ws = p.ws;
    float* tile = (float*)sm;
    bf16_t* WM = (bf16_t*)(ws + WS_WM);
    {
        float* sc = (float*)sm; float* part = sc + 9 * 1024;
        for (int i = tid; i < 9 * 1024; i += 512) { const float v = i < 8192 ? p.in(1)[i] : p.in(3)[i - 8192]; sc[i] = silu_f(v); }
        __syncthreads();
        float* MOD = (float*)(ws + WS_MOD);
        for (int it = obid(); it < 4 * 144; it += gridDim.x) {
            const int layer = it / 144, col = (it % 144) * 64 + lane;
            const float* W = p.in(4) + (size_t)layer * DM * MODW + col;
            float a[9];
#pragma unroll
            for (int r = 0; r < 9; ++r) a[r] = 0.f;
            const int kb = wid * 128;
#pragma unroll 16
            for (int k = 0; k < 128; ++k) { const float w = W[(size_t)(kb + k) * MODW];
#pragma unroll
                for (int r = 0; r < 9; ++r) a[r] += sc[r * 1024 + kb + k] * w; }
#pragma unroll
            for (int r = 0; r < 9; ++r) part[(wid * 9 + r) * 64 + lane] = a[r];
            __syncthreads();
            for (int o = tid; o < 9 * 64; o += 512) { const int r = o >> 6, l = o & 63; float s = 0.f;
#pragma unroll
                for (int w = 0; w < 8; ++w) s += part[(w * 9 + r) * 64 + l];
                const int c = (it % 144) * 64 + l;
                MOD[((size_t)layer * 9 + r) * MODW + c] = s + p.in(5)[(size_t)layer * MODW + c]; }
            __syncthreads();
        }
    }
    { float* ct = (float*)(ws + WS_ROPE); float* st = ct + 1024;
      for (int i = obid() * 512 + tid; i < 1024; i += gridDim.x * 512) { const int pos = i >> 4, pp = i & 15;
          const float inv = exp2f(-(float)pp * (13.287712379549449f / 16.f)); const float ang = (float)pos * inv; ct[i] = cosf(ang); st[i] = sinf(ang); } }
    conv_ffn(tile, p, 0, (bf16_t*)(ws + WS_WF));
    for (int j = 0; j < 1; ++j) {
        bf16_t* M = WM + (j ? WM_MLA1 : WM_MLA0);
        convT(tile, p.in(11) + (size_t)j * 1024 * 512, 512, 1024, 512, M + MLA_DQKV, 1024, 0, 0, nullptr, 1 << 30, 0);
        convT(tile, p.in(14) + (size_t)j * 1024 * 320, 320, 1024, 320, M + MLA_DQKV, 1024, 512, 0, nullptr, 1 << 30, 0);
        zero2d(M + MLA_DQKV, 1024, 832, 1024, 0, 1024);
        convT(tile, p.in(13) + (size_t)j * 512 * 1536, 1536, 512, 1536, M + MLA_UQ, 512, 0, 0, nullptr, 1 << 30, 0);
        convT(tile, p.in(16) + (size_t)j * 256 * 2048, 2048, 256, 2048, M + MLA_UKV, 256, 0, 0, nullptr, 1 << 30, 0);
        convT(tile, p.in(17) + (size_t)j * 1024 * 1024, 1024, 1024, 1024, M + MLA_WO, 1024, 0, 0, nullptr, 1 << 30, 0);
    }
    __syncthreads();
}

DEVINL void prep_late(const PV& p, unsigned char* sm, int bid, int nb) {
    const int tid = otid(), wid = tid >> 6, lane = tid & 63;
    unsigned char* ws = p.ws;
    float* tile = (float*)sm;
    bf16_t* WM = (bf16_t*)(ws + WS_WM);
    (void)wid; (void)lane;
    { bf16_t* DT = WM + WM_DT2;
      for (size_t i = (size_t)bid * 512 + tid; i < (size_t)4096 * 1024; i += (size_t)nb * 512) {
          const int row = (int)(i >> 10), t = (int)(i & 1023) * 2, cs = row >> 11, to = row & 2047;
          float v[2];
#pragma unroll
          for (int q = 0; q < 2; ++q) { const int mm = (to * (t + q)) & 2047; const float x = (float)mm * (1.f / 1024.f); v[q] = (cs ? sinpif(x) : cospif(x)) * 0.022097086912079608f; }
          *(unsigned*)(DT + (size_t)row * 2048 + t) = pk2(v[0], v[1]); }
      bf16_t* DC = WM + WM_DT2C;
      for (int i = bid * 512 + tid; i < 512 * 128; i += nb * 512) {
          const int row = i >> 7, t = (i & 127) * 2, cs = row >> 8, to = row & 255;
          float v[2];
#pragma unroll
          for (int q = 0; q < 2; ++q) { const int mm = (to * (t + q)) & 255; const float x = (float)mm * (1.f / 128.f); v[q] = (cs ? sinpif(x) : cospif(x)) * 0.0625f; }
          *(unsigned*)(DC + (size_t)row * 256 + t) = pk2(v[0], v[1]); } }
    {
        __syncthreads();
        float* ctab = (float*)sm; float* stab = ctab + 128; float* wt = ctab + 256;
        if (tid < 128) { const float x = (float)tid * (1.f / 64.f); ctab[tid] = cospif(x) * 0.08838834764831845f; stab[tid] = -sinpif(x) * 0.08838834764831845f; }
        bf16_t* W2 = WM + WM_W2T; const float* wo = p.in(18);
        for (int it = bid; it < 128; it += nb) {
            const int g = it >> 4, n0 = (it & 15) * 64;
            __syncthreads();
            for (int q = tid; q < 128 * 64; q += 512) wt[q] = wo[(size_t)(g * 128 + (q >> 6)) * DM + n0 + (q & 63)];
            __syncthreads();
            const int k = tid & 127, cs = (tid >> 7) & 1, ng = tid >> 8; const float* tab = cs ? stab : ctab;
            float acc[32];
#pragma unroll
            for (int q = 0; q < 32; ++q) acc[q] = 0.f;
            for (int j = 0; j < 128; ++j) { const float t = tab[(k * j) & 127]; const float* wr = wt + j * 64 + ng * 32;
#pragma unroll
                for (int q = 0; q < 32; q += 4) { const f32x4 w4 = *(const f32x4*)(wr + q); acc[q] += t * w4[0]; acc[q + 1] += t * w4[1]; acc[q + 2] += t * w4[2]; acc[q + 3] += t * w4[3]; } }
#pragma unroll
            for (int q = 0; q < 32; ++q) W2[(size_t)(n0 + ng * 32 + q) * 2048 + cs * 1024 + g * 128 + k] = f2bf(acc[q]);
        }
        __syncthreads();
    }
    for (int j = 1; j < 2; ++j) {
        bf16_t* M = WM + (j ? WM_MLA1 : WM_MLA0);
        convT(tile, p.in(11) + (size_t)j * 1024 * 512, 512, 1024, 512, M + MLA_DQKV, 1024, 0, 0, nullptr, 1 << 30, 0, bid, nb);
        convT(tile, p.in(14) + (size_t)j * 1024 * 320, 320, 1024, 320, M + MLA_DQKV, 1024, 512, 0, nullptr, 1 << 30, 0, bid, nb);
        zero2d(M + MLA_DQKV, 1024, 832, 1024, 0, 1024, bid, nb);
        convT(tile, p.in(13) + (size_t)j * 512 * 1536, 1536, 512, 1536, M + MLA_UQ, 512, 0, 0, nullptr, 1 << 30, 0, bid, nb);
        convT(tile, p.in(16) + (size_t)j * 256 * 2048, 2048, 256, 2048, M + MLA_UKV, 256, 0, 0, nullptr, 1 << 30, 0, bid, nb);
        convT(tile, p.in(17) + (size_t)j * 1024 * 1024, 1024, 1024, 1024, M + MLA_WO, 1024, 0, 0, nullptr, 1 << 30, 0, bid, nb);
    }
    {
        bf16_t* WC = WM + WM_WCAT; const float* mix = p.in(20);
        for (int h = 0; h < 2; ++h) { const int dc = h * 1024;
            convT(tile, p.in(21), 1024, 1024, 1024, WC, 2048, 0, dc, h ? mix + 0 * 1024 : nullptr, 1 << 30, 0, bid, nb);
            convT(tile, p.in(22), 1024, 1024, 1024, WC, 2048, 1024, dc, h ? mix + 2 * 1024 : nullptr, 1 << 30, 0, bid, nb);
            convT(tile, p.in(23), 1024, 1024, 1024, WC, 2048, 2048, dc, h ? mix + 3 * 1024 : nullptr, 1 << 30, 0, bid, nb);
            for (int e = 0; e < 2; ++e) {
                convT(tile, p.in(25) + (size_t)e * 1024 * 64, 64, 1024, 64, WC, 2048, 3072 + e * 64, dc, h ? mix + 1 * 1024 : nullptr, 1 << 30, 0, bid, nb);
                convT(tile, p.in(28) + (size_t)e * 1024 * 64, 64, 1024, 64, WC, 2048, 3200 + e * 64, dc, h ? mix + 4 * 1024 : nullptr, 1 << 30, 0, bid, nb); }
            convT(tile, p.in(30), 160, 1024, 160, WC, 2048, 3328, dc, h ? mix + 5 * 1024 : nullptr, 1 << 30, 0, bid, nb); }
        zero2d(WC, 2048, 3488, 3584, 0, 2048, bid, nb);
        bf16_t* BW = WM + WM_BW; bf16_t* BA = WM + WM_BA; bf16_t* BG = WM + WM_BG;
        for (int e = 0; e < 2; ++e) {
            convT(tile, p.in(26) + (size_t)e * 64 * 1024, 1024, 64, 1024, BW, 256, e * 1024, e * 64, nullptr, 1 << 30, 0, bid, nb);
            convT(tile, p.in(29) + (size_t)e * 64 * 1024, 1024, 64, 1024, BA, 256, e * 1024, 128 + e * 64, nullptr, 1 << 30, 0, bid, nb);
            zero2d(BW, 256, e * 1024, e * 1024 + 1024, (1 - e) * 64, (1 - e) * 64 + 64, bid, nb); zero2d(BW, 256, e * 1024, e * 1024 + 1024, 128, 256, bid, nb);
            zero2d(BA, 256, e * 1024, e * 1024 + 1024, 128 + (1 - e) * 64, 128 + (1 - e) * 64 + 64, bid, nb); zero2d(BA, 256, e * 1024, e * 1024 + 1024, 0, 128, bid, nb); }
        convT(tile, p.in(31), 1024, 160, 1024, BG, 256, 0, 0, nullptr, 1 << 30, 0, bid, nb);
        zero2d(BG, 256, 0, 1024, 160, 256, bid, nb);
        convT(tile, p.in(37), 1024, 1024, 1024, WM + WM_RWO, 1024, 0, 0, nullptr, 1 << 30, 0, bid, nb);
    }
    __syncthreads();
}

struct RowArgs {
    const float* hin_l; const float* hin_c; float* hout_l; float* hout_c;
    const float* Y; const float* modp; int subp; const float* gpost; float coef;
    const float* modn; int subn; const float* gpre;
    bf16_t* xn; int xn_ld; int nrows; int upd_ctx; const float* Ys; int nslab;
    int pad_;
};
struct RowIn { f32x4 h[4], y[4]; };
DEVINL void row_load(const RowArgs& a, int r, int lane, RowIn& v) {
    const bool lat = r < NLAT; const int rc = r - NLAT;
    const float* hin = lat ? a.hin_l + (size_t)r * DM : a.hin_c + (size_t)rc * DM;
#pragma unroll
    for (int i = 0; i < 4; ++i) v.h[i] = *(const f32x4*)(hin + i * 256 + lane * 4);
    if (a.Y != nullptr && (lat || a.upd_ctx)) {
        if (lat || a.nslab == 0) {
#pragma unroll
            for (int i = 0; i < 4; ++i) { const u32x2 w = *(const u32x2*)((const bf16_t*)a.Y + (size_t)r * DM + i * 256 + lane * 4); v.y[i] = (f32x4){lo_bf(w.x), hi_bf(w.x), lo_bf(w.y), hi_bf(w.y)}; }
        } else {
#pragma unroll
            for (int i = 0; i < 4; ++i) v.y[i] = *(const f32x4*)(a.Ys + (size_t)rc * DM + i * 256 + lane * 4);
            for (int sl = 1; sl < a.nslab; ++sl) {
#pragma unroll
                for (int i = 0; i < 4; ++i) v.y[i] += *(const f32x4*)(a.Ys + ((size_t)sl * NCTX + rc) * DM + i * 256 + lane * 4); }
        }
    }
}
DEVINL void row_math(const RowArgs& a, int r, int lane, RowIn& v, f32x4 (&xo)[4]) {
    const bool lat = r < NLAT; const int rc = r - NLAT; const int mrow = lat ? (r >> 11) : 8;
    const float* hin = lat ? a.hin_l + (size_t)r * DM : a.hin_c + (size_t)rc * DM;
    float* hout = lat ? a.hout_l + (size_t)r * DM : a.hout_c + (size_t)rc * DM;
    const bool upd = a.Y != nullptr && (lat || a.upd_ctx);
    if (upd) {
        float ss = 0.f;
#pragma unroll
        for (int i = 0; i < 4; ++i)
#pragma unroll
            for (int j = 0; j < 4; ++j) ss += v.y[i][j] * v.y[i][j];
        ss = wave_sum_dpp(ss); const float rs = rsqrtf(ss * (1.f / 1024.f) + EPS) * a.coef;
        const float* gate = a.modp + (size_t)mrow * MODW + (a.subp * 3 + 2) * 1024;
#pragma unroll
        for (int i = 0; i < 4; ++i) { const int c = i * 256 + lane * 4; const f32x4 gt = *(const f32x4*)(gate + c), gp = *(const f32x4*)(a.gpost + c);
            v.h[i] += gt * (v.y[i] * gp) * rs; }
    }
    if (upd || hin != hout) {
#pragma unroll
        for (int i = 0; i < 4; ++i) *(f32x4*)(hout + i * 256 + lane * 4) = v.h[i];
    }
    if (a.modn) {
        float ss = 0.f;
#pragma unroll
        for (int i = 0; i < 4; ++i)
#pragma unroll
            for (int j = 0; j < 4; ++j) ss += v.h[i][j] * v.h[i][j];
        ss = wave_sum_dpp(ss); const float rs = rsqrtf(ss * (1.f / 1024.f) + EPS);
        const float* sh = a.modn + (size_t)mrow * MODW + (a.subn * 3 + 0) * 1024; const float* scl = sh + 1024;
#pragma unroll
        for (int i = 0; i < 4; ++i) { const int c = i * 256 + lane * 4; const f32x4 g = *(const f32x4*)(a.gpre + c), s1 = *(const f32x4*)(scl + c), s0 = *(const f32x4*)(sh + c);
            xo[i] = (v.h[i] * rs * g) * (s1 + 1.f) + s0; }
    }
}
DEVINL void row_core(const RowArgs& a, int r, int lane, f32x4 (&xo)[4]) { RowIn v; row_load(a, r, lane, v); row_math(a, r, lane, v, xo); }
DEVINL void phase_rows(const RowArgs& a) {
    const int lane = otid() & 63, gw = obid() * 8 + (otid() >> 6), nw = gridDim.x * 8;
    RowIn cur, n1, n2;
    if (gw < a.nrows) row_load(a, gw, lane, cur);
    if (gw + nw < a.nrows) row_load(a, gw + nw, lane, n1);
    for (int r = gw; r < a.nrows; r += nw) {
        if (r + 2 * nw < a.nrows) row_load(a, r + 2 * nw, lane, n2);
        f32x4 xo[4]; row_math(a, r, lane, cur, xo);
        if (a.modn) {
#pragma unroll
            for (int i = 0; i < 4; ++i) st_bf4(a.xn + (size_t)r * a.xn_ld + i * 256 + lane * 4, xo[i]);
        }
        cur = n1; n1 = n2;
    }
}
DEVINL void phase_rows_T(const RowArgs& a, unsigned char* sm, bf16_t* XT, bf16_t* XTc) {
    const int tid = otid(), wid = tid >> 6, lane = tid & 63;
    constexpr int RS = 2052;
    for (int tl = obid(); tl < NTOK / 64; tl += gridDim.x) {
        __syncthreads();
        RowIn cur, nxt; row_load(a, tl * 64 + wid * 8, lane, cur);
        for (int q = 0; q < 8; ++q) { const int lr = wid * 8 + q, r = tl * 64 + lr; f32x4 xo[4];
            if (q < 7) row_load(a, r + 1, lane, nxt);
            row_math(a, r, lane, cur, xo); cur = nxt;
#pragma unroll
            for (int i = 0; i < 4; ++i) { u32x2 w; w.x = pk2(xo[i][0], xo[i][1]); w.y = pk2(xo[i][2], xo[i][3]);
                unsigned* dp = (unsigned*)(sm + lr * RS + (i * 256 + lane * 4) * 2); dp[0] = w.x; dp[1] = w.y; } }
        __syncthreads();
        const int r0 = tl * 64; const bool lat = r0 < NLAT; const int b = lat ? (r0 >> 11) : ((r0 - NLAT) >> 8), t0 = lat ? (r0 & 2047) : ((r0 - NLAT) & 255), T = lat ? 2048 : 256;
        bf16_t* dstb = (lat ? XT : XTc) + (size_t)b * 1024 * T + t0;
        for (int it = tid; it < 1024 * 8; it += 512) { const int d = it >> 3, tc = it & 7; unsigned w[4];
#pragma unroll
            for (int q = 0; q < 4; ++q) { const unsigned lo = *(const bf16_t*)(sm + (tc * 8 + q * 2) * RS + d * 2), hi = *(const bf16_t*)(sm + (tc * 8 + q * 2 + 1) * RS + d * 2); w[q] = lo | (hi << 16); }
            *(u32x4*)(dstb + (size_t)d * T + tc * 8) = (u32x4){w[0], w[1], w[2], w[3]}; }
    }
    __syncthreads();
}

DEVINL void phase_mla_norm(const PV& p, int j, const float* raw, bf16_t* QN, bf16_t* CKVN, bf16_t* Kb) {
    const int lane = otid() & 63, gw = obid() * 8 + (otid() >> 6), nw = gridDim.x * 8;
    const float* qg = p.in(12) + j * 512; const float* kg = p.in(15) + j * 256;
    const float* ct = (const float*)(p.ws + WS_ROPE); const float* st = ct + 1024;
    for (int r = gw; r < NTOK; r += nw) {
        const float* row = raw + (size_t)r * 1024;
        f32x4 q0 = *(const f32x4*)(row + lane * 4), q1 = *(const f32x4*)(row + 256 + lane * 4), kv = *(const f32x4*)(row + 512 + lane * 4);
        const float kp = row[768 + lane];
        float sq = 0.f, sk = 0.f;
#pragma unroll
        for (int i = 0; i < 4; ++i) { sq += q0[i] * q0[i] + q1[i] * q1[i]; sk += kv[i] * kv[i]; }
        sq = wave_sum_dpp(sq); sk = wave_sum_dpp(sk);
        const float rq = rsqrtf(sq * (1.f / 512.f) + EPS), rk = rsqrtf(sk * (1.f / 256.f) + EPS);
        st_bf4(QN + (size_t)r * 512 + lane * 4, q0 * rq * *(const f32x4*)(qg + lane * 4));
        st_bf4(QN + (size_t)r * 512 + 256 + lane * 4, q1 * rq * *(const f32x4*)(qg + 256 + lane * 4));
        st_bf4(CKVN + (size_t)r * 256 + lane * 4, kv * rk * *(const f32x4*)(kg + lane * 4));
        int b, tk; bool lat; tok_of_row(r, b, tk, lat);
        const float other = __shfl_xor(kp, 16); float o = kp;
        if (lat) { const int axis = lane >> 5, half = (lane >> 4) & 1, pp = lane & 15, pos = axis == 0 ? (tk >> 6) : (tk & 63);
            const float c = ct[pos * 16 + pp], s = st[pos * 16 + pp];
            o = half == 0 ? kp * c - other * s : kp * c + other * s; }
        const bf16_t ob = f2bf(o);
#pragma unroll
        for (int h = 0; h < 8; ++h) Kb[((size_t)(b * 8 + h) * TKV + tk) * 192 + 128 + lane] = ob;
    }
}

constexpr int QBLK = 32, KVBLK = 64, NW = 8;
constexpr float ATT_SCALE = 0.07216878364870322f;
constexpr float ATT_THR = 8.f;
constexpr size_t SHM_V = KVBLK * 128 * 2, SHM_K = KVBLK * 192 * 2;
#define KSWZ(row, colB) ((row) * 384 + ((colB) ^ ((((row) >> 1) & 7) << 4)))
#define SBAR() __builtin_amdgcn_sched_barrier(0)
DEVINL int crow(int r, int hi) { return (r & 3) + 8 * (r >> 2) + 4 * hi; }
DEVINL void partialSM(f32x16& p0, f32x16& p1, float& m_reg, float& mn, float& alpha) {
    constexpr float C = ATT_SCALE * 1.4426950408889634f;
    float pmax = p0[0];
#pragma unroll
    for (int r = 1; r < 16; ++r) pmax = fmaxf(pmax, p0[r]);
#pragma unroll
    for (int r = 0; r < 16; ++r) pmax = fmaxf(pmax, p1[r]);
    { auto rr = __builtin_amdgcn_permlane32_swap(__float_as_uint(pmax), __float_as_uint(pmax), false, false);
      pmax = fmaxf(__uint_as_float(rr[0]), __uint_as_float(rr[1])); }
    if (__builtin_expect(__all(pmax - m_reg <= ATT_THR / ATT_SCALE), 1)) { mn = m_reg; alpha = 1.f; }
    else { mn = fmaxf(m_reg, pmax); alpha = __builtin_amdgcn_exp2f((m_reg - mn) * C); m_reg = mn; }
    const float mnC = -mn * C;
#pragma unroll
    for (int r = 0; r < 16; ++r) p0[r] = fmaf(p0[r], C, mnC);
#pragma unroll
    for (int r = 0; r < 16; ++r) p1[r] = fmaf(p1[r], C, mnC);
#pragma unroll
    for (int r = 0; r < 16; ++r) p0[r] = __builtin_amdgcn_exp2f(p0[r]);
}
DEVINL void finishSM(f32x16& p0, f32x16& p1, float alpha, float& l_reg, bf16x8& pa0, bf16x8& pa1, bf16x8& pa2, bf16x8& pa3) {
#pragma unroll
    for (int r = 0; r < 16; ++r) p1[r] = __builtin_amdgcn_exp2f(p1[r]);
    float ps = 0;
#pragma unroll
    for (int r = 0; r < 16; ++r) ps += p0[r];
#pragma unroll
    for (int r = 0; r < 16; ++r) ps += p1[r];
    { auto rr = __builtin_amdgcn_permlane32_swap(__float_as_uint(ps), __float_as_uint(ps), false, false);
      ps = __uint_as_float(rr[0]) + __uint_as_float(rr[1]); }
    l_reg = l_reg * alpha + ps;
#define PK4(P, BASE, OUT) do { unsigned a0 = pk2(P[BASE + 0], P[BASE + 1]), a1 = pk2(P[BASE + 2], P[BASE + 3]);   \
    unsigned b0 = pk2(P[BASE + 4], P[BASE + 5]), b1 = pk2(P[BASE + 6], P[BASE + 7]);                              \
    auto r0 = __builtin_amdgcn_permlane32_swap(a0, b0, false, false); auto r1 = __builtin_amdgcn_permlane32_swap(a1, b1, false, false); \
    u32x4 w = {r0[0], r1[0], r0[1], r1[1]}; OUT = *reinterpret_cast<bf16x8*>(&w); } while (0)
    PK4(p0, 0, pa0); PK4(p0, 8, pa1); PK4(p1, 0, pa2); PK4(p1, 8, pa3);
#undef PK4
}
DEVINL void qkt(f32x16& p0, f32x16& p1, const char* Ks, const bf16x8* qr, const char* qpe, int qsw, int r32, int hi) {
    p0 = f32x16{}; p1 = f32x16{};
#pragma unroll
    for (int d0 = 0; d0 < 12; ++d0) { const int cb = (d0 * 16 + hi * 8) * 2;
        const bf16x8 b0 = *reinterpret_cast<const bf16x8*>(Ks + KSWZ(r32, cb));
        const bf16x8 b1 = *reinterpret_cast<const bf16x8*>(Ks + KSWZ(32 + r32, cb));
        const bf16x8 q = d0 < 8 ? qr[d0 < 8 ? d0 : 0] : *reinterpret_cast<const bf16x8*>(qpe + (((((d0 - 8) * 2 + hi) ^ qsw) & 7) << 4));
        p0 = __builtin_amdgcn_mfma_f32_32x32x16_bf16(b0, q, p0, 0, 0, 0);
        p1 = __builtin_amdgcn_mfma_f32_32x32x16_bf16(b1, q, p1, 0, 0, 0); }
}
DEVINL int v_st(int k, int c) { const int kk = (k & ~0xC) | ((k & 4) << 1) | ((k & 8) >> 1); return ((kk >> 3) * 4 + (c >> 5)) * 512 + ((kk & 7) * 32 + (c & 31)) * 2; }
DEVINL int v_rd_base(int lane) { return ((lane & 3) << 3) | (((lane >> 2) & 3) << 6) | (((lane >> 4) & 1) << 5) | (((lane >> 5) & 1) << 8); }
constexpr int v_rd_off(int d0, int ks, int half) { return d0 * 512 + ks * 4096 + half * 2048; }
template <int OFF> DEVINL s16x4 tr_read(int vb) { s16x4 r; asm volatile("ds_read_b64_tr_b16 %0, %1 offset:%2" : "=&v"(r) : "v"(vb), "i"(OFF) : "memory"); return r; }
template <int D0> DEVINL void pv_one(f32x16& od, int vb, bf16x8 pa0, bf16x8 pa1, bf16x8 pa2, bf16x8 pa3) {
    const s16x4 l0 = tr_read<v_rd_off(D0, 0, 0)>(vb), h0 = tr_read<v_rd_off(D0, 0, 1)>(vb), l1 = tr_read<v_rd_off(D0, 1, 0)>(vb), h1 = tr_read<v_rd_off(D0, 1, 1)>(vb);
    const s16x4 l2 = tr_read<v_rd_off(D0, 2, 0)>(vb), h2 = tr_read<v_rd_off(D0, 2, 1)>(vb), l3 = tr_read<v_rd_off(D0, 3, 0)>(vb), h3 = tr_read<v_rd_off(D0, 3, 1)>(vb);
    asm volatile("s_waitcnt lgkmcnt(0)" ::: "memory"); SBAR();
#define PK(L, H) (bf16x8){L[0], L[1], L[2], L[3], H[0], H[1], H[2], H[3]}
    od = __builtin_amdgcn_mfma_f32_32x32x16_bf16(pa0, PK(l0, h0), od, 0, 0, 0);
    od = __builtin_amdgcn_mfma_f32_32x32x16_bf16(pa1, PK(l1, h1), od, 0, 0, 0);
    od = __builtin_amdgcn_mfma_f32_32x32x16_bf16(pa2, PK(l2, h2), od, 0, 0, 0);
    od = __builtin_amdgcn_mfma_f32_32x32x16_bf16(pa3, PK(l3, h3), od, 0, 0, 0);
#undef PK
}
DEVINL void pv_d0(f32x16* o, int vb, bf16x8 pa0, bf16x8 pa1, bf16x8 pa2, bf16x8 pa3) {
    pv_one<0>(o[0], vb, pa0, pa1, pa2, pa3); pv_one<1>(o[1], vb, pa0, pa1, pa2, pa3); pv_one<2>(o[2], vb, pa0, pa1, pa2, pa3); pv_one<3>(o[3], vb, pa0, pa1, pa2, pa3);
}
DEVINL void attn_body(const bf16_t* __restrict__ Qb, const bf16_t* __restrict__ Kh, const bf16_t* __restrict__ Vh, bf16_t* __restrict__ Ob, int seq, char* lds) {
    const int tid = otid(), wid = tid >> 6, lane = tid & 63, r32 = lane & 31, hi = lane >> 5;
    char* V_lds = lds; char* K_lds = lds + 2 * SHM_V;
    float* wsm = (float*)(lds + 2 * SHM_V + 2 * SHM_K) + wid * 64; float* li_l = wsm; float* al_l = wsm + 32;
    float m_reg = -1e30f, l_reg = 0; f32x16 o[4] = {}; bf16x8 qr[8];
    const bf16_t* Qw = Qb + (long)(wid * QBLK + r32) * 192 + hi * 8;
    char* qpe = lds + 2 * SHM_V + 2 * SHM_K + 2048 + wid * 4096 + r32 * 128; const int qsw = (r32 >> 1) & 7;
#pragma unroll
    for (int d0 = 0; d0 < 8; ++d0) qr[d0] = *reinterpret_cast<const bf16x8*>(Qw + d0 * 16);
#pragma unroll
    for (int d0 = 8; d0 < 12; ++d0) *reinterpret_cast<bf16x8*>(qpe + (((((d0 - 8) * 2 + hi) ^ qsw) & 7) << 4)) = *reinterpret_cast<const bf16x8*>(Qw + d0 * 16);
    const int sr = tid >> 4, sc = (tid & 15) * 8, vst0 = v_st(sr, sc), vst1 = v_st(32 + sr, sc);
    int kst[3];
#pragma unroll
    for (int i = 0; i < 3; ++i) { const int id = tid + 512 * i, row = id / 24, ch = id % 24; kst[i] = KSWZ(row, ch * 16); }
    const int vb0 = (int)(uintptr_t)V_lds + v_rd_base(lane);
    bf16x8 vs0, vs1, ks0, ks1, ks2;
#define SLOAD(k0) do { vs0 = *reinterpret_cast<const bf16x8*>(&Vh[(long)((k0) + sr) * 128 + sc]); vs1 = *reinterpret_cast<const bf16x8*>(&Vh[(long)((k0) + 32 + sr) * 128 + sc]); \
    const bf16_t* kp_ = Kh + (long)(k0) * 192 + tid * 8; ks0 = *reinterpret_cast<const bf16x8*>(kp_); ks1 = *reinterpret_cast<const bf16x8*>(kp_ + 4096); ks2 = *reinterpret_cast<const bf16x8*>(kp_ + 8192); } while (0)
#define SWRITE(b) do { *(bf16x8*)(V_lds + (b) * SHM_V + vst0) = vs0; *(bf16x8*)(V_lds + (b) * SHM_V + vst1) = vs1; \
    *(bf16x8*)(K_lds + (b) * SHM_K + kst[0]) = ks0; *(bf16x8*)(K_lds + (b) * SHM_K + kst[1]) = ks1; *(bf16x8*)(K_lds + (b) * SHM_K + kst[2]) = ks2; } while (0)
#define RESC(a) do { if (__any((a) < 1.f)) { if (hi == 0) al_l[r32] = (a); asm volatile("s_waitcnt lgkmcnt(0)" ::: "memory"); \
    _Pragma("unroll") for (int d = 0; d < 4; ++d) _Pragma("unroll") for (int r = 0; r < 16; ++r) o[d][r] *= al_l[crow(r, hi)]; } } while (0)
    f32x16 pA0, pA1, pB0, pB1; float mnA, mnB, alA, alB; bf16x8 pa0, pa1, pa2, pa3; const int NT = seq / KVBLK;
    __syncthreads();
    SLOAD(0); WAIT_V0(); SWRITE(0); __syncthreads();
    qkt(pA0, pA1, K_lds, qr, qpe, qsw, r32, hi); partialSM(pA0, pA1, m_reg, mnA, alA);
    SLOAD(KVBLK);
    WAIT_V0(); SWRITE(1); __syncthreads();
    for (int j = 1; j + 1 < NT; j += 2) {
        SBAR(); qkt(pB0, pB1, K_lds + SHM_K, qr, qpe, qsw, r32, hi);
        finishSM(pA0, pA1, alA, l_reg, pa0, pa1, pa2, pa3); SBAR();
        SLOAD((j + 1) * KVBLK); SBAR();
        pv_d0(o, vb0, pa0, pa1, pa2, pa3); partialSM(pB0, pB1, m_reg, mnB, alB);
        __syncthreads(); WAIT_V0(); SWRITE(0);
        RESC(alB); __syncthreads();
        SBAR(); qkt(pA0, pA1, K_lds, qr, qpe, qsw, r32, hi);
        finishSM(pB0, pB1, alB, l_reg, pa0, pa1, pa2, pa3); SBAR();
        SLOAD((j + 2) * KVBLK); SBAR();
        pv_d0(o, vb0 + (int)SHM_V, pa0, pa1, pa2, pa3); partialSM(pA0, pA1, m_reg, mnA, alA);
        __syncthreads(); WAIT_V0(); SWRITE(1);
        RESC(alA); __syncthreads();
    }
    SBAR(); qkt(pB0, pB1, K_lds + SHM_K, qr, qpe, qsw, r32, hi);
    finishSM(pA0, pA1, alA, l_reg, pa0, pa1, pa2, pa3); SBAR();
    pv_d0(o, vb0, pa0, pa1, pa2, pa3); partialSM(pB0, pB1, m_reg, mnB, alB);
    __syncthreads(); RESC(alB);
    finishSM(pB0, pB1, alB, l_reg, pa0, pa1, pa2, pa3); SBAR();
    pv_d0(o, vb0 + (int)SHM_V, pa0, pa1, pa2, pa3);
    if (hi == 0) li_l[r32] = l_reg; asm volatile("s_waitcnt lgkmcnt(0)" ::: "memory");
    float rli[16];
#pragma unroll
    for (int r = 0; r < 16; ++r) rli[r] = __builtin_amdgcn_rcpf(li_l[crow(r, hi)]);
    bf16_t* Ow = Ob + (long)(wid * QBLK) * 1024;
#pragma unroll
    for (int r = 0; r < 16; ++r) { const int orow = crow(r, hi);
#pragma unroll
        for (int d0 = 0; d0 < 4; ++d0) Ow[(long)orow * 1024 + d0 * 32 + r32] = f2bf(o[d0][r] * rli[r]); }
#undef SLOAD
#undef SWRITE
#undef RESC
}
DEVINL void phase_attn(const bf16_t* Q, const bf16_t* K, const bf16_t* V, bf16_t* O, bool with_ctx, char* lds) {
    const int nu = 512 + (with_ctx ? 64 : 0);
    for (int u = obid(); u < nu; u += gridDim.x) {
        if (u < 512) {
            int bh = u >> 3, qb = u & 7;
            if (gridDim.x == 256) { const int x = u & 7, l = (u >> 8) * 32 + ((u & 255) >> 3); bh = x * 8 + (l >> 3); qb = l & 7; }
            const int b = bh >> 3, h = bh & 7;
            attn_body(Q + ((size_t)bh * TKV + qb * 256) * 192, K + (size_t)bh * TKV * 192, V + (size_t)bh * TKV * 128, O + ((size_t)(b * SEQ + qb * 256)) * 1024 + h * 128, TKV, lds); }
        else { const int bh = u - 512, b = bh >> 3, h = bh & 7;
            attn_body(Q + ((size_t)bh * TKV + SEQ) * 192, K + ((size_t)bh * TKV + SEQ) * 192, V + ((size_t)bh * TKV + SEQ) * 128, O + ((size_t)(NLAT + b * CTX)) * 1024 + h * 128, CTX, lds); }
    }
    __syncthreads();
}

DEVINL void phase_rwkv_shift(bf16_t* XN) {
    for (size_t it = (size_t)obid() * 512 + otid(); it < (size_t)NTOK * 128; it += (size_t)gridDim.x * 512) {
        const int r = (int)(it >> 7), c = (int)(it & 127) * 8; int b, tk; bool lat; tok_of_row(r, b, tk, lat);
        const int t = lat ? tk : tk - SEQ, T = lat ? SEQ : CTX;
        const bf16_t* up = XN + (size_t)r * 2048 + c;
        const u32x4 u0 = *(const u32x4*)up; u32x4 um = {0, 0, 0, 0}, upl = {0, 0, 0, 0};
        if (t > 0) um = *(const u32x4*)(up - 2048);
        if (t < T - 1) upl = *(const u32x4*)(up + 2048);
        u32x4 o;
#pragma unroll
        for (int q = 0; q < 4; ++q) { const float a = 0.5f * (lo_bf(um[q]) + lo_bf(upl[q])) - lo_bf(u0[q]), bq = 0.5f * (hi_bf(um[q]) + hi_bf(upl[q])) - hi_bf(u0[q]); o[q] = pk2(a, bq); }
        *(u32x4*)(XN + (size_t)r * 2048 + 1024 + c) = o;
    }
}
DEVINL void zero_f32(float* p, size_t n4) { for (size_t i = (size_t)obid() * 512 + otid(); i < n4; i += (size_t)gridDim.x * 512) ((f32x4*)p)[i] = (f32x4){0.f, 0.f, 0.f, 0.f}; }

DEVINL float red8(float v) {
    v += __builtin_bit_cast(float, __builtin_amdgcn_update_dpp(0, __builtin_bit_cast(int, v), 0xB1, 0xF, 0xF, false));
    v += __builtin_bit_cast(float, __builtin_amdgcn_update_dpp(0, __builtin_bit_cast(int, v), 0x4E, 0xF, 0xF, false));
    v += __builtin_bit_cast(float, __builtin_amdgcn_update_dpp(0, __builtin_bit_cast(int, v), 0x141, 0xF, 0xF, false));
    return v;
}
typedef float f32x2 __attribute__((ext_vector_type(2)));
struct StepOps { f32x4 a0, a1, q0, q1, w0, w1, b0, b1, k0, k1; float viA, viB; f32x2 sc2; };
DEVINL void phase_scan(const PV& p, const bf16_t* R, const bf16_t* Kf, const bf16_t* Vf, const bf16_t* AA, const bf16_t* LW, float* Y0, bf16_t* Y1, unsigned char* sm) {
    constexpr int TC = 32, NCH = (CTX + SEQ) / TC;
    const int tid = otid(), wid = __builtin_amdgcn_readfirstlane(tid >> 6), lane = tid & 63;
    float* Fb = (float*)sm;
    float* ybb = Fb + 2 * TC * 384;
    float* sclb = ybb + 2 * TC * 64;
    const float* kkp = p.in(32); const float* kap = p.in(33);
    for (int it = obid(); it < 256; it += gridDim.x) {
        const int e = it >> 7, b = (it >> 4) & 7, h = it & 15, ch = h * 64 + lane;
        __syncthreads();
        if (wid >= 4) {
            const int hw = wid - 4;
            const float k_k = kkp[ch], k_a = kap[ch];
            const bf16_t* Ae = AA + (size_t)e * NTOK * DM; const bf16_t* Le = LW + (size_t)e * NTOK * DM;
            bf16_t pr[8], pk[8], pv[8], pa[8], pl[8];
#define SC_ROW(c_, s_) ({ const int g_ = (c_) * TC + (s_); const bool cx_ = g_ < CTX; const int sl_ = cx_ ? g_ : g_ - CTX, T_ = cx_ ? CTX : SEQ; \
            (cx_ ? NLAT + b * CTX : b * SEQ) + (e == 0 ? sl_ : T_ - 1 - sl_); })
#define SC_LOAD(c_) do { _Pragma("unroll") for (int q = 0; q < 8; ++q) { const size_t o_ = (size_t)SC_ROW(c_, hw + 4 * q) * DM + ch; \
            pr[q] = R[o_]; pk[q] = Kf[o_]; pv[q] = Vf[o_]; pa[q] = Ae[o_]; pl[q] = Le[o_]; } } while (0)
#define SC_DERIVE(c_) do { float* F_ = Fb + ((c_) & 1) * TC * 384; float* scl_ = sclb + ((c_) & 1) * TC * 2; _Pragma("unroll") for (int q = 0; q < 8; ++q) { const int s = hw + 4 * q; \
            const float r = bf2f(pr[q]), k = bf2f(pk[q]), v = bf2f(pv[q]), a = sigm_f(bf2f(pa[q])), nx = -bf2f(pl[q]); \
            const float sp = fmaxf(nx, 0.f) + __logf(1.f + __expf(-fabsf(nx))), w = __expf(-__expf(-sp - 0.5f)); \
            const float kv = k * k_k; const float n2 = wave_sum_dpp(kv * kv); const float kk = kv * __builtin_amdgcn_rsqf(fmaxf(n2, 1e-24f)); \
            const float bb = kk * a, kd = k * (1.f + (a - 1.f) * k_a); \
            const float br = wave_sum_dpp(bb * r), kr = wave_sum_dpp(kd * r); \
            float* f = F_ + s * 384 + lane; \
            f[0] = -kk; f[64] = bb; f[128] = w; f[192] = kd; f[256] = w * r; f[320] = v; \
            if (lane == 0) { scl_[s * 2] = br; scl_[s * 2 + 1] = kr; } } } while (0)
#define SC_FLUSH(c_) do { const float* yb_ = ybb + ((c_) & 1) * TC * 64; _Pragma("unroll") for (int q = 0; q < 8; ++q) { const int s = hw + 4 * q; const size_t o_ = (size_t)SC_ROW(c_, s) * DM + ch; \
            const float yv = yb_[s * 64 + lane]; if (e == 0) Y0[o_] = yv; else Y1[o_] = f2bf(yv); } } while (0)
            SC_LOAD(0); SC_DERIVE(0); SC_LOAD(1);
            __syncthreads();
            for (int c = 0; c < NCH; ++c) {
                if (c + 1 < NCH) { SC_DERIVE(c + 1); if (c + 2 < NCH) SC_LOAD(c + 2); }
                if (c >= 1) SC_FLUSH(c - 1);
                __syncthreads();
            }
            SC_FLUSH(NCH - 1);
#undef SC_LOAD
#undef SC_DERIVE
#undef SC_FLUSH
#undef SC_ROW
        } else {
            f32x2 SA[4], SB[4];
#pragma unroll
            for (int j = 0; j < 4; ++j) { SA[j] = (f32x2){0.f, 0.f}; SB[j] = (f32x2){0.f, 0.f}; }
            const int iA = wid * 16 + (lane >> 3), iB = iA + 8, cg8 = (lane & 7) * 8;
            __syncthreads();
            for (int c = 0; c < NCH; ++c) {
                const float* F = Fb + (c & 1) * TC * 384; float* yb = ybb + (c & 1) * TC * 64; const float* scl = sclb + (c & 1) * TC * 2;
#define ST_LD(o, s_) do { const float* f_ = F + (s_) * 384 + cg8; o.a0 = *(const f32x4*)(f_); o.a1 = *(const f32x4*)(f_ + 4); o.q0 = *(const f32x4*)(f_ + 256); o.q1 = *(const f32x4*)(f_ + 260); \
                o.w0 = *(const f32x4*)(f_ + 128); o.w1 = *(const f32x4*)(f_ + 132); o.b0 = *(const f32x4*)(f_ + 64); o.b1 = *(const f32x4*)(f_ + 68); o.k0 = *(const f32x4*)(f_ + 192); o.k1 = *(const f32x4*)(f_ + 196); \
                o.viA = F[(s_) * 384 + 320 + iA]; o.viB = F[(s_) * 384 + 320 + iB]; o.sc2 = *(const f32x2*)(scl + (s_) * 2); } while (0)
#define P2(v, i) (f32x2){v[i], v[i + 1]}
#define ST_ROW(o, S, vi, irow, s_) do { \
                f32x2 da = S[0] * P2(o.a0, 0), dq = S[0] * P2(o.q0, 0); da += S[1] * P2(o.a0, 2); dq += S[1] * P2(o.q0, 2); \
                da += S[2] * P2(o.a1, 0); dq += S[2] * P2(o.q1, 0); da += S[3] * P2(o.a1, 2); dq += S[3] * P2(o.q1, 2); \
                float sa = da[0] + da[1], sy = dq[0] + dq[1]; \
                sa += DPPF(sa, 0xB1); sy += DPPF(sy, 0xB1); sa += DPPF(sa, 0x4E); sy += DPPF(sy, 0x4E); sa += DPPF(sa, 0x141); sy += DPPF(sy, 0x141); \
                const f32x2 sa2 = {sa, sa}, vi2 = {vi, vi}; \
                S[0] = S[0] * P2(o.w0, 0) + sa2 * P2(o.b0, 0) + vi2 * P2(o.k0, 0); S[1] = S[1] * P2(o.w0, 2) + sa2 * P2(o.b0, 2) + vi2 * P2(o.k0, 2); \
                S[2] = S[2] * P2(o.w1, 0) + sa2 * P2(o.b1, 0) + vi2 * P2(o.k1, 0); S[3] = S[3] * P2(o.w1, 2) + sa2 * P2(o.b1, 2) + vi2 * P2(o.k1, 2); \
                yb[(s_) * 64 + irow] = sy + sa * o.sc2[0] + vi * o.sc2[1]; } while (0)
                StepOps X, Z; ST_LD(X, 0);
#pragma unroll
                for (int s = 0; s < TC; s += 2) {
                    ST_LD(Z, s + 1);
                    ST_ROW(X, SA, X.viA, iA, s); ST_ROW(X, SB, X.viB, iB, s);
                    ST_LD(X, s + 2);
                    ST_ROW(Z, SA, Z.viA, iA, s + 1); ST_ROW(Z, SB, Z.viB, iB, s + 1);
                }
#undef ST_LD
#undef ST_ROW
#undef P2
                __syncthreads();
            }
        }
    }
    __syncthreads();
}
DEVINL void phase_rwkv_out(const PV& p, const float* Y, const bf16_t* Y1, const bf16_t* R, const bf16_t* Kf, const bf16_t* Vf, const bf16_t* AA, const bf16_t* Gg, bf16_t* XO) {
    const int lane = otid() & 63, gw = obid() * 8 + (otid() >> 6), nw = gridDim.x * 8;
    const float* k_a = p.in(33); const float* r_k = p.in(34); const float* lnw = p.in(35); const float* lnb = p.in(36);
    for (int r = gw; r < NTOK; r += nw) {
#pragma unroll
        for (int i = 0; i < 4; ++i) { const int c = i * 256 + lane * 4; const size_t o = (size_t)r * DM + c;
            const u32x2 y1w = *(const u32x2*)(Y1 + o);
            const f32x4 y = *(const f32x4*)(Y + o) + (f32x4){lo_bf(y1w.x), hi_bf(y1w.x), lo_bf(y1w.y), hi_bf(y1w.y)};
            const u32x2 rw = *(const u32x2*)(R + o), kw = *(const u32x2*)(Kf + o), vw = *(const u32x2*)(Vf + o), a0w = *(const u32x2*)(AA + o), a1w = *(const u32x2*)(AA + (size_t)NTOK * DM + o), gw2 = *(const u32x2*)(Gg + o);
            const f32x4 rr = {lo_bf(rw.x), hi_bf(rw.x), lo_bf(rw.y), hi_bf(rw.y)}, kk = {lo_bf(kw.x), hi_bf(kw.x), lo_bf(kw.y), hi_bf(kw.y)}, vv = {lo_bf(vw.x), hi_bf(vw.x), lo_bf(vw.y), hi_bf(vw.y)};
            const f32x4 a0 = {sigm_f(lo_bf(a0w.x)), sigm_f(hi_bf(a0w.x)), sigm_f(lo_bf(a0w.y)), sigm_f(hi_bf(a0w.y))}, a1 = {sigm_f(lo_bf(a1w.x)), sigm_f(hi_bf(a1w.x)), sigm_f(lo_bf(a1w.y)), sigm_f(hi_bf(a1w.y))}, gg = {lo_bf(gw2.x), hi_bf(gw2.x), lo_bf(gw2.y), hi_bf(gw2.y)};
            const f32x4 ka = *(const f32x4*)(k_a + c), rk = *(const f32x4*)(r_k + c), lw = *(const f32x4*)(lnw + c), lb = *(const f32x4*)(lnb + c);
            float s = y[0] + y[1] + y[2] + y[3]; s = sum16(s); const float mu = s * (1.f / 64.f);
            const f32x4 d = y - mu; float vs = d[0] * d[0] + d[1] * d[1] + d[2] * d[2] + d[3] * d[3]; vs = sum16(vs);
            const float rstd = rsqrtf(vs * (1.f / 64.f) + 64e-5f);
            const f32x4 kd = kk * ((a0 + a1 - 2.f) * ka + 2.f);
            const f32x4 cf = rr * kd * rk; float co = cf[0] + cf[1] + cf[2] + cf[3]; co = sum16(co);
            const f32x4 out = (d * rstd * lw + lb + vv * co) * gg;
            st_bf4(XO + o, out); }
    }
}

enum { OP_PREP, OP_ROW0, OP_ROW_A, OP_ROW_B, OP_ROW_C, OP_FFN_UP, OP_FFN_DN, OP_MLA_DQKV, OP_MLA_NORM, OP_MLA_UQ, OP_MLA_UKV, OP_MLA_ATTN, OP_MLA_WO,
       OP_FN_DFT, OP_FN_DFTC, OP_FN_OUT, OP_RW_SHIFT, OP_RW_G1, OP_RW_G2W, OP_RW_G2A, OP_RW_G2G, OP_RW_SCAN, OP_RW_OUT, OP_RW_WO };
#define OPC(op, layer, which, nosync) ((op) | ((layer) << 8) | ((which) << 12) | ((nosync) << 16))
#define FFN1(l) OPC(OP_FFN_UP, l, 0, 0), OPC(OP_FFN_DN, l, 0, 0), OPC(OP_ROW_A, l, 0, 0)
#define FFN2(l) OPC(OP_ROW_B, l, 0, 0), OPC(OP_FFN_UP, l, 1, 0), OPC(OP_FFN_DN, l, 1, 0), OPC(OP_ROW_C, l, 0, 0)
#define MLA(l) OPC(OP_MLA_DQKV, l, 0, 0), OPC(OP_MLA_NORM, l, 0, 0), OPC(OP_MLA_UQ, l, 0, 1), OPC(OP_MLA_UKV, l, 0, 0), OPC(OP_MLA_ATTN, l, 0, 0), OPC(OP_MLA_WO, l, 0, 0)
constexpr int PROG[] = {
    OPC(OP_PREP, 0, 0, 0), OPC(OP_ROW0, 0, 0, 0),
    FFN1(0), MLA(0), FFN2(0),
    FFN1(1), OPC(OP_FN_DFT, 1, 0, 1), OPC(OP_FN_DFTC, 1, 0, 0), OPC(OP_FN_OUT, 1, 0, 0), FFN2(1),
    FFN1(2), OPC(OP_RW_SHIFT, 2, 0, 0), OPC(OP_RW_G1, 2, 0, 0), OPC(OP_RW_G2W, 2, 0, 1), OPC(OP_RW_G2A, 2, 0, 1), OPC(OP_RW_G2G, 2, 0, 0), OPC(OP_RW_SCAN, 2, 0, 0),
             OPC(OP_RW_OUT, 2, 0, 0), OPC(OP_RW_WO, 2, 0, 0), FFN2(2),
    FFN1(3), MLA(3), FFN2(3) };
constexpr int NPROG = 2 + (3 + 6 + 4) + (3 + 3 + 4) + (3 + 8 + 4) + (3 + 6 + 4);

#define XB_TMO      128
#define XB_XCNT(j)  (256  + 64 * (j))
#define XB_XSUB(j)  (1280 + 64 * (j))
#define XB_XGEN(j)  (2304 + 64 * (j))
#define XB_TOP      3328
#define XB_TOPGEN   3392
#define XCD_BAR_WORDS 3456
#define XB_SPIN_CAP (1u << 20)
DEVINL unsigned xb_ld(unsigned* p)              { return __hip_atomic_load(p, __ATOMIC_RELAXED, __HIP_MEMORY_SCOPE_AGENT); }
DEVINL unsigned xb_add(unsigned* p, unsigned v) { return __hip_atomic_fetch_add(p, v, __ATOMIC_RELAXED, __HIP_MEMORY_SCOPE_AGENT); }
DEVINL unsigned xb_xcc_id() { return (unsigned)__builtin_amdgcn_s_getreg((3 << 11) | 20) & 0xFu; }
#define XB_SPIN(cond, bar) do { unsigned _sp = 0; while (cond) { __builtin_amdgcn_s_sleep(1); \
    if ((++_sp & 255u) == 0u) { if (xb_ld(&(bar)[XB_TMO])) break; if (_sp > XB_SPIN_CAP) { atomicAdd(&(bar)[XB_TMO], 1u); break; } } } } while (0)
DEVINL void xcd_barrier_post(unsigned* bar) { if (otid() == 0) (void)xb_add(&bar[XB_XCNT(xb_xcc_id())], 1u); }
DEVINL void xcd_barrier_complete(unsigned* bar, unsigned x, unsigned& nloc, unsigned& nx) {
    const unsigned G = gridDim.x;
    unsigned sum, cnt, mine, sp = 0u;
    for (;;) {
        sum = 0u; cnt = 0u; mine = 0u;
#pragma unroll
        for (unsigned j = 0; j < 16; ++j) { const unsigned c = xb_ld(&bar[XB_XCNT(j)]); sum += c; cnt += (c > 0u) ? 1u : 0u; mine = (j == x) ? c : mine; }
        if (sum == G) break;
        __builtin_amdgcn_s_sleep(1);
        if ((++sp & 255u) == 0u) { if (xb_ld(&bar[XB_TMO])) break; if (sp > XB_SPIN_CAP) { atomicAdd(&bar[XB_TMO], 1u); break; } }
    }
    nloc = mine > 0u ? mine : 1u; nx = cnt > 0u ? cnt : 1u;
}
DEVINL void xcd_barrier(unsigned* bar, volatile LAS unsigned* st) {
    asm volatile("s_waitcnt vmcnt(0)" ::: "memory");
    __syncthreads();
    if (otid() == 0) {
        const unsigned x = xb_xcc_id();
        __builtin_amdgcn_s_waitcnt(0);
        unsigned nloc = st[0], nx = st[1];
        if (nloc == 0u) { xcd_barrier_complete(bar, x, nloc, nx); st[0] = nloc; st[1] = nx; }
        const unsigned old = xb_add(&bar[XB_XSUB(x)], 1u);
        const unsigned gen = old / nloc;
        if (old + 1u == (gen + 1u) * nloc) {
            __builtin_amdgcn_fence(__ATOMIC_RELEASE, "agent");
            asm volatile("s_waitcnt vmcnt(0)" ::: "memory");
            const unsigned og = xb_add(&bar[XB_TOP], 1u);
            const unsigned tg = og / nx;
            if (og + 1u == (tg + 1u) * nx) xb_add(&bar[XB_TOPGEN], 1u);
            else XB_SPIN(xb_ld(&bar[XB_TOPGEN]) == tg, bar);
            __builtin_amdgcn_fence(__ATOMIC_ACQUIRE, "agent");
            xb_add(&bar[XB_XGEN(x)], 1u);
            asm volatile("s_waitcnt vmcnt(0)" ::: "memory");
        } else {
            XB_SPIN(xb_ld(&bar[XB_XGEN(x)]) == gen, bar);
            __builtin_amdgcn_fence(__ATOMIC_ACQUIRE, "agent");
            asm volatile("s_waitcnt vmcnt(0)" ::: "memory");
        }
    }
    __syncthreads();
}
constexpr int bar_ordinal(int pc) { int n = 0; for (int q = 1; q <= pc; ++q) if (!((PROG[q] >> 16) & 1)) ++n; return n; }
template <int PC>
DEVINL void run_prog(const Params& kp, unsigned char* smem, cg::grid_group& grid) {
    LAS unsigned char* lds = (LAS unsigned char*)smem;
    {
        constexpr int code = PROG[PC], op = code & 0xff, i = (code >> 8) & 0xf, which = (code >> 12) & 0xf, nosync = (code >> 16) & 1;
        unsigned char* ws = kp.ws;
        const int zz = 0;
        float* outp = kp.out;
        const PV p{kp, zz, ws, outp};
        float* MOD = (float*)(ws + WS_MOD); float* HC = (float*)(ws + WS_HC); bf16_t* XN = (bf16_t*)(ws + WS_XN); float* Y = (float*)(ws + WS_Y);
        bf16_t* WM = (bf16_t*)(ws + WS_WM); unsigned char* SCR = ws + WS_SCR;
        const float* npre = p.in(6); const float* npost = p.in(7);
        const int kind = i % 3, j = i / 3; const bool last = (i == 3);
        const float* modi = MOD + (size_t)i * 9 * MODW;
        bf16_t* slot = (bf16_t*)(ws + WS_WF) + (size_t)(i & 1) * FFN_SLOT;
        bf16_t* G = (bf16_t*)(SCR + S_G);
        bf16_t* M = WM + (j ? WM_MLA1 : WM_MLA0);
        switch (op) {
        case OP_PREP: phase_prep(p, smem); break;
        case OP_ROW0: case OP_ROW_A: case OP_ROW_B: case OP_ROW_C: {
            RowArgs a{}; a.hin_l = p.out; a.hin_c = HC; a.hout_l = p.out; a.hout_c = HC; a.Y = Y; a.modp = modi; a.xn = XN; a.xn_ld = 1024; a.nrows = NTOK; a.upd_ctx = 1; a.modn = modi;
            if (op == OP_ROW0) { a.hin_l = p.in(0); a.hin_c = p.in(2); a.Y = nullptr; a.subn = 0; a.gpre = npre; }
            else if (op == OP_ROW_A) { a.Ys = (const float*)(ws + WS_SLAB); a.nslab = NSLAB; a.subp = 0; a.gpost = npost + (i * 3 + 0) * 1024; a.coef = 0.5f; a.subn = 1; a.gpre = npre + (i * 3 + 1) * 1024; a.xn_ld = (kind == 2) ? 2048 : 1024; }
            else if (op == OP_ROW_B) { a.Ys = (const float*)(ws + WS_SLAB); a.nslab = last ? 0 : 4; a.subp = 1; a.gpost = npost + (i * 3 + 1) * 1024; a.coef = 1.0f; a.subn = 2; a.gpre = npre + (i * 3 + 2) * 1024; a.nrows = last ? NLAT : NTOK; }
            else { a.Ys = (const float*)(ws + WS_SLAB); a.nslab = last ? 0 : NSLAB; a.subp = 2; a.gpost = npost + (i * 3 + 2) * 1024; a.coef = 0.5f; a.nrows = last ? NLAT : NTOK;
                   if (last) a.modn = nullptr; else { a.modn = MOD + (size_t)(i + 1) * 9 * MODW; a.subn = 0; a.gpre = npre + ((i + 1) * 3 + 0) * 1024; } }
            if (op == OP_ROW_A && kind == 1) phase_rows_T(a, smem, (bf16_t*)(SCR + S_XT), (bf16_t*)(SCR + S_XTC)); else phase_rows(a);
        } break;
        case OP_FFN_UP: { Gemm g{XN, slot + (size_t)which * (FFN_WGU + FFN_WD), 1024, 1024, 1024, ((last && which) ? NLAT : NTOK) / 256, 2 * DFF / 256, 0, 0}; EpiSwiGLU E{G}; gemm_phase(lds, g, E);
            if (i < 3) { const int nbusy = (g.nM * g.nN) % (int)gridDim.x, bid = obid();
                if (bid >= nbusy) { __syncthreads(); conv_ffn_w((float*)smem, p, i + 1, which, (bf16_t*)(ws + WS_WF) + (size_t)((i + 1) & 1) * FFN_SLOT, bid - nbusy, (int)gridDim.x - nbusy); } } } break;
        case OP_MLA_DQKV: { Gemm g{XN, M + MLA_DQKV, 1024, 1024, 1024, NTOK / 256, 4, 0, 0}; EpiF32 E{Y, 1024, nullptr, nullptr}; gemm_phase(lds, g, E);
            if (i == 0) { const int nbusy = (g.nM * g.nN) % (int)gridDim.x, bid = obid(); if (bid >= nbusy) { __syncthreads(); prep_late(p, smem, bid - nbusy, (int)gridDim.x - nbusy); } } } break;
        case OP_FFN_DN: case OP_MLA_WO: case OP_FN_OUT: case OP_RW_WO: {
            Gemm g{XN, M + MLA_WO, 1024, 1024, 1024, NLAT / 256, 4, 0, 0}; EpiY E{(bf16_t*)Y, nullptr, (float*)(ws + WS_SLAB)};
            bool tail = true;
            if (op == OP_FFN_DN) { g.A = G; g.Bt = slot + (size_t)which * (FFN_WGU + FFN_WD) + FFN_WGU; g.lda = g.ldb = g.K = DFF; tail = !(last && which); g.KS = 512; g.nSl = NSLAB; }
            else if (op == OP_MLA_WO) { tail = !last; g.KS = 256; g.nSl = 4; }
            else if (op == OP_FN_OUT) { g.A = (bf16_t*)(SCR + S_P); g.Bt = WM + WM_W2T; g.lda = g.ldb = g.K = 2048; E.bias = p.in(19); g.KS = 512; g.nSl = 4; }
            else { g.Bt = WM + WM_RWO; g.KS = 256; g.nSl = 4; }
            if (tail) g.nTailM = NCTX / 256; else g.nSl = 0;
            gemm_phase(lds, g, E);
        } break;
        case OP_MLA_NORM: phase_mla_norm(p, j, Y, (bf16_t*)(SCR + S_QN), (bf16_t*)(SCR + S_CKVN), (bf16_t*)(SCR + S_K)); break;
        case OP_MLA_UQ: { Gemm g{(bf16_t*)(SCR + S_QN), M + MLA_UQ, 512, 512, 512, NTOK / 256, 6, 0, 0}; EpiUQ E{(bf16_t*)(SCR + S_Q), (const float*)(ws + WS_ROPE), (const float*)(ws + WS_ROPE) + 1024}; gemm_phase(lds, g, E); } break;
        case OP_MLA_UKV: { Gemm g{(bf16_t*)(SCR + S_CKVN), M + MLA_UKV, 256, 256, 256, NTOK / 256, 8, 0, 0}; EpiUKV E{(bf16_t*)(SCR + S_K), (bf16_t*)(SCR + S_V)}; gemm_phase(lds, g, E); } break;
        case OP_MLA_ATTN: phase_attn((bf16_t*)(SCR + S_Q), (bf16_t*)(SCR + S_K), (bf16_t*)(SCR + S_V), XN, !last, (char*)smem); break;
        case OP_FN_DFT: case OP_FN_DFTC: {
            Gemm g{WM + WM_DT2, (bf16_t*)(SCR + S_XT), 2048, 2048, 2048, 128, 4, 16, (size_t)1024 * 2048 * 2}; EpiDFT1 E{(bf16_t*)(SCR + S_P), 4, 2048, 0};
            if (op == OP_FN_DFTC) { g.A = WM + WM_DT2C; g.Bt = (bf16_t*)(SCR + S_XTC); g.lda = g.ldb = g.K = 256; g.nM = 16; g.amod = 2; g.bbatch = (size_t)1024 * 256 * 2; E.shift = 1; E.rpb = 256; E.rowbase = NLAT; }
            gemm_phase(lds, g, E);
        } break;
        case OP_RW_SHIFT: phase_rwkv_shift(XN); break;
        case OP_RW_G1: { Gemm g{XN, WM + WM_WCAT, 2048, 2048, 2048, NTOK / 256, 14, 0, 0}; EpiRwkv1 E{(bf16_t*)(SCR + S_R), (bf16_t*)(SCR + S_A2)}; gemm_phase(lds, g, E); } break;
        case OP_RW_G2W: case OP_RW_G2A: {
            Gemm g{(bf16_t*)(SCR + S_A2), WM + WM_BW, 512, 256, 256, NTOK / 256, 8, 0, 0};
            if (op == OP_RW_G2A) { g.Bt = WM + WM_BA; EpiRwkv2<1> E{(bf16_t*)(SCR + S_AA), p.in(27)}; gemm_phase(lds, g, E); }
            else { EpiRwkv2<0> E{XN, p.in(24)}; gemm_phase(lds, g, E); }
        } break;
        case OP_RW_G2G: { Gemm g{(bf16_t*)(SCR + S_A2) + 256, WM + WM_BG, 512, 256, 256, NTOK / 256, 4, 0, 0}; EpiBf16 E{(bf16_t*)(SCR + S_GG), 1024}; gemm_phase(lds, g, E); } break;
        case OP_RW_SCAN: phase_scan(p, (bf16_t*)(SCR + S_R), (bf16_t*)(SCR + S_KK), (bf16_t*)(SCR + S_VV), (bf16_t*)(SCR + S_AA), XN, Y, (bf16_t*)(ws + WS_SLAB), smem); break;
        case OP_RW_OUT: phase_rwkv_out(p, Y, (const bf16_t*)(ws + WS_SLAB), (bf16_t*)(SCR + S_R), (bf16_t*)(SCR + S_KK), (bf16_t*)(SCR + S_VV), (bf16_t*)(SCR + S_AA), (bf16_t*)(SCR + S_GG), XN); break;
        default: break;
        }
        if (!nosync && PC + 1 < NPROG) { if (PC == 0 && kp.ws == nullptr) grid.sync(); xcd_barrier((unsigned*)(kp.ws + WS_BAR), (volatile LAS unsigned*)(lds + LDS_BYTES - 16)); }
    }
    if constexpr (PC + 1 < NPROG) run_prog<PC + 1>(kp, smem, grid);
}
__global__ void __launch_bounds__(512) fwd_megakernel(Params kp) {
    extern __shared__ __attribute__((aligned(16))) unsigned char smem[];
    cg::grid_group grid = cg::this_grid();
    if (otid() < 4) ((volatile LAS unsigned*)((LAS unsigned char*)smem + LDS_BYTES - 16))[otid()] = 0u;
    __syncthreads();
    xcd_barrier_post((unsigned*)(kp.ws + WS_BAR));
    run_prog<0>(kp, smem, grid);
}

extern "C" void kernel_launch(void* const* d_in, const int* in_sizes, int n_in, void* d_out, int out_size, void* d_ws, size_t ws_size, hipStream_t stream) {
    static int grid = 0;
    if (grid == 0) {
        if (n_in != 38 || ws_size < WS_END) { fprintf(stderr, "kernel_launch: need 38 inputs and %zu bytes of workspace; got %d, %zu\n", (size_t)WS_END, n_in, ws_size); grid = -1; return; }
        int dev = 0, cus = 0, per_cu = 0;
        (void)hipGetDevice(&dev); (void)hipDeviceGetAttribute(&cus, hipDeviceAttributeMultiprocessorCount, dev);
        if (hipFuncSetAttribute((const void*)fwd_megakernel, hipFuncAttributeMaxDynamicSharedMemorySize, LDS_BYTES) != hipSuccess) { fprintf(stderr, "kernel_launch: hipFuncSetAttribute failed\n"); grid = -1; return; }
        if (hipOccupancyMaxActiveBlocksPerMultiprocessor(&per_cu, (const void*)fwd_megakernel, 512, LDS_BYTES) != hipSuccess || per_cu < 1) { fprintf(stderr, "kernel_launch: occupancy query says %d\n", per_cu); per_cu = 1; }
        (void)hipGetLastError();
        grid = cus * 1;
    }
    if (grid < 0) return;
    Params p{};
    for (int i = 0; i < 38; ++i) p.in[i] = (const float*)d_in[i];
    p.out = (float*)d_out; p.ws = (unsigned char*)d_ws;
    if (hipMemsetAsync((char*)d_ws + WS_BAR, 0, 16384, stream) != hipSuccess) { fprintf(stderr, "kernel_launch: memset failed\n"); return; }
    void* args[] = {&p};
    hipError_t e = hipLaunchCooperativeKernel((const void*)fwd_megakernel, dim3(grid), dim3(512), args, LDS_BYTES, stream);
    if (e != hipSuccess) fprintf(stderr, "cooperative launch failed: %s (grid %d)\n", hipGetErrorString(e), grid);
}
```

```cpp
#include <hip/hip_runtime.h>
#include <hip/hip_cooperative_groups.h>
#include <cstdio>
namespace cg = cooperative_groups;

#define LAS __attribute__((address_space(3)))
#define DEVINL __device__ __forceinline__
typedef unsigned short bf16_t;
typedef short bf16x8 __attribute__((ext_vector_type(8)));
typedef short s16x4 __attribute__((ext_vector_type(4)));
typedef float f32x4 __attribute__((ext_vector_type(4)));
typedef float f32x16 __attribute__((ext_vector_type(16)));
typedef unsigned u32x4 __attribute__((ext_vector_type(4)));
typedef unsigned u32x2 __attribute__((ext_vector_type(2)));

constexpr int DM = 1024, NB = 8, SEQ = 2048, CTX = 256, DFF = 2816, NLAT = NB * SEQ, NCTX = NB * CTX, NTOK = NLAT + NCTX, TKV = SEQ + CTX;
constexpr int MODW = 9 * DM;
constexpr float EPS = 1e-6f;

constexpr size_t al256(size_t x) { return (x + 255) / 256 * 256; }
constexpr size_t WS_MOD = 0;
constexpr size_t WS_ROPE = al256(WS_MOD + (size_t)4 * 9 * MODW * 4);
constexpr size_t WS_HC = al256(WS_ROPE + 2 * 64 * 16 * 4);
constexpr size_t WS_XN = al256(WS_HC + (size_t)NCTX * DM * 4);
constexpr size_t WS_Y = al256(WS_XN + (size_t)NTOK * 2048 * 2);
constexpr size_t FFN_WGU = (size_t)2 * DFF * DM;
constexpr size_t FFN_WD = (size_t)DM * DFF;
constexpr size_t FFN_SLOT = 2 * (FFN_WGU + FFN_WD);
constexpr size_t WS_WF = al256(WS_Y + (size_t)NTOK * DM * 4);
constexpr size_t WS_WM = al256(WS_WF + 2 * FFN_SLOT * 2);
constexpr size_t MLA_DQKV = 0, MLA_UQ = MLA_DQKV + 1024 * 1024, MLA_UKV = MLA_UQ + 1536 * 512, MLA_WO = MLA_UKV + 2048 * 256, MLA_SZ = MLA_WO + 1024 * 1024;
constexpr size_t WM_MLA0 = 0, WM_MLA1 = MLA_SZ;
constexpr size_t WM_W2T = 2 * MLA_SZ, WM_DT2 = WM_W2T + 1024 * 2048, WM_DT2C = WM_DT2 + (size_t)4096 * 2048;
constexpr size_t WM_WCAT = WM_DT2C + 512 * 256, WM_BW = WM_WCAT + (size_t)3584 * 2048, WM_BA = WM_BW + 2048 * 256, WM_BG = WM_BA + 2048 * 256, WM_RWO = WM_BG + 1024 * 256;
constexpr size_t WM_END = WM_RWO + 1024 * 1024;
constexpr size_t WS_SCR = al256(WS_WM + WM_END * 2);
constexpr size_t SCR_BYTES = 245366784;
constexpr size_t WS_BAR = WS_SCR + SCR_BYTES;
constexpr int NSLAB = 6;
constexpr size_t WS_SLAB = WS_BAR + 16384;
constexpr size_t WS_END = WS_SLAB + (size_t)NSLAB * NCTX * DM * 4;
constexpr size_t S_G = 0;
constexpr size_t S_QN = 0, S_CKVN = S_QN + (size_t)NTOK * 512 * 2, S_Q = S_CKVN + (size_t)NTOK * 256 * 2, S_K = S_Q + (size_t)64 * TKV * 192 * 2,
                 S_V = S_K + (size_t)64 * TKV * 192 * 2;
constexpr size_t S_XT = 0, S_XTC = S_XT + (size_t)8 * 1024 * 2048 * 2, S_P = al256(S_XTC + (size_t)8 * 1024 * 256 * 2);
constexpr size_t S_R = 0, S_KK = S_R + (size_t)NTOK * DM * 2, S_VV = S_KK + (size_t)NTOK * DM * 2, S_A2 = S_VV + (size_t)NTOK * DM * 2,
                 S_AA = S_A2 + (size_t)NTOK * 512 * 2, S_GG = S_AA + (size_t)2 * NTOK * DM * 2;
static_assert(S_GG + (size_t)NTOK * DM * 2 <= SCR_BYTES, "scratch");
static_assert(S_V + (size_t)64 * TKV * 128 * 2 <= SCR_BYTES, "scratch");
static_assert(S_P + (size_t)NTOK * 2048 * 2 <= SCR_BYTES, "scratch");

constexpr int LDS_BYTES = 135168;

struct Params { const float* in[38]; float* out; unsigned char* ws; };
struct PV { const Params& p; int z; unsigned char* ws; float* out;
    __device__ __forceinline__ const float* in(int k) const { return p.in[k + z]; } };

DEVINL int otid() { int t = threadIdx.x; asm volatile("" : "+v"(t)); return t; }
DEVINL int obid() { int b = blockIdx.x; asm volatile("" : "+s"(b)); return b; }
DEVINL float bf2f(bf16_t b) { return __uint_as_float(((unsigned)b) << 16); }
DEVINL bf16_t f2bf(float f) { unsigned u = __float_as_uint(f); u += 0x7FFFu + ((u >> 16) & 1u); return (bf16_t)(u >> 16); }
typedef float f32x2c __attribute__((ext_vector_type(2)));
typedef __bf16 bf16x2c __attribute__((ext_vector_type(2)));
DEVINL unsigned pk2(float lo, float hi) { const f32x2c v = {lo, hi}; const bf16x2c r = __builtin_convertvector(v, bf16x2c); return __builtin_bit_cast(unsigned, r); }
DEVINL float wave_sum(float v) {
#pragma unroll
    for (int o = 32; o > 0; o >>= 1) v += __shfl_xor(v, o);
    return v; }
#define DPPF(v, ctrl) __builtin_bit_cast(float, __builtin_amdgcn_update_dpp(0, __builtin_bit_cast(int, (v)), (ctrl), 0xF, 0xF, false))
DEVINL float wave_sum_dpp(float v) {
    v += DPPF(v, 0xB1); v += DPPF(v, 0x4E); v += DPPF(v, 0x141); v += DPPF(v, 0x140);
    const int vi_ = __builtin_bit_cast(int, v);
    return __builtin_bit_cast(float, __builtin_amdgcn_readlane(vi_, 0)) + __builtin_bit_cast(float, __builtin_amdgcn_readlane(vi_, 16)) + __builtin_bit_cast(float, __builtin_amdgcn_readlane(vi_, 32)) + __builtin_bit_cast(float, __builtin_amdgcn_readlane(vi_, 48));
}
DEVINL float sum16(float v) {
    v += DPPF(v, 0xB1); v += DPPF(v, 0x4E); v += DPPF(v, 0x141); v += DPPF(v, 0x140);
    return v; }
DEVINL float silu_f(float x) { return x * __builtin_amdgcn_rcpf(1.f + __expf(-x)); }
DEVINL float sigm_f(float x) { return __builtin_amdgcn_rcpf(1.f + __expf(-x)); }
DEVINL float lo_bf(unsigned w) { return __uint_as_float(w << 16); }
DEVINL float hi_bf(unsigned w) { return __uint_as_float(w & 0xFFFF0000u); }

constexpr int BM = 256, BK = 64, HALF = 128, HTB = HALF * BK * 2, NXCD = 8, WGM = 8;
DEVINL int lds_byte(int r, int c) { const int st = (r >> 4) * 2 + (c >> 5), rr = r & 15, cc = c & 31, ob = rr * 64 + cc * 2; return st * 1024 + (ob ^ (((ob >> 9) & 1) << 5)); }
DEVINL void stage_rc(int b, int& R, int& C) { const int st = b / 1024, sb = b % 1024, swz = sb ^ (((sb >> 9) & 1) << 5); R = (st >> 1) * 16 + swz / 64; C = (st & 1) * 32 + (swz % 64) / 2; }
DEVINL int perm32(int rho) { const int n = rho >> 4, i = rho & 15; return 8 * (i >> 2) + 4 * n + (i & 3); }
struct Unit { int pm, pn, ks; };
struct Gemm { const bf16_t* A; const bf16_t* Bt; int lda, ldb, K, nM, nN, amod; size_t bbatch; int nTailM, nSl, KS; };
struct Sched {
    int nM, nN, nwg, G, c, ntail, nSl;
    DEVINL void init(int nM_, int nN_, int nTailM, int nSl_) { nM = nM_; nN = nN_; nwg = nM * nN; G = gridDim.x; c = obid(); nSl = nSl_; ntail = nTailM * nN_ * nSl_; }
    DEVINL bool next(int i, Unit& u) const {
        const long L = (long)i * G + c; if (L >= nwg + ntail) return false;
        if (L >= nwg) { const int t = (int)L - nwg, rest = t / nSl; u.ks = t % nSl; u.pn = rest % nN; u.pm = nM + rest / nN; return true; }
        u.ks = -1;
        int wgid = (int)L; { const int q = nwg / NXCD, r = nwg % NXCD, xcd = wgid % NXCD, off = wgid / NXCD; wgid = (xcd < r ? xcd * (q + 1) : r * (q + 1) + (xcd - r) * q) + off; }
        const int nig = WGM * nN, gid = wgid / nig, fm = gid * WGM, gsz = (nM - fm) < WGM ? (nM - fm) : WGM;
        u.pm = fm + ((wgid % nig) % gsz); u.pn = (wgid % nig) / gsz; return true;
    }
};
typedef f32x4 Acc[2][2][4][2];

template <class Epi>
DEVINL void gemm_phase(LAS unsigned char* lds, const Gemm g, const Epi& E) {
    const int tid = otid(), wid = __builtin_amdgcn_readfirstlane(tid >> 6), lane = tid & 63, wr = wid >> 2, wc = wid & 3, fr = lane & 15, fq = lane >> 4;
    Sched S; S.init(g.nM, g.nN, g.nTailM, g.nSl);
    const int K = g.K;
    unsigned voffA[2], voffB[2];
#pragma unroll
    for (int i = 0; i < 2; ++i) { int R, C; stage_rc(tid * 16 + i * 8192, R, C);
        const int Rb = Epi::PERM ? ((R & ~31) + perm32(R & 31)) : R;
        voffA[i] = (unsigned)(R * g.lda + C) * 2u; voffB[i] = (unsigned)(Rb * g.ldb + C) * 2u; }
    const size_t kstep = (size_t)(BK * 2);
    const size_t hstepA = (size_t)HALF * g.lda * 2, hstepB = (size_t)HALF * g.ldb * 2;
    const size_t tstepA = 2 * hstepA, tstepB = 2 * hstepB;
    const unsigned ldsw = (unsigned)wid * 1024u;
    const int aoff = lds_byte(wr * 64 + fr, fq * 8), boff = lds_byte(wc * 32 + fr, fq * 8);
#define PG8_SA(b, h) (((b) * 2 + (h)) * HTB)
#define PG8_SB(b, h) ((4 + (b) * 2 + (h)) * HTB)
#define PG8_STAGE(bufoff, gbase, voff) do { _Pragma("unroll") for (int _i = 0; _i < 2; ++_i) \
        __builtin_amdgcn_global_load_lds((const unsigned*)((const char*)(gbase) + (voff)[_i]), (LAS unsigned*)(lds + (bufoff) + ldsw + _i * 8192), 16, 0, 0); } while (0)
#define PG8_LDA(dst, b, h) do { _Pragma("unroll") for (int m = 0; m < 4; ++m) _Pragma("unroll") for (int k = 0; k < 2; ++k) dst[m][k] = *(const LAS bf16x8*)(lds + PG8_SA(b, h) + aoff + m * 2048 + k * 1024); } while (0)
#define PG8_LDB(dst, b, h) do { _Pragma("unroll") for (int n = 0; n < 2; ++n) _Pragma("unroll") for (int k = 0; k < 2; ++k) dst[n][k] = *(const LAS bf16x8*)(lds + PG8_SB(b, h) + boff + n * 2048 + k * 1024); } while (0)
#define PG8_MMA(ai, bj, At, Bt) do { __builtin_amdgcn_s_setprio(1); _Pragma("unroll") for (int m = 0; m < 4; ++m) _Pragma("unroll") for (int n = 0; n < 2; ++n) _Pragma("unroll") for (int k = 0; k < 2; ++k) \
        acc[ai][bj][m][n] = __builtin_amdgcn_mfma_f32_16x16x32_bf16(Bt[n][k], At[m][k], acc[ai][bj][m][n], 0, 0, 0); __builtin_amdgcn_s_setprio(0); } while (0)
#define PG8_WAIT_V(n) asm volatile("s_waitcnt vmcnt(" #n ")" ::: "memory")
#define PG8_WAIT_L(n) asm volatile("s_waitcnt lgkmcnt(" #n ")" ::: "memory")
#define PG8_BAR __builtin_amdgcn_s_barrier()
#define PG8_SCHED __builtin_amdgcn_sched_barrier(0)
    Unit cur, nxt; int ui = 0;
    if (!S.next(0, cur)) return;
    Acc acc;
#pragma unroll
    for (int a = 0; a < 2; ++a)
#pragma unroll
        for (int b = 0; b < 2; ++b)
#pragma unroll
            for (int m = 0; m < 4; ++m)
#pragma unroll
                for (int n = 0; n < 2; ++n) acc[a][b][m][n] = (f32x4){0.f, 0.f, 0.f, 0.f};
    bf16x8 At[4][2], B0[2][2], B1[2][2];
#define PG8_KOFF(u) ((u).ks > 0 ? (size_t)(u).ks * g.KS * 2 : (size_t)0)
#define PG8_NT(u) ((u).ks < 0 ? K / BK : ((K - (u).ks * g.KS) < g.KS ? (K - (u).ks * g.KS) : g.KS) / BK)
#define PG8_APTR(u) ((const char*)g.A + (size_t)(g.amod ? (u).pm % g.amod : (u).pm) * tstepA + PG8_KOFF(u))
#define PG8_BPTR(u) ((const char*)g.Bt + (size_t)(u).pn * tstepB + (g.amod ? (size_t)((u).pm / g.amod) * g.bbatch : (size_t)0) + PG8_KOFF(u))
    const char* cA = PG8_APTR(cur); const char* cB = PG8_BPTR(cur); int nt = PG8_NT(cur);
    PG8_STAGE(PG8_SB(0, 0), cB, voffB); PG8_STAGE(PG8_SA(0, 0), cA, voffA); PG8_STAGE(PG8_SB(0, 1), cB + hstepB, voffB); PG8_STAGE(PG8_SA(0, 1), cA + hstepA, voffA);
    if (wr == 1) PG8_BAR;
    PG8_WAIT_V(4); PG8_BAR;
    PG8_STAGE(PG8_SB(1, 0), cB + kstep, voffB); PG8_STAGE(PG8_SA(1, 0), cA + kstep, voffA); PG8_STAGE(PG8_SB(1, 1), cB + hstepB + kstep, voffB);
    PG8_WAIT_V(6); PG8_BAR;
    for (;;) {
        const bool has_next = S.next(ui + 1, nxt);
        const char* nA = has_next ? PG8_APTR(nxt) : cA; const char* nB = has_next ? PG8_BPTR(nxt) : cB;
        for (int t = 0; t < nt; t += 2) {
            const bool last = (t == nt - 2);
            const char* a1 = cA + (size_t)(t + 1) * kstep;
            const char* a2 = last ? nA : cA + (size_t)(t + 2) * kstep; const char* b2 = last ? nB : cB + (size_t)(t + 2) * kstep;
            const char* a3 = a2 + kstep; const char* b3 = b2 + kstep;
            PG8_LDB(B0, 0, 0); PG8_SCHED; PG8_LDA(At, 0, 0); PG8_STAGE(PG8_SA(1, 1), a1 + hstepA, voffA);
            PG8_WAIT_L(8); PG8_BAR; PG8_WAIT_L(0); PG8_MMA(0, 0, At, B0); PG8_BAR; PG8_SCHED;
            PG8_LDB(B1, 0, 1); PG8_STAGE(PG8_SB(0, 0), b2, voffB);
            PG8_BAR; PG8_WAIT_L(0); PG8_MMA(0, 1, At, B1); PG8_BAR;
            PG8_LDA(At, 0, 1); PG8_STAGE(PG8_SA(0, 0), a2, voffA);
            PG8_BAR; PG8_WAIT_L(0); PG8_MMA(1, 0, At, B0); PG8_BAR; PG8_SCHED;
            PG8_STAGE(PG8_SB(0, 1), b2 + hstepB, voffB);
            PG8_WAIT_V(6); PG8_BAR; PG8_MMA(1, 1, At, B1); PG8_BAR;
            PG8_LDB(B0, 1, 0); PG8_SCHED; PG8_LDA(At, 1, 0); PG8_STAGE(PG8_SA(0, 1), a2 + hstepA, voffA);
            PG8_WAIT_L(8); PG8_BAR; PG8_WAIT_L(0); PG8_MMA(0, 0, At, B0); PG8_BAR; PG8_SCHED;
            PG8_LDB(B1, 1, 1); PG8_STAGE(PG8_SB(1, 0), b3, voffB);
            PG8_BAR; PG8_WAIT_L(0); PG8_MMA(0, 1, At, B1); PG8_BAR;
            PG8_LDA(At, 1, 1); PG8_STAGE(PG8_SA(1, 0), a3, voffA);
            PG8_BAR; PG8_WAIT_L(0); PG8_MMA(1, 0, At, B0); PG8_BAR; PG8_SCHED;
            PG8_STAGE(PG8_SB(1, 1), b3 + hstepB, voffB);
            PG8_WAIT_V(6); PG8_BAR; PG8_MMA(1, 1, At, B1); PG8_BAR;
        }
        E(acc, cur, wr, wc, fr, fq);
        if (!has_next) break;
#pragma unroll
        for (int a = 0; a < 2; ++a)
#pragma unroll
            for (int b = 0; b < 2; ++b)
#pragma unroll
                for (int m = 0; m < 4; ++m)
#pragma unroll
                    for (int n = 0; n < 2; ++n) acc[a][b][m][n] = (f32x4){0.f, 0.f, 0.f, 0.f};
        cur = nxt; cA = nA; cB = nB; ++ui; nt = PG8_NT(cur);
    }
    PG8_WAIT_V(0);
    if (wr == 0) PG8_BAR;
    PG8_BAR;
#undef PG8_SA
#undef PG8_SB
#undef PG8_STAGE
#undef PG8_LDA
#undef PG8_LDB
#undef PG8_MMA
#undef PG8_BAR
#undef PG8_SCHED
#undef PG8_APTR
#undef PG8_KOFF
#undef PG8_NT
#undef PG8_BPTR
}
#define WAIT_V0() asm volatile("s_waitcnt vmcnt(0)" ::: "memory")

#define EPI_LOOP_ROWS for (int ai = 0; ai < 2; ++ai) for (int m = 0; m < 4; ++m)
DEVINL void st_bf4(bf16_t* p, f32x4 v) { u32x2 w; w.x = pk2(v[0], v[1]); w.y = pk2(v[2], v[3]); *(u32x2*)p = w; }

DEVINL void st_bf8(bf16_t* p, f32x4 a, f32x4 b) { u32x4 w; w.x = pk2(a[0], a[1]); w.y = pk2(a[2], a[3]); w.z = pk2(b[0], b[1]); w.w = pk2(b[2], b[3]); *(u32x4*)p = w; }
struct EpiF32 { static constexpr bool PERM = false;
    float* C; int ldc; const float* bias; float* Cs;
    DEVINL void operator()(const Acc& acc, const Unit& u, int wr, int wc, int fr, int fq) const {
        const int row0 = u.pm * BM + wr * 64 + fr, col0 = u.pn * BM + wc * 32 + 4 * fq;
        float* base = u.ks < 0 ? C : Cs + ((long)u.ks * NCTX - NLAT) * 1024;
#pragma unroll
        for (int ai = 0; ai < 2; ++ai)
#pragma unroll
            for (int m = 0; m < 4; ++m) { float* rowp = base + (size_t)(row0 + ai * HALF + m * 16) * ldc + col0;
#pragma unroll
                for (int bj = 0; bj < 2; ++bj)
#pragma unroll
                    for (int n = 0; n < 2; ++n) { f32x4 v = acc[ai][bj][m][n];
                        if (bias) v += *(const f32x4*)(bias + col0 + bj * HALF + n * 16);
                        *(f32x4*)(rowp + bj * HALF + n * 16) = v; } }
    }
};
struct EpiY { static constexpr bool PERM = true;
    bf16_t* Yb; const float* bias; float* Cs;
    DEVINL void operator()(const Acc& acc, const Unit& u, int wr, int wc, int fr, int fq) const {
        const int row0 = u.pm * BM + wr * 64 + fr, col0 = u.pn * BM + wc * 32 + 8 * fq;
        const bool addb = bias != nullptr && u.ks <= 0;
        float* sbase = Cs + ((long)u.ks * NCTX - NLAT) * 1024;
#pragma unroll
        for (int ai = 0; ai < 2; ++ai)
#pragma unroll
            for (int m = 0; m < 4; ++m) { const size_t ro = (size_t)(row0 + ai * HALF + m * 16) * 1024 + col0;
#pragma unroll
                for (int bj = 0; bj < 2; ++bj) { f32x4 v0 = acc[ai][bj][m][0], v1 = acc[ai][bj][m][1];
                    if (addb) { v0 += *(const f32x4*)(bias + col0 + bj * HALF); v1 += *(const f32x4*)(bias + col0 + bj * HALF + 4); }
                    if (u.ks < 0) st_bf8(Yb + ro + bj * HALF, v0, v1); else { *(f32x4*)(sbase + ro + bj * HALF) = v0; *(f32x4*)(sbase + ro + bj * HALF + 4) = v1; } } }
    }
};
struct EpiBf16 { static constexpr bool PERM = true;
    bf16_t* O; int ldc;
    DEVINL void operator()(const Acc& acc, const Unit& u, int wr, int wc, int fr, int fq) const {
        const int row0 = u.pm * BM + wr * 64 + fr, col0 = u.pn * BM + wc * 32 + 8 * fq;
#pragma unroll
        for (int ai = 0; ai < 2; ++ai)
#pragma unroll
            for (int m = 0; m < 4; ++m) { bf16_t* rowp = O + (size_t)(row0 + ai * HALF + m * 16) * ldc + col0;
#pragma unroll
                for (int bj = 0; bj < 2; ++bj) st_bf8(rowp + bj * HALF, acc[ai][bj][m][0], acc[ai][bj][m][1]); }
    }
};
struct EpiSwiGLU { static constexpr bool PERM = true;
    bf16_t* G;
    DEVINL void operator()(const Acc& acc, const Unit& u, int wr, int wc, int fr, int fq) const {
        const int row0 = u.pm * BM + wr * 64 + fr, col0 = u.pn * HALF + wc * 32 + 8 * fq;
#pragma unroll
        for (int ai = 0; ai < 2; ++ai)
#pragma unroll
            for (int m = 0; m < 4; ++m) { bf16_t* rowp = G + (size_t)(row0 + ai * HALF + m * 16) * DFF + col0;
                f32x4 o[2];
#pragma unroll
                for (int n = 0; n < 2; ++n) { const f32x4 gt = acc[ai][0][m][n], up = acc[ai][1][m][n];
#pragma unroll
                    for (int j = 0; j < 4; ++j) o[n][j] = silu_f(gt[j]) * up[j]; }
                st_bf8(rowp, o[0], o[1]); }
    }
};
DEVINL void tok_of_row(int r, int& b, int& tk, bool& lat) { lat = r < NLAT; if (lat) { b = r >> 11; tk = r & 2047; } else { const int rc = r - NLAT; b = rc >> 8; tk = SEQ + (rc & 255); } }
struct EpiUQ { static constexpr bool PERM = false;
    bf16_t* Q; const float* cosT; const float* sinT;
    DEVINL void operator()(const Acc& acc, const Unit& u, int wr, int wc, int fr, int fq) const {
#pragma unroll
        for (int ai = 0; ai < 2; ++ai)
#pragma unroll
            for (int m = 0; m < 4; ++m) { const int r = u.pm * BM + ai * HALF + wr * 64 + m * 16 + fr; int b, tq; bool lat; tok_of_row(r, b, tq, lat);
#pragma unroll
                for (int bj = 0; bj < 2; ++bj) { const int col32 = u.pn * BM + bj * HALF + wc * 32, head = col32 / 192, off = col32 % 192;
                    f32x4 v0 = acc[ai][bj][m][0], v1 = acc[ai][bj][m][1];
                    if (off >= 128 && lat) { const int axis = (off - 128) >> 5, pos = axis == 0 ? (tq >> 6) : (tq & 63);
                        const f32x4 c = *(const f32x4*)(cosT + pos * 16 + fq * 4), s = *(const f32x4*)(sinT + pos * 16 + fq * 4);
                        const f32x4 o0 = v0 * c - v1 * s, o1 = v1 * c + v0 * s; v0 = o0; v1 = o1; }
                    bf16_t* dst = Q + ((size_t)(b * 8 + head) * TKV + tq) * 192 + off + fq * 4;
                    st_bf4(dst, v0); st_bf4(dst + 16, v1); } }
    }
};
struct EpiUKV { static constexpr bool PERM = true;
    bf16_t* Kb; bf16_t* Vb;
    DEVINL void operator()(const Acc& acc, const Unit& u, int wr, int wc, int fr, int fq) const {
#pragma unroll
        for (int ai = 0; ai < 2; ++ai)
#pragma unroll
            for (int m = 0; m < 4; ++m) { const int r = u.pm * BM + ai * HALF + wr * 64 + m * 16 + fr; int b, tk; bool lat; tok_of_row(r, b, tk, lat);
                const size_t tokidx = (size_t)(b * 8 + u.pn) * TKV + tk; const int c = wc * 32 + fq * 8;
                st_bf8(Kb + tokidx * 192 + c, acc[ai][0][m][0], acc[ai][0][m][1]); st_bf8(Vb + tokidx * 128 + c, acc[ai][1][m][0], acc[ai][1][m][1]); }
    }
};
struct EpiDFT1 { static constexpr bool PERM = true;
    bf16_t* P; int shift, rpb, rowbase;
    DEVINL void operator()(const Acc& acc, const Unit& u, int wr, int wc, int fr, int fq) const {
        const int b = u.pm >> shift, tile = u.pm & ((1 << shift) - 1), cs = tile >> (shift - 1), t0 = (tile & ((1 << (shift - 1)) - 1)) * 256;
        const int row0 = rowbase + b * rpb + t0 + wr * 64 + fr, col0 = cs * 1024 + u.pn * BM + wc * 32 + 8 * fq;
#pragma unroll
        for (int ai = 0; ai < 2; ++ai)
#pragma unroll
            for (int m = 0; m < 4; ++m) { bf16_t* rowp = P + (size_t)(row0 + ai * HALF + m * 16) * 2048 + col0;
#pragma unroll
                for (int bj = 0; bj < 2; ++bj) st_bf8(rowp + bj * HALF, acc[ai][bj][m][0], acc[ai][bj][m][1]); }
    }
};
struct EpiRwkv1 { static constexpr bool PERM = true;
    bf16_t* R; bf16_t* A2;
    DEVINL void operator()(const Acc& acc, const Unit& u, int wr, int wc, int fr, int fq) const {
        const int row0 = u.pm * BM + wr * 64 + fr;
#pragma unroll
        for (int ai = 0; ai < 2; ++ai)
#pragma unroll
            for (int m = 0; m < 4; ++m) { const size_t r = (size_t)(row0 + ai * HALF + m * 16);
#pragma unroll
                for (int bj = 0; bj < 2; ++bj) { f32x4 v0 = acc[ai][bj][m][0], v1 = acc[ai][bj][m][1]; const int c = bj * HALF + wc * 32 + fq * 8;
                    if (u.pn < 12) { st_bf8(R + (size_t)(u.pn >> 2) * NTOK * DM + r * DM + (u.pn & 3) * 256 + c, v0, v1); }
                    else if (u.pn == 12) { if (bj == 0) {
#pragma unroll
                            for (int j = 0; j < 4; ++j) { const float e0 = __expf(-2.f * fabsf(v0[j])), t0 = (1.f - e0) / (1.f + e0); v0[j] = v0[j] < 0.f ? -t0 : t0;
                                const float e1 = __expf(-2.f * fabsf(v1[j])), t1 = (1.f - e1) / (1.f + e1); v1[j] = v1[j] < 0.f ? -t1 : t1; } }
                        st_bf8(A2 + r * 512 + c, v0, v1); }
                    else {
#pragma unroll
                        for (int j = 0; j < 4; ++j) { v0[j] = (c + j < 160) ? sigm_f(v0[j]) : 0.f; v1[j] = (c + 4 + j < 160) ? sigm_f(v1[j]) : 0.f; }
                        st_bf8(A2 + r * 512 + 256 + c, v0, v1); } } }
    }
};
template <int mode> struct EpiRwkv2 { static constexpr bool PERM = true;
    bf16_t* O; const float* bias;
    DEVINL void operator()(const Acc& acc, const Unit& u, int wr, int wc, int fr, int fq) const {
        const int row0 = u.pm * BM + wr * 64 + fr, e = u.pn >> 2, d0 = (u.pn & 3) * 256 + wc * 32 + 8 * fq;
#pragma unroll
        for (int ai = 0; ai < 2; ++ai)
#pragma unroll
            for (int m = 0; m < 4; ++m) { bf16_t* rowp = O + (size_t)e * NTOK * DM + (size_t)(row0 + ai * HALF + m * 16) * DM + d0;
#pragma unroll
                for (int bj = 0; bj < 2; ++bj) { const int d = d0 + bj * HALF;
                    st_bf8(rowp + bj * HALF, acc[ai][bj][m][0] + *(const f32x4*)(bias + e * DM + d), acc[ai][bj][m][1] + *(const f32x4*)(bias + e * DM + d + 4)); } }
    }
};

DEVINL void convT(float* tile, const float* src, int ldsrc, int K, int N, bf16_t* dst, int ldd, int drow0, int dcol0, const float* rs, int rdiv, int rmul, int bid = -1, int nb = 0) {
    const int tid = otid(), tK = (K + 63) / 64, tN = (N + 63) / 64;
    if (bid < 0) { bid = obid(); nb = gridDim.x; }
    for (int t = bid; t < tK * tN; t += nb) {
        const int k0 = (t / tN) * 64, n0 = (t % tN) * 64;
        __syncthreads();
#pragma unroll
        for (int p = 0; p < 8; ++p) { const int i = (tid >> 6) + 8 * p, j = tid & 63; float v = 0.f;
            if (k0 + i < K && n0 + j < N) { v = src[(size_t)(k0 + i) * ldsrc + n0 + j]; if (rs) v *= rs[k0 + i]; }
            tile[i * 65 + j] = v; }
        __syncthreads();
#pragma unroll
        for (int p = 0; p < 4; ++p) { const int j = (tid >> 5) + 16 * p, i = (tid & 31) * 2, n = n0 + j;
            if (n < N && k0 + i < K) { const int row = (n / rdiv) * rmul + (n % rdiv) + drow0;
                *(unsigned*)(dst + (size_t)row * ldd + dcol0 + k0 + i) = pk2(tile[i * 65 + j], tile[(i + 1) * 65 + j]); } }
    }
}
DEVINL void zero2d(bf16_t* dst, int ld, int r0, int r1, int c0, int c1, int bid = -1, int nb = 0) {
    const int w = (c1 - c0) / 2, n = (r1 - r0) * w;
    if (bid < 0) { bid = obid(); nb = gridDim.x; }
    for (int i = bid * 512 + otid(); i < n; i += nb * 512) { const int r = r0 + i / w, c = c0 + (i % w) * 2; *(unsigned*)(dst + (size_t)r * ld + c) = 0u; }
}
DEVINL void conv_ffn_w(float* tile, const PV& p, int layer, int w, bf16_t* slot, int bid, int nb) {
    const size_t o = (size_t)(layer * 2 + w) * DM * DFF;
    bf16_t* gu = slot + w * (FFN_WGU + FFN_WD); bf16_t* wd = gu + FFN_WGU;
    convT(tile, p.in(8) + o, DFF, DM, DFF, gu, DM, 0, 0, nullptr, 128, 256, bid, nb);
    convT(tile, p.in(9) + o, DFF, DM, DFF, gu, DM, 128, 0, nullptr, 128, 256, bid, nb);
    convT(tile, p.in(10) + o, DM, DFF, DM, wd, DFF, 0, 0, nullptr, 1 << 30, 0, bid, nb);
}
DEVINL void conv_ffn(float* tile, const PV& p, int layer, bf16_t* slot) { conv_ffn_w(tile, p, layer, 0, slot, obid(), gridDim.x); conv_ffn_w(tile, p, layer, 1, slot, obid(), gridDim.x); }

DEVINL void phase_prep(const PV& p, unsigned char* sm) {
    const int tid = otid(), wid = tid >> 6, lane = tid & 63;
    unsigned char* ws = p.ws;
    float* tile = (float*)sm;
    bf16_t* WM = (bf16_t*)(ws + WS_WM);
    {
        float* sc = (float*)sm; float* part = sc + 9 * 1024;
        for (int i = tid; i < 9 * 1024; i += 512) { const float v = i < 8192 ? p.in(1)[i] : p.in(3)[i - 8192]; sc[i] = silu_f(v); }
        __syncthreads();
        float* MOD = (float*)(ws + WS_MOD);
        for (int it = obid(); it < 4 * 144; it += gridDim.x) {
            const int layer = it / 144, col = (it % 144) * 64 + lane;
            const float* W = p.in(4) + (size_t)layer * DM * MODW + col;
            float a[9];
#pragma unroll
            for (int r = 0; r < 9; ++r) a[r] = 0.f;
            const int kb = wid * 128;
#pragma unroll 16
            for (int k = 0; k < 128; ++k) { const float w = W[(size_t)(kb + k) * MODW];
#pragma unroll
                for (int r = 0; r < 9; ++r) a[r] += sc[r * 1024 + kb + k] * w; }
#pragma unroll
            for (int r = 0; r < 9; ++r) part[(wid * 9 + r) * 64 + lane] = a[r];
            __syncthreads();
            for (int o = tid; o < 9 * 64; o += 512) { const int r = o >> 6, l = o & 63; float s = 0.f;
#pragma unroll
                for (int w = 0; w < 8; ++w) s += part[(w * 9 + r) * 64 + l];
                const int c = (it % 144) * 64 + l;
                MOD[((size_t)layer * 9 + r) * MODW + c] = s + p.in(5)[(size_t)layer * MODW + c]; }
            __syncthreads();
        }
    }
    { float* ct = (float*)(ws + WS_ROPE); float* st = ct + 1024;
      for (int i = obid() * 512 + tid; i < 1024; i += gridDim.x * 512) { const int pos = i >> 4, pp = i & 15;
          const float inv = exp2f(-(float)pp * (13.287712379549449f / 16.f)); const float ang = (float)pos * inv; ct[i] = cosf(ang); st[i] = sinf(ang); } }
    conv_ffn(tile, p, 0, (bf16_t*)(ws + WS_WF));
    for (int j = 0; j < 1; ++j) {
        bf16_t* M = WM + (j ? WM_MLA1 : WM_MLA0);
        convT(tile, p.in(11) + (size_t)j * 1024 * 512, 512, 1024, 512, M + MLA_DQKV, 1024, 0, 0, nullptr, 1 << 30, 0);
        convT(tile, p.in(14) + (size_t)j * 1024 * 320, 320, 1024, 320, M + MLA_DQKV, 1024, 512, 0, nullptr, 1 << 30, 0);
        zero2d(M + MLA_DQKV, 1024, 832, 1024, 0, 1024);
        convT(tile, p.in(13) + (size_t)j * 512 * 1536, 1536, 512, 1536, M + MLA_UQ, 512, 0, 0, nullptr, 1 << 30, 0);
        convT(tile, p.in(16) + (size_t)j * 256 * 2048, 2048, 256, 2048, M + MLA_UKV, 256, 0, 0, nullptr, 1 << 30, 0);
        convT(tile, p.in(17) + (size_t)j * 1024 * 1024, 1024, 1024, 1024, M + MLA_WO, 1024, 0, 0, nullptr, 1 << 30, 0);
    }
    __syncthreads();
}

DEVINL void prep_late(const PV& p, unsigned char* sm, int bid, int nb) {
    const int tid = otid(), wid = tid >> 6, lane = tid & 63;
    unsigned char* ws = p.ws;
    float* tile = (float*)sm;
    bf16_t* WM = (bf16_t*)(ws + WS_WM);
    (void)wid; (void)lane;
    { bf16_t* DT = WM + WM_DT2;
      for (size_t i = (size_t)bid * 512 + tid; i < (size_t)4096 * 1024; i += (size_t)nb * 512) {
          const int row = (int)(i >> 10), t = (int)(i & 1023) * 2, cs = row >> 11, to = row & 2047;
          float v[2];
#pragma unroll
          for (int q = 0; q < 2; ++q) { const int mm = (to * (t + q)) & 2047; const float x = (float)mm * (1.f / 1024.f); v[q] = (cs ? sinpif(x) : cospif(x)) * 0.022097086912079608f; }
          *(unsigned*)(DT + (size_t)row * 2048 + t) = pk2(v[0], v[1]); }
      bf16_t* DC = WM + WM_DT2C;
      for (int i = bid * 512 + tid; i < 512 * 128; i += nb * 512) {
          const int row = i >> 7, t = (i & 127) * 2, cs = row >> 8, to = row & 255;
          float v[2];
#pragma unroll
          for (int q = 0; q < 2; ++q) { const int mm = (to * (t + q)) & 255; const float x = (float)mm * (1.f / 128.f); v[q] = (cs ? sinpif(x) : cospif(x)) * 0.0625f; }
          *(unsigned*)(DC + (size_t)row * 256 + t) = pk2(v[0], v[1]); } }
    {
        __syncthreads();
        float* ctab = (float*)sm; float* stab = ctab + 128; float* wt = ctab + 256;
        if (tid < 128) { const float x = (float)tid * (1.f / 64.f); ctab[tid] = cospif(x) * 0.08838834764831845f; stab[tid] = -sinpif(x) * 0.08838834764831845f; }
        bf16_t* W2 = WM + WM_W2T; const float* wo = p.in(18);
        for (int it = bid; it < 128; it += nb) {
            const int g = it >> 4, n0 = (it & 15) * 64;
            __syncthreads();
            for (int q = tid; q < 128 * 64; q += 512) wt[q] = wo[(size_t)(g * 128 + (q >> 6)) * DM + n0 + (q & 63)];
            __syncthreads();
            const int k = tid & 127, cs = (tid >> 7) & 1, ng = tid >> 8; const float* tab = cs ? stab : ctab;
            float acc[32];
#pragma unroll
            for (int q = 0; q < 32; ++q) acc[q] = 0.f;
            for (int j = 0; j < 128; ++j) { const float t = tab[(k * j) & 127]; const float* wr = wt + j * 64 + ng * 32;
#pragma unroll
                for (int q = 0; q < 32; q += 4) { const f32x4 w4 = *(const f32x4*)(wr + q); acc[q] += t * w4[0]; acc[q + 1] += t * w4[1]; acc[q + 2] += t * w4[2]; acc[q + 3] += t * w4[3]; } }
#pragma unroll
            for (int q = 0; q < 32; ++q) W2[(size_t)(n0 + ng * 32 + q) * 2048 + cs * 1024 + g * 128 + k] = f2bf(acc[q]);
        }
        __syncthreads();
    }
    for (int j = 1; j < 2; ++j) {
        bf16_t* M = WM + (j ? WM_MLA1 : WM_MLA0);
        convT(tile, p.in(11) + (size_t)j * 1024 * 512, 512, 1024, 512, M + MLA_DQKV, 1024, 0, 0, nullptr, 1 << 30, 0, bid, nb);
        convT(tile, p.in(14) + (size_t)j * 1024 * 320, 320, 1024, 320, M + MLA_DQKV, 1024, 512, 0, nullptr, 1 << 30, 0, bid, nb);
        zero2d(M + MLA_DQKV, 1024, 832, 1024, 0, 1024, bid, nb);
        convT(tile, p.in(13) + (size_t)j * 512 * 1536, 1536, 512, 1536, M + MLA_UQ, 512, 0, 0, nullptr, 1 << 30, 0, bid, nb);
        convT(tile, p.in(16) + (size_t)j * 256 * 2048, 2048, 256, 2048, M + MLA_UKV, 256, 0, 0, nullptr, 1 << 30, 0, bid, nb);
        convT(tile, p.in(17) + (size_t)j * 1024 * 1024, 1024, 1024, 1024, M + MLA_WO, 1024, 0, 0, nullptr, 1 << 30, 0, bid, nb);
    }
    {
        bf16_t* WC = WM + WM_WCAT; const float* mix = p.in(20);
        for (int h = 0; h < 2; ++h) { const int dc = h * 1024;
            convT(tile, p.in(21), 1024, 1024, 1024, WC, 2048, 0, dc, h ? mix + 0 * 1024 : nullptr, 1 << 30, 0, bid, nb);
            convT(tile, p.in(22), 1024, 1024, 1024, WC, 2048, 1024, dc, h ? mix + 2 * 1024 : nullptr, 1 << 30, 0, bid, nb);
            convT(tile, p.in(23), 1024, 1024, 1024, WC, 2048, 2048, dc, h ? mix + 3 * 1024 : nullptr, 1 << 30, 0, bid, nb);
            for (int e = 0; e < 2; ++e) {
                convT(tile, p.in(25) + (size_t)e * 1024 * 64, 64, 1024, 64, WC, 2048, 3072 + e * 64, dc, h ? mix + 1 * 1024 : nullptr, 1 << 30, 0, bid, nb);
                convT(tile, p.in(28) + (size_t)e * 1024 * 64, 64, 1024, 64, WC, 2048, 3200 + e * 64, dc, h ? mix + 4 * 1024 : nullptr, 1 << 30, 0, bid, nb); }
            convT(tile, p.in(30), 160, 1024, 160, WC, 2048, 3328, dc, h ? mix + 5 * 1024 : nullptr, 1 << 30, 0, bid, nb); }
        zero2d(WC, 2048, 3488, 3584, 0, 2048, bid, nb);
        bf16_t* BW = WM + WM_BW; bf16_t* BA = WM + WM_BA; bf16_t* BG = WM + WM_BG;
        for (int e = 0; e < 2; ++e) {
            convT(tile, p.in(26) + (size_t)e * 64 * 1024, 1024, 64, 1024, BW, 256, e * 1024, e * 64, nullptr, 1 << 30, 0, bid, nb);
            convT(tile, p.in(29) + (size_t)e * 64 * 1024, 1024, 64, 1024, BA, 256, e * 1024, 128 + e * 64, nullptr, 1 << 30, 0, bid, nb);
            zero2d(BW, 256, e * 1024, e * 1024 + 1024, (1 - e) * 64, (1 - e) * 64 + 64, bid, nb); zero2d(BW, 256, e * 1024, e * 1024 + 1024, 128, 256, bid, nb);
            zero2d(BA, 256, e * 1024, e * 1024 + 1024, 128 + (1 - e) * 64, 128 + (1 - e) * 64 + 64, bid, nb); zero2d(BA, 256, e * 1024, e * 1024 + 1024, 0, 128, bid, nb); }
        convT(tile, p.in(31), 1024, 160, 1024, BG, 256, 0, 0, nullptr, 1 << 30, 0, bid, nb);
        zero2d(BG, 256, 0, 1024, 160, 256, bid, nb);
        convT(tile, p.in(37), 1024, 1024, 1024, WM + WM_RWO, 1024, 0, 0, nullptr, 1 << 30, 0, bid, nb);
    }
    __syncthreads();
}

struct RowArgs {
    const float* hin_l; const float* hin_c; float* hout_l; float* hout_c;
    const float* Y; const float* modp; int subp; const float* gpost; float coef;
    const float* modn; int subn; const float* gpre;
    bf16_t* xn; int xn_ld; int nrows; int upd_ctx; const float* Ys; int nslab;
    int pad_;
};
struct RowIn { f32x4 h[4], y[4]; };
DEVINL void row_load(const RowArgs& a, int r, int lane, RowIn& v) {
    const bool lat = r < NLAT; const int rc = r - NLAT;
    const float* hin = lat ? a.hin_l + (size_t)r * DM : a.hin_c + (size_t)rc * DM;
#pragma unroll
    for (int i = 0; i < 4; ++i) v.h[i] = *(const f32x4*)(hin + i * 256 + lane * 4);
    if (a.Y != nullptr && (lat || a.upd_ctx)) {
        if (lat || a.nslab == 0) {
#pragma unroll
            for (int i = 0; i < 4; ++i) { const u32x2 w = *(const u32x2*)((const bf16_t*)a.Y + (size_t)r * DM + i * 256 + lane * 4); v.y[i] = (f32x4){lo_bf(w.x), hi_bf(w.x), lo_bf(w.y), hi_bf(w.y)}; }
        } else {
#pragma unroll
            for (int i = 0; i < 4; ++i) v.y[i] = *(const f32x4*)(a.Ys + (size_t)rc * DM + i * 256 + lane * 4);
            for (int sl = 1; sl < a.nslab; ++sl) {
#pragma unroll
                for (int i = 0; i < 4; ++i) v.y[i] += *(const f32x4*)(a.Ys + ((size_t)sl * NCTX + rc) * DM + i * 256 + lane * 4); }
        }
    }
}
DEVINL void row_math(const RowArgs& a, int r, int lane, RowIn& v, f32x4 (&xo)[4]) {
    const bool lat = r < NLAT; const int rc = r - NLAT; const int mrow = lat ? (r >> 11) : 8;
    const float* hin = lat ? a.hin_l + (size_t)r * DM : a.hin_c + (size_t)rc * DM;
    float* hout = lat ? a.hout_l + (size_t)r * DM : a.hout_c + (size_t)rc * DM;
    const bool upd = a.Y != nullptr && (lat || a.upd_ctx);
    if (upd) {
        float ss = 0.f;
#pragma unroll
        for (int i = 0; i < 4; ++i)
#pragma unroll
            for (int j = 0; j < 4; ++j) ss += v.y[i][j] * v.y[i][j];
        ss = wave_sum_dpp(ss); const float rs = rsqrtf(ss * (1.f / 1024.f) + EPS) * a.coef;
        const float* gate = a.modp + (size_t)mrow * MODW + (a.subp * 3 + 2) * 1024;
#pragma unroll
        for (int i = 0; i < 4; ++i) { const int c = i * 256 + lane * 4; const f32x4 gt = *(const f32x4*)(gate + c), gp = *(const f32x4*)(a.gpost + c);
            v.h[i] += gt * (v.y[i] * gp) * rs; }
    }
    if (upd || hin != hout) {
#pragma unroll
        for (int i = 0; i < 4; ++i) *(f32x4*)(hout + i * 256 + lane * 4) = v.h[i];
    }
    if (a.modn) {
        float ss = 0.f;
#pragma unroll
        for (int i = 0; i < 4; ++i)
#pragma unroll
            for (int j = 0; j < 4; ++j) ss += v.h[i][j] * v.h[i][j];
        ss = wave_sum_dpp(ss); const float rs = rsqrtf(ss * (1.f / 1024.f) + EPS);
        const float* sh = a.modn + (size_t)mrow * MODW + (a.subn * 3 + 0) * 1024; const float* scl = sh + 1024;
#pragma unroll
        for (int i = 0; i < 4; ++i) { const int c = i * 256 + lane * 4; const f32x4 g = *(const f32x4*)(a.gpre + c), s1 = *(const f32x4*)(scl + c), s0 = *(const f32x4*)(sh + c);
            xo[i] = (v.h[i] * rs * g) * (s1 + 1.f) + s0; }
    }
}
DEVINL void row_core(const RowArgs& a, int r, int lane, f32x4 (&xo)[4]) { RowIn v; row_load(a, r, lane, v); row_math(a, r, lane, v, xo); }
DEVINL void phase_rows(const RowArgs& a) {
    const int lane = otid() & 63, gw = obid() * 8 + (otid() >> 6), nw = gridDim.x * 8;
    RowIn cur, n1, n2;
    if (gw < a.nrows) row_load(a, gw, lane, cur);
    if (gw + nw < a.nrows) row_load(a, gw + nw, lane, n1);
    for (int r = gw; r < a.nrows; r += nw) {
        if (r + 2 * nw < a.nrows) row_load(a, r + 2 * nw, lane, n2);
        f32x4 xo[4]; row_math(a, r, lane, cur, xo);
        if (a.modn) {
#pragma unroll
            for (int i = 0; i < 4; ++i) st_bf4(a.xn + (size_t)r * a.xn_ld + i * 256 + lane * 4, xo[i]);
        }
        cur = n1; n1 = n2;
    }
}
DEVINL void phase_rows_T(const RowArgs& a, unsigned char* sm, bf16_t* XT, bf16_t* XTc) {
    const int tid = otid(), wid = tid >> 6, lane = tid & 63;
    constexpr int RS = 2052;
    for (int tl = obid(); tl < NTOK / 64; tl += gridDim.x) {
        __syncthreads();
        RowIn cur, nxt; row_load(a, tl * 64 + wid * 8, lane, cur);
        for (int q = 0; q < 8; ++q) { const int lr = wid * 8 + q, r = tl * 64 + lr; f32x4 xo[4];
            if (q < 7) row_load(a, r + 1, lane, nxt);
            row_math(a, r, lane, cur, xo); cur = nxt;
#pragma unroll
            for (int i = 0; i < 4; ++i) { u32x2 w; w.x = pk2(xo[i][0], xo[i][1]); w.y = pk2(xo[i][2], xo[i][3]);
                unsigned* dp = (unsigned*)(sm + lr * RS + (i * 256 + lane * 4) * 2); dp[0] = w.x; dp[1] = w.y; } }
        __syncthreads();
        const int r0 = tl * 64; const bool lat = r0 < NLAT; const int b = lat ? (r0 >> 11) : ((r0 - NLAT) >> 8), t0 = lat ? (r0 & 2047) : ((r0 - NLAT) & 255), T = lat ? 2048 : 256;
        bf16_t* dstb = (lat ? XT : XTc) + (size_t)b * 1024 * T + t0;
        for (int it = tid; it < 1024 * 8; it += 512) { const int d = it >> 3, tc = it & 7; unsigned w[4];
#pragma unroll
            for (int q = 0; q < 4; ++q) { const unsigned lo = *(const bf16_t*)(sm + (tc * 8 + q * 2) * RS + d * 2), hi = *(const bf16_t*)(sm + (tc * 8 + q * 2 + 1) * RS + d * 2); w[q] = lo | (hi << 16); }
            *(u32x4*)(dstb + (size_t)d * T + tc * 8) = (u32x4){w[0], w[1], w[2], w[3]}; }
    }
    __syncthreads();
}

DEVINL void phase_mla_norm(const PV& p, int j, const float* raw, bf16_t* QN, bf16_t* CKVN, bf16_t* Kb) {
    const int lane = otid() & 63, gw = obid() * 8 + (otid() >> 6), nw = gridDim.x * 8;
    const float* qg = p.in(12) + j * 512; const float* kg = p.in(15) + j * 256;
    const float* ct = (const float*)(p.ws + WS_ROPE); const float* st = ct + 1024;
    for (int r = gw; r < NTOK; r += nw) {
        const float* row = raw + (size_t)r * 1024;
        f32x4 q0 = *(const f32x4*)(row + lane * 4), q1 = *(const f32x4*)(row + 256 + lane * 4), kv = *(const f32x4*)(row + 512 + lane * 4);
        const float kp = row[768 + lane];
        float sq = 0.f, sk = 0.f;
#pragma unroll
        for (int i = 0; i < 4; ++i) { sq += q0[i] * q0[i] + q1[i] * q1[i]; sk += kv[i] * kv[i]; }
        sq = wave_sum_dpp(sq); sk = wave_sum_dpp(sk);
        const float rq = rsqrtf(sq * (1.f / 512.f) + EPS), rk = rsqrtf(sk * (1.f / 256.f) + EPS);
        st_bf4(QN + (size_t)r * 512 + lane * 4, q0 * rq * *(const f32x4*)(qg + lane * 4));
        st_bf4(QN + (size_t)r * 512 + 256 + lane * 4, q1 * rq * *(const f32x4*)(qg + 256 + lane * 4));
        st_bf4(CKVN + (size_t)r * 256 + lane * 4, kv * rk * *(const f32x4*)(kg + lane * 4));
        int b, tk; bool lat; tok_of_row(r, b, tk, lat);
        const float other = __shfl_xor(kp, 16); float o = kp;
        if (lat) { const int axis = lane >> 5, half = (lane >> 4) & 1, pp = lane & 15, pos = axis == 0 ? (tk >> 6) : (tk & 63);
            const float c = ct[pos * 16 + pp], s = st[pos * 16 + pp];
            o = half == 0 ? kp * c - other * s : kp * c + other * s; }
        const bf16_t ob = f2bf(o);
#pragma unroll
        for (int h = 0; h < 8; ++h) Kb[((size_t)(b * 8 + h) * TKV + tk) * 192 + 128 + lane] = ob;
    }
}

constexpr int QBLK = 32, KVBLK = 64, NW = 8;
constexpr float ATT_SCALE = 0.07216878364870322f;
constexpr float ATT_THR = 8.f;
constexpr size_t SHM_V = KVBLK * 128 * 2, SHM_K = KVBLK * 192 * 2;
#define KSWZ(row, colB) ((row) * 384 + ((colB) ^ ((((row) >> 1) & 7) << 4)))
#define SBAR() __builtin_amdgcn_sched_barrier(0)
DEVINL int crow(int r, int hi) { return (r & 3) + 8 * (r >> 2) + 4 * hi; }
DEVINL void partialSM(f32x16& p0, f32x16& p1, float& m_reg, float& mn, float& alpha) {
    constexpr float C = ATT_SCALE * 1.4426950408889634f;
    float pmax = p0[0];
#pragma unroll
    for (int r = 1; r < 16; ++r) pmax = fmaxf(pmax, p0[r]);
#pragma unroll
    for (int r = 0; r < 16; ++r) pmax = fmaxf(pmax, p1[r]);
    { auto rr = __builtin_amdgcn_permlane32_swap(__float_as_uint(pmax), __float_as_uint(pmax), false, false);
      pmax = fmaxf(__uint_as_float(rr[0]), __uint_as_float(rr[1])); }
    if (__builtin_expect(__all(pmax - m_reg <= ATT_THR / ATT_SCALE), 1)) { mn = m_reg; alpha = 1.f; }
    else { mn = fmaxf(m_reg, pmax); alpha = __builtin_amdgcn_exp2f((m_reg - mn) * C); m_reg = mn; }
    const float mnC = -mn * C;
#pragma unroll
    for (int r = 0; r < 16; ++r) p0[r] = fmaf(p0[r], C, mnC);
#pragma unroll
    for (int r = 0; r < 16; ++r) p1[r] = fmaf(p1[r], C, mnC);
#pragma unroll
    for (int r = 0; r < 16; ++r) p0[r] = __builtin_amdgcn_exp2f(p0[r]);
}
DEVINL void finishSM(f32x16& p0, f32x16& p1, float alpha, float& l_reg, bf16x8& pa0, bf16x8& pa1, bf16x8& pa2, bf16x8& pa3) {
#pragma unroll
    for (int r = 0; r < 16; ++r) p1[r] = __builtin_amdgcn_exp2f(p1[r]);
    float ps = 0;
#pragma unroll
    for (int r = 0; r < 16; ++r) ps += p0[r];
#pragma unroll
    for (int r = 0; r < 16; ++r) ps += p1[r];
    { auto rr = __builtin_amdgcn_permlane32_swap(__float_as_uint(ps), __float_as_uint(ps), false, false);
      ps = __uint_as_float(rr[0]) + __uint_as_float(rr[1]); }
    l_reg = l_reg * alpha + ps;
#define PK4(P, BASE, OUT) do { unsigned a0 = pk2(P[BASE + 0], P[BASE + 1]), a1 = pk2(P[BASE + 2], P[BASE + 3]);   \
    unsigned b0 = pk2(P[BASE + 4], P[BASE + 5]), b1 = pk2(P[BASE + 6], P[BASE + 7]);                              \
    auto r0 = __builtin_amdgcn_permlane32_swap(a0, b0, false, false); auto r1 = __builtin_amdgcn_permlane32_swap(a1, b1, false, false); \
    u32x4 w = {r0[0], r1[0], r0[1], r1[1]}; OUT = *reinterpret_cast<bf16x8*>(&w); } while (0)
    PK4(p0, 0, pa0); PK4(p0, 8, pa1); PK4(p1, 0, pa2); PK4(p1, 8, pa3);
#undef PK4
}
DEVINL void qkt(f32x16& p0, f32x16& p1, const char* Ks, const bf16x8* qr, const char* qpe, int qsw, int r32, int hi) {
    p0 = f32x16{}; p1 = f32x16{};
#pragma unroll
    for (int d0 = 0; d0 < 12; ++d0) { const int cb = (d0 * 16 + hi * 8) * 2;
        const bf16x8 b0 = *reinterpret_cast<const bf16x8*>(Ks + KSWZ(r32, cb));
        const bf16x8 b1 = *reinterpret_cast<const bf16x8*>(Ks + KSWZ(32 + r32, cb));
        const bf16x8 q = d0 < 8 ? qr[d0 < 8 ? d0 : 0] : *reinterpret_cast<const bf16x8*>(qpe + (((((d0 - 8) * 2 + hi) ^ qsw) & 7) << 4));
        p0 = __builtin_amdgcn_mfma_f32_32x32x16_bf16(b0, q, p0, 0, 0, 0);
        p1 = __builtin_amdgcn_mfma_f32_32x32x16_bf16(b1, q, p1, 0, 0, 0); }
}
DEVINL int v_st(int k, int c) { const int kk = (k & ~0xC) | ((k & 4) << 1) | ((k & 8) >> 1); return ((kk >> 3) * 4 + (c >> 5)) * 512 + ((kk & 7) * 32 + (c & 31)) * 2; }
DEVINL int v_rd_base(int lane) { return ((lane & 3) << 3) | (((lane >> 2) & 3) << 6) | (((lane >> 4) & 1) << 5) | (((lane >> 5) & 1) << 8); }
constexpr int v_rd_off(int d0, int ks, int half) { return d0 * 512 + ks * 4096 + half * 2048; }
template <int OFF> DEVINL s16x4 tr_read(int vb) { s16x4 r; asm volatile("ds_read_b64_tr_b16 %0, %1 offset:%2" : "=&v"(r) : "v"(vb), "i"(OFF) : "memory"); return r; }
template <int D0> DEVINL void pv_one(f32x16& od, int vb, bf16x8 pa0, bf16x8 pa1, bf16x8 pa2, bf16x8 pa3) {
    const s16x4 l0 = tr_read<v_rd_off(D0, 0, 0)>(vb), h0 = tr_read<v_rd_off(D0, 0, 1)>(vb), l1 = tr_read<v_rd_off(D0, 1, 0)>(vb), h1 = tr_read<v_rd_off(D0, 1, 1)>(vb);
    const s16x4 l2 = tr_read<v_rd_off(D0, 2, 0)>(vb), h2 = tr_read<v_rd_off(D0, 2, 1)>(vb), l3 = tr_read<v_rd_off(D0, 3, 0)>(vb), h3 = tr_read<v_rd_off(D0, 3, 1)>(vb);
    asm volatile("s_waitcnt lgkmcnt(0)" ::: "memory"); SBAR();
#define PK(L, H) (bf16x8){L[0], L[1], L[2], L[3], H[0], H[1], H[2], H[3]}
    od = __builtin_amdgcn_mfma_f32_32x32x16_bf16(pa0, PK(l0, h0), od, 0, 0, 0);
    od = __builtin_amdgcn_mfma_f32_32x32x16_bf16(pa1, PK(l1, h1), od, 0, 0, 0);
    od = __builtin_amdgcn_mfma_f32_32x32x16_bf16(pa2, PK(l2, h2), od, 0, 0, 0);
    od = __builtin_amdgcn_mfma_f32_32x32x16_bf16(pa3, PK(l3, h3), od, 0, 0, 0);
#undef PK
}
DEVINL void pv_d0(f32x16* o, int vb, bf16x8 pa0, bf16x8 pa1, bf16x8 pa2, bf16x8 pa3) {
    pv_one<0>(o[0], vb, pa0, pa1, pa2, pa3); pv_one<1>(o[1], vb, pa0, pa1, pa2, pa3); pv_one<2>(o[2], vb, pa0, pa1, pa2, pa3); pv_one<3>(o[3], vb, pa0, pa1, pa2, pa3);
}
DEVINL void attn_body(const bf16_t* __restrict__ Qb, const bf16_t* __restrict__ Kh, const bf16_t* __restrict__ Vh, bf16_t* __restrict__ Ob, int seq, char* lds) {
    const int tid = otid(), wid = tid >> 6, lane = tid & 63, r32 = lane & 31, hi = lane >> 5;
    char* V_lds = lds; char* K_lds = lds + 2 * SHM_V;
    float* wsm = (float*)(lds + 2 * SHM_V + 2 * SHM_K) + wid * 64; float* li_l = wsm; float* al_l = wsm + 32;
    float m_reg = -1e30f, l_reg = 0; f32x16 o[4] = {}; bf16x8 qr[8];
    const bf16_t* Qw = Qb + (long)(wid * QBLK + r32) * 192 + hi * 8;
    char* qpe = lds + 2 * SHM_V + 2 * SHM_K + 2048 + wid * 4096 + r32 * 128; const int qsw = (r32 >> 1) & 7;
#pragma unroll
    for (int d0 = 0; d0 < 8; ++d0) qr[d0] = *reinterpret_cast<const bf16x8*>(Qw + d0 * 16);
#pragma unroll
    for (int d0 = 8; d0 < 12; ++d0) *reinterpret_cast<bf16x8*>(qpe + (((((d0 - 8) * 2 + hi) ^ qsw) & 7) << 4)) = *reinterpret_cast<const bf16x8*>(Qw + d0 * 16);
    const int sr = tid >> 4, sc = (tid & 15) * 8, vst0 = v_st(sr, sc), vst1 = v_st(32 + sr, sc);
    int kst[3];
#pragma unroll
    for (int i = 0; i < 3; ++i) { const int id = tid + 512 * i, row = id / 24, ch = id % 24; kst[i] = KSWZ(row, ch * 16); }
    const int vb0 = (int)(uintptr_t)V_lds + v_rd_base(lane);
    bf16x8 vs0, vs1, ks0, ks1, ks2;
#define SLOAD(k0) do { vs0 = *reinterpret_cast<const bf16x8*>(&Vh[(long)((k0) + sr) * 128 + sc]); vs1 = *reinterpret_cast<const bf16x8*>(&Vh[(long)((k0) + 32 + sr) * 128 + sc]); \
    const bf16_t* kp_ = Kh + (long)(k0) * 192 + tid * 8; ks0 = *reinterpret_cast<const bf16x8*>(kp_); ks1 = *reinterpret_cast<const bf16x8*>(kp_ + 4096); ks2 = *reinterpret_cast<const bf16x8*>(kp_ + 8192); } while (0)
#define SWRITE(b) do { *(bf16x8*)(V_lds + (b) * SHM_V + vst0) = vs0; *(bf16x8*)(V_lds + (b) * SHM_V + vst1) = vs1; \
    *(bf16x8*)(K_lds + (b) * SHM_K + kst[0]) = ks0; *(bf16x8*)(K_lds + (b) * SHM_K + kst[1]) = ks1; *(bf16x8*)(K_lds + (b) * SHM_K + kst[2]) = ks2; } while (0)
#define RESC(a) do { if (__any((a) < 1.f)) { if (hi == 0) al_l[r32] = (a); asm volatile("s_waitcnt lgkmcnt(0)" ::: "memory"); \
    _Pragma("unroll") for (int d = 0; d < 4; ++d) _Pragma("unroll") for (int r = 0; r < 16; ++r) o[d][r] *= al_l[crow(r, hi)]; } } while (0)
    f32x16 pA0, pA1, pB0, pB1; float mnA, mnB, alA, alB; bf16x8 pa0, pa1, pa2, pa3; const int NT = seq / KVBLK;
    __syncthreads();
    SLOAD(0); WAIT_V0(); SWRITE(0); __syncthreads();
    qkt(pA0, pA1, K_lds, qr, qpe, qsw, r32, hi); partialSM(pA0, pA1, m_reg, mnA, alA);
    SLOAD(KVBLK);
    WAIT_V0(); SWRITE(1); __syncthreads();
    for (int j = 1; j + 1 < NT; j += 2) {
        SBAR(); qkt(pB0, pB1, K_lds + SHM_K, qr, qpe, qsw, r32, hi);
        finishSM(pA0, pA1, alA, l_reg, pa0, pa1, pa2, pa3); SBAR();
        SLOAD((j + 1) * KVBLK); SBAR();
        pv_d0(o, vb0, pa0, pa1, pa2, pa3); partialSM(pB0, pB1, m_reg, mnB, alB);
        __syncthreads(); WAIT_V0(); SWRITE(0);
        RESC(alB); __syncthreads();
        SBAR(); qkt(pA0, pA1, K_lds, qr, qpe, qsw, r32, hi);
        finishSM(pB0, pB1, alB, l_reg, pa0, pa1, pa2, pa3); SBAR();
        SLOAD((j + 2) * KVBLK); SBAR();
        pv_d0(o, vb0 + (int)SHM_V, pa0, pa1, pa2, pa3); partialSM(pA0, pA1, m_reg, mnA, alA);
        __syncthreads(); WAIT_V0(); SWRITE(1);
        RESC(alA); __syncthreads();
    }
    SBAR(); qkt(pB0, pB1, K_lds + SHM_K, qr, qpe, qsw, r32, hi);
    finishSM(pA0, pA1, alA, l_reg, pa0, pa1, pa2, pa3); SBAR();
    pv_d0(o, vb0, pa0, pa1, pa2, pa3); partialSM(pB0, pB1, m_reg, mnB, alB);
    __syncthreads(); RESC(alB);
    finishSM(pB0, pB1, alB, l_reg, pa0, pa1, pa2, pa3); SBAR();
    pv_d0(o, vb0 + (int)SHM_V, pa0, pa1, pa2, pa3);
    if (hi == 0) li_l[r32] = l_reg; asm volatile("s_waitcnt lgkmcnt(0)" ::: "memory");
    float rli[16];
#pragma unroll
    for (int r = 0; r < 16; ++r) rli[r] = __builtin_amdgcn_rcpf(li_l[crow(r, hi)]);
    bf16_t* Ow = Ob + (long)(wid * QBLK) * 1024;
#pragma unroll
    for (int r = 0; r < 16; ++r) { const int orow = crow(r, hi);
#pragma unroll
        for (int d0 = 0; d0 < 4; ++d0) Ow[(long)orow * 1024 + d0 * 32 + r32] = f2bf(o[d0][r] * rli[r]); }
#undef SLOAD
#undef SWRITE
#undef RESC
}
DEVINL void phase_attn(const bf16_t* Q, const bf16_t* K, const bf16_t* V, bf16_t* O, bool with_ctx, char* lds) {
    const int nu = 512 + (with_ctx ? 64 : 0);
    for (int u = obid(); u < nu; u += gridDim.x) {
        if (u < 512) {
            int bh = u >> 3, qb = u & 7;
            if (gridDim.x == 256) { const int x = u & 7, l = (u >> 8) * 32 + ((u & 255) >> 3); bh = x * 8 + (l >> 3); qb = l & 7; }
            const int b = bh >> 3, h = bh & 7;
            attn_body(Q + ((size_t)bh * TKV + qb * 256) * 192, K + (size_t)bh * TKV * 192, V + (size_t)bh * TKV * 128, O + ((size_t)(b * SEQ + qb * 256)) * 1024 + h * 128, TKV, lds); }
        else { const int bh = u - 512, b = bh >> 3, h = bh & 7;
            attn_body(Q + ((size_t)bh * TKV + SEQ) * 192, K + ((size_t)bh * TKV + SEQ) * 192, V + ((size_t)bh * TKV + SEQ) * 128, O + ((size_t)(NLAT + b * CTX)) * 1024 + h * 128, CTX, lds); }
    }
    __syncthreads();
}

DEVINL void phase_rwkv_shift(bf16_t* XN) {
    for (size_t it = (size_t)obid() * 512 + otid(); it < (size_t)NTOK * 128; it += (size_t)gridDim.x * 512) {
        const int r = (int)(it >> 7), c = (int)(it & 127) * 8; int b, tk; bool lat; tok_of_row(r, b, tk, lat);
        const int t = lat ? tk : tk - SEQ, T = lat ? SEQ : CTX;
        const bf16_t* up = XN + (size_t)r * 2048 + c;
        const u32x4 u0 = *(const u32x4*)up; u32x4 um = {0, 0, 0, 0}, upl = {0, 0, 0, 0};
        if (t > 0) um = *(const u32x4*)(up - 2048);
        if (t < T - 1) upl = *(const u32x4*)(up + 2048);
        u32x4 o;
#pragma unroll
        for (int q = 0; q < 4; ++q) { const float a = 0.5f * (lo_bf(um[q]) + lo_bf(upl[q])) - lo_bf(u0[q]), bq = 0.5f * (hi_bf(um[q]) + hi_bf(upl[q])) - hi_bf(u0[q]); o[q] = pk2(a, bq); }
        *(u32x4*)(XN + (size_t)r * 2048 + 1024 + c) = o;
    }
}
DEVINL void zero_f32(float* p, size_t n4) { for (size_t i = (size_t)obid() * 512 + otid(); i < n4; i += (size_t)gridDim.x * 512) ((f32x4*)p)[i] = (f32x4){0.f, 0.f, 0.f, 0.f}; }

DEVINL float red8(float v) {
    v += __builtin_bit_cast(float, __builtin_amdgcn_update_dpp(0, __builtin_bit_cast(int, v), 0xB1, 0xF, 0xF, false));
    v += __builtin_bit_cast(float, __builtin_amdgcn_update_dpp(0, __builtin_bit_cast(int, v), 0x4E, 0xF, 0xF, false));
    v += __builtin_bit_cast(float, __builtin_amdgcn_update_dpp(0, __builtin_bit_cast(int, v), 0x141, 0xF, 0xF, false));
    return v;
}
typedef float f32x2 __attribute__((ext_vector_type(2)));
struct StepOps { f32x4 a0, a1, q0, q1, w0, w1, b0, b1, k0, k1; float viA, viB; f32x2 sc2; };
DEVINL void phase_scan(const PV& p, const bf16_t* R, const bf16_t* Kf, const bf16_t* Vf, const bf16_t* AA, const bf16_t* LW, float* Y0, bf16_t* Y1, unsigned char* sm) {
    constexpr int TC = 32, NCH = (CTX + SEQ) / TC;
    const int tid = otid(), wid = __builtin_amdgcn_readfirstlane(tid >> 6), lane = tid & 63;
    float* Fb = (float*)sm;
    float* ybb = Fb + 2 * TC * 384;
    float* sclb = ybb + 2 * TC * 64;
    const float* kkp = p.in(32); const float* kap = p.in(33);
    for (int it = obid(); it < 256; it += gridDim.x) {
        const int e = it >> 7, b = (it >> 4) & 7, h = it & 15, ch = h * 64 + lane;
        __syncthreads();
        if (wid >= 4) {
            const int hw = wid - 4;
            const float k_k = kkp[ch], k_a = kap[ch];
            const bf16_t* Ae = AA + (size_t)e * NTOK * DM; const bf16_t* Le = LW + (size_t)e * NTOK * DM;
            bf16_t pr[8], pk[8], pv[8], pa[8], pl[8];
#define SC_ROW(c_, s_) ({ const int g_ = (c_) * TC + (s_); const bool cx_ = g_ < CTX; const int sl_ = cx_ ? g_ : g_ - CTX, T_ = cx_ ? CTX : SEQ; \
            (cx_ ? NLAT + b * CTX : b * SEQ) + (e == 0 ? sl_ : T_ - 1 - sl_); })
#define SC_LOAD(c_) do { _Pragma("unroll") for (int q = 0; q < 8; ++q) { const size_t o_ = (size_t)SC_ROW(c_, hw + 4 * q) * DM + ch; \
            pr[q] = R[o_]; pk[q] = Kf[o_]; pv[q] = Vf[o_]; pa[q] = Ae[o_]; pl[q] = Le[o_]; } } while (0)
#define SC_DERIVE(c_) do { float* F_ = Fb + ((c_) & 1) * TC * 384; float* scl_ = sclb + ((c_) & 1) * TC * 2; _Pragma("unroll") for (int q = 0; q < 8; ++q) { const int s = hw + 4 * q; \
            const float r = bf2f(pr[q]), k = bf2f(pk[q]), v = bf2f(pv[q]), a = sigm_f(bf2f(pa[q])), nx = -bf2f(pl[q]); \
            const float sp = fmaxf(nx, 0.f) + __logf(1.f + __expf(-fabsf(nx))), w = __expf(-__expf(-sp - 0.5f)); \
            const float kv = k * k_k; const float n2 = wave_sum_dpp(kv * kv); const float kk = kv * __builtin_amdgcn_rsqf(fmaxf(n2, 1e-24f)); \
            const float bb = kk * a, kd = k * (1.f + (a - 1.f) * k_a); \
            const float br = wave_sum_dpp(bb * r), kr = wave_sum_dpp(kd * r); \
            float* f = F_ + s * 384 + lane; \
            f[0] = -kk; f[64] = bb; f[128] = w; f[192] = kd; f[256] = w * r; f[320] = v; \
            if (lane == 0) { scl_[s * 2] = br; scl_[s * 2 + 1] = kr; } } } while (0)
#define SC_FLUSH(c_) do { const float* yb_ = ybb + ((c_) & 1) * TC * 64; _Pragma("unroll") for (int q = 0; q < 8; ++q) { const int s = hw + 4 * q; const size_t o_ = (size_t)SC_ROW(c_, s) * DM + ch; \
            const float yv = yb_[s * 64 + lane]; if (e == 0) Y0[o_] = yv; else Y1[o_] = f2bf(yv); } } while (0)
            SC_LOAD(0); SC_DERIVE(0); SC_LOAD(1);
            __syncthreads();
            for (int c = 0; c < NCH; ++c) {
                if (c + 1 < NCH) { SC_DERIVE(c + 1); if (c + 2 < NCH) SC_LOAD(c + 2); }
                if (c >= 1) SC_FLUSH(c - 1);
                __syncthreads();
            }
            SC_FLUSH(NCH - 1);
#undef SC_LOAD
#undef SC_DERIVE
#undef SC_FLUSH
#undef SC_ROW
        } else {
            f32x2 SA[4], SB[4];
#pragma unroll
            for (int j = 0; j < 4; ++j) { SA[j] = (f32x2){0.f, 0.f}; SB[j] = (f32x2){0.f, 0.f}; }
            const int iA = wid * 16 + (lane >> 3), iB = iA + 8, cg8 = (lane & 7) * 8;
            __syncthreads();
            for (int c = 0; c < NCH; ++c) {
                const float* F = Fb + (c & 1) * TC * 384; float* yb = ybb + (c & 1) * TC * 64; const float* scl = sclb + (c & 1) * TC * 2;
#define ST_LD(o, s_) do { const float* f_ = F + (s_) * 384 + cg8; o.a0 = *(const f32x4*)(f_); o.a1 = *(const f32x4*)(f_ + 4); o.q0 = *(const f32x4*)(f_ + 256); o.q1 = *(const f32x4*)(f_ + 260); \
                o.w0 = *(const f32x4*)(f_ + 128); o.w1 = *(const f32x4*)(f_ + 132); o.b0 = *(const f32x4*)(f_ + 64); o.b1 = *(const f32x4*)(f_ + 68); o.k0 = *(const f32x4*)(f_ + 192); o.k1 = *(const f32x4*)(f_ + 196); \
                o.viA = F[(s_) * 384 + 320 + iA]; o.viB = F[(s_) * 384 + 320 + iB]; o.sc2 = *(const f32x2*)(scl + (s_) * 2); } while (0)
#define P2(v, i) (f32x2){v[i], v[i + 1]}
#define ST_ROW(o, S, vi, irow, s_) do { \
                f32x2 da = S[0] * P2(o.a0, 0), dq = S[0] * P2(o.q0, 0); da += S[1] * P2(o.a0, 2); dq += S[1] * P2(o.q0, 2); \
                da += S[2] * P2(o.a1, 0); dq += S[2] * P2(o.q1, 0); da += S[3] * P2(o.a1, 2); dq += S[3] * P2(o.q1, 2); \
                float sa = da[0] + da[1], sy = dq[0] + dq[1]; \
                sa += DPPF(sa, 0xB1); sy += DPPF(sy, 0xB1); sa += DPPF(sa, 0x4E); sy += DPPF(sy, 0x4E); sa += DPPF(sa, 0x141); sy += DPPF(sy, 0x141); \
                const f32x2 sa2 = {sa, sa}, vi2 = {vi, vi}; \
                S[0] = S[0] * P2(o.w0, 0) + sa2 * P2(o.b0, 0) + vi2 * P2(o.k0, 0); S[1] = S[1] * P2(o.w0, 2) + sa2 * P2(o.b0, 2) + vi2 * P2(o.k0, 2); \
                S[2] = S[2] * P2(o.w1, 0) + sa2 * P2(o.b1, 0) + vi2 * P2(o.k1, 0); S[3] = S[3] * P2(o.w1, 2) + sa2 * P2(o.b1, 2) + vi2 * P2(o.k1, 2); \
                yb[(s_) * 64 + irow] = sy + sa * o.sc2[0] + vi * o.sc2[1]; } while (0)
                StepOps X, Z; ST_LD(X, 0);
#pragma unroll
                for (int s = 0; s < TC; s += 2) {
                    ST_LD(Z, s + 1);
                    ST_ROW(X, SA, X.viA, iA, s); ST_ROW(X, SB, X.viB, iB, s);
                    ST_LD(X, s + 2);
                    ST_ROW(Z, SA, Z.viA, iA, s + 1); ST_ROW(Z, SB, Z.viB, iB, s + 1);
                }
#undef ST_LD
#undef ST_ROW
#undef P2
                __syncthreads();
            }
        }
    }
    __syncthreads();
}
struct ROIn { f32x4 y[4]; u32x2 y1[4], rw[4], kw[4], vw[4], a0w[4], a1w[4], gw[4]; };
DEVINL f32x4 bf4(u32x2 w) { return (f32x4){lo_bf(w.x), hi_bf(w.x), lo_bf(w.y), hi_bf(w.y)}; }
DEVINL void phase_rwkv_out(const PV& p, const float* Y, const bf16_t* Y1, const bf16_t* R, const bf16_t* Kf, const bf16_t* Vf, const bf16_t* AA, const bf16_t* Gg, bf16_t* XO) {
    const int lane = otid() & 63, gw = obid() * 8 + (otid() >> 6), nw = gridDim.x * 8;
    const float* k_a = p.in(33); const float* r_k = p.in(34); const float* lnw = p.in(35); const float* lnb = p.in(36);
#define RO_LOAD(v, r_) do { _Pragma("unroll") for (int i = 0; i < 4; ++i) { const size_t o = (size_t)(r_) * DM + i * 256 + lane * 4; \
        v.y[i] = *(const f32x4*)(Y + o); v.y1[i] = *(const u32x2*)(Y1 + o); v.rw[i] = *(const u32x2*)(R + o); v.kw[i] = *(const u32x2*)(Kf + o); v.vw[i] = *(const u32x2*)(Vf + o); \
        v.a0w[i] = *(const u32x2*)(AA + o); v.a1w[i] = *(const u32x2*)(AA + (size_t)NTOK * DM + o); v.gw[i] = *(const u32x2*)(Gg + o); } } while (0)
    ROIn cur, nxt;
    if (gw < NTOK) RO_LOAD(cur, gw);
    for (int r = gw; r < NTOK; r += nw) {
        const bool more = r + nw < NTOK;
        if (more) RO_LOAD(nxt, r + nw);
#pragma unroll
        for (int i = 0; i < 4; ++i) { const int c = i * 256 + lane * 4; const size_t o = (size_t)r * DM + c;
            const f32x4 y = cur.y[i] + bf4(cur.y1[i]);
            const f32x4 rr = bf4(cur.rw[i]), kk = bf4(cur.kw[i]), vv = bf4(cur.vw[i]), gg = bf4(cur.gw[i]);
            const f32x4 a0r = bf4(cur.a0w[i]), a1r = bf4(cur.a1w[i]);
            const f32x4 a0 = {sigm_f(a0r[0]), sigm_f(a0r[1]), sigm_f(a0r[2]), sigm_f(a0r[3])}, a1 = {sigm_f(a1r[0]), sigm_f(a1r[1]), sigm_f(a1r[2]), sigm_f(a1r[3])};
            const f32x4 ka = *(const f32x4*)(k_a + c), rk = *(const f32x4*)(r_k + c), lw = *(const f32x4*)(lnw + c), lb = *(const f32x4*)(lnb + c);
            float s = y[0] + y[1] + y[2] + y[3]; s = sum16(s); const float mu = s * (1.f / 64.f);
            const f32x4 d = y - mu; float vs = d[0] * d[0] + d[1] * d[1] + d[2] * d[2] + d[3] * d[3]; vs = sum16(vs);
            const float rstd = rsqrtf(vs * (1.f / 64.f) + 64e-5f);
            const f32x4 kd = kk * ((a0 + a1 - 2.f) * ka + 2.f);
            const f32x4 cf = rr * kd * rk; float co = cf[0] + cf[1] + cf[2] + cf[3]; co = sum16(co);
            const f32x4 out = (d * rstd * lw + lb + vv * co) * gg;
            st_bf4(XO + o, out); }
        if (more) cur = nxt;
    }
#undef RO_LOAD
}

enum { OP_PREP, OP_ROW0, OP_ROW_A, OP_ROW_B, OP_ROW_C, OP_FFN_UP, OP_FFN_DN, OP_MLA_DQKV, OP_MLA_NORM, OP_MLA_UQ, OP_MLA_UKV, OP_MLA_ATTN, OP_MLA_WO,
       OP_FN_DFT, OP_FN_DFTC, OP_FN_OUT, OP_RW_SHIFT, OP_RW_G1, OP_RW_G2W, OP_RW_G2A, OP_RW_G2G, OP_RW_SCAN, OP_RW_OUT, OP_RW_WO };
#define OPC(op, layer, which, nosync) ((op) | ((layer) << 8) | ((which) << 12) | ((nosync) << 16))
#define FFN1(l) OPC(OP_FFN_UP, l, 0, 0), OPC(OP_FFN_DN, l, 0, 0), OPC(OP_ROW_A, l, 0, 0)
#define FFN2(l) OPC(OP_ROW_B, l, 0, 0), OPC(OP_FFN_UP, l, 1, 0), OPC(OP_FFN_DN, l, 1, 0), OPC(OP_ROW_C, l, 0, 0)
#define MLA(l) OPC(OP_MLA_DQKV, l, 0, 0), OPC(OP_MLA_NORM, l, 0, 0), OPC(OP_MLA_UQ, l, 0, 1), OPC(OP_MLA_UKV, l, 0, 0), OPC(OP_MLA_ATTN, l, 0, 0), OPC(OP_MLA_WO, l, 0, 0)
constexpr int PROG[] = {
    OPC(OP_PREP, 0, 0, 0), OPC(OP_ROW0, 0, 0, 0),
    FFN1(0), MLA(0), FFN2(0),
    FFN1(1), OPC(OP_FN_DFT, 1, 0, 1), OPC(OP_FN_DFTC, 1, 0, 0), OPC(OP_FN_OUT, 1, 0, 0), FFN2(1),
    FFN1(2), OPC(OP_RW_SHIFT, 2, 0, 0), OPC(OP_RW_G1, 2, 0, 0), OPC(OP_RW_G2W, 2, 0, 1), OPC(OP_RW_G2A, 2, 0, 1), OPC(OP_RW_G2G, 2, 0, 0), OPC(OP_RW_SCAN, 2, 0, 0),
             OPC(OP_RW_OUT, 2, 0, 0), OPC(OP_RW_WO, 2, 0, 0), FFN2(2),
    FFN1(3), MLA(3), FFN2(3) };
constexpr int NPROG = 2 + (3 + 6 + 4) + (3 + 3 + 4) + (3 + 8 + 4) + (3 + 6 + 4);

#define XB_TMO      128
#define XB_XCNT(j)  (256  + 64 * (j))
#define XB_XSUB(j)  (1280 + 64 * (j))
#define XB_XGEN(j)  (2304 + 64 * (j))
#define XB_TOP      3328
#define XB_TOPGEN   3392
#define XCD_BAR_WORDS 3456
#define XB_SPIN_CAP (1u << 20)
DEVINL unsigned xb_ld(unsigned* p)              { return __hip_atomic_load(p, __ATOMIC_RELAXED, __HIP_MEMORY_SCOPE_AGENT); }
DEVINL unsigned xb_add(unsigned* p, unsigned v) { return __hip_atomic_fetch_add(p, v, __ATOMIC_RELAXED, __HIP_MEMORY_SCOPE_AGENT); }
DEVINL unsigned xb_xcc_id() { return (unsigned)__builtin_amdgcn_s_getreg((3 << 11) | 20) & 0xFu; }
#define XB_SPIN(cond, bar) do { unsigned _sp = 0; while (cond) { __builtin_amdgcn_s_sleep(1); \
    if ((++_sp & 255u) == 0u) { if (xb_ld(&(bar)[XB_TMO])) break; if (_sp > XB_SPIN_CAP) { atomicAdd(&(bar)[XB_TMO], 1u); break; } } } } while (0)
DEVINL void xcd_barrier_post(unsigned* bar) { if (otid() == 0) (void)xb_add(&bar[XB_XCNT(xb_xcc_id())], 1u); }
DEVINL void xcd_barrier_complete(unsigned* bar, unsigned x, unsigned& nloc, unsigned& nx) {
    const unsigned G = gridDim.x;
    unsigned sum, cnt, mine, sp = 0u;
    for (;;) {
        sum = 0u; cnt = 0u; mine = 0u;
#pragma unroll
        for (unsigned j = 0; j < 16; ++j) { const unsigned c = xb_ld(&bar[XB_XCNT(j)]); sum += c; cnt += (c > 0u) ? 1u : 0u; mine = (j == x) ? c : mine; }
        if (sum == G) break;
        __builtin_amdgcn_s_sleep(1);
        if ((++sp & 255u) == 0u) { if (xb_ld(&bar[XB_TMO])) break; if (sp > XB_SPIN_CAP) { atomicAdd(&bar[XB_TMO], 1u); break; } }
    }
    nloc = mine > 0u ? mine : 1u; nx = cnt > 0u ? cnt : 1u;
}
DEVINL void xcd_barrier(unsigned* bar, volatile LAS unsigned* st) {
    asm volatile("s_waitcnt vmcnt(0)" ::: "memory");
    __syncthreads();
    if (otid() == 0) {
        const unsigned x = xb_xcc_id();
        __builtin_amdgcn_s_waitcnt(0);
        unsigned nloc = st[0], nx = st[1];
        if (nloc == 0u) { xcd_barrier_complete(bar, x, nloc, nx); st[0] = nloc; st[1] = nx; }
        const unsigned old = xb_add(&bar[XB_XSUB(x)], 1u);
        const unsigned gen = old / nloc;
        if (old + 1u == (gen + 1u) * nloc) {
            __builtin_amdgcn_fence(__ATOMIC_RELEASE, "agent");
            asm volatile("s_waitcnt vmcnt(0)" ::: "memory");
            const unsigned og = xb_add(&bar[XB_TOP], 1u);
            const unsigned tg = og / nx;
            if (og + 1u == (tg + 1u) * nx) xb_add(&bar[XB_TOPGEN], 1u);
            else XB_SPIN(xb_ld(&bar[XB_TOPGEN]) == tg, bar);
            __builtin_amdgcn_fence(__ATOMIC_ACQUIRE, "agent");
            xb_add(&bar[XB_XGEN(x)], 1u);
            asm volatile("s_waitcnt vmcnt(0)" ::: "memory");
        } else {
            XB_SPIN(xb_ld(&bar[XB_XGEN(x)]) == gen, bar);
            __builtin_amdgcn_fence(__ATOMIC_ACQUIRE, "agent");
            asm volatile("s_waitcnt vmcnt(0)" ::: "memory");
        }
    }
    __syncthreads();
}
constexpr int bar_ordinal(int pc) { int n = 0; for (int q = 1; q <= pc; ++q) if (!((PROG[q] >> 16) & 1)) ++n; return n; }
template <int PC>
DEVINL void run_prog(const Params& kp, unsigned char* smem, cg::grid_group& grid) {
    LAS unsigned char* lds = (LAS unsigned char*)smem;
    {
        constexpr int code = PROG[PC], op = code & 0xff, i = (code >> 8) & 0xf, which = (code >> 12) & 0xf, nosync = (code >> 16) & 1;
        unsigned char* ws = kp.ws;
        const int zz = 0;
        float* outp = kp.out;
        const PV p{kp, zz, ws, outp};
        float* MOD = (float*)(ws + WS_MOD); float* HC = (float*)(ws + WS_HC); bf16_t* XN = (bf16_t*)(ws + WS_XN); float* Y = (float*)(ws + WS_Y);
        bf16_t* WM = (bf16_t*)(ws + WS_WM); unsigned char* SCR = ws + WS_SCR;
        const float* npre = p.in(6); const float* npost = p.in(7);
        const int kind = i % 3, j = i / 3; const bool last = (i == 3);
        const float* modi = MOD + (size_t)i * 9 * MODW;
        bf16_t* slot = (bf16_t*)(ws + WS_WF) + (size_t)(i & 1) * FFN_SLOT;
        bf16_t* G = (bf16_t*)(SCR + S_G);
        bf16_t* M = WM + (j ? WM_MLA1 : WM_MLA0);
        switch (op) {
        case OP_PREP: phase_prep(p, smem); break;
        case OP_ROW0: case OP_ROW_A: case OP_ROW_B: case OP_ROW_C: {
            RowArgs a{}; a.hin_l = p.out; a.hin_c = HC; a.hout_l = p.out; a.hout_c = HC; a.Y = Y; a.modp = modi; a.xn = XN; a.xn_ld = 1024; a.nrows = NTOK; a.upd_ctx = 1; a.modn = modi;
            if (op == OP_ROW0) { a.hin_l = p.in(0); a.hin_c = p.in(2); a.Y = nullptr; a.subn = 0; a.gpre = npre; }
            else if (op == OP_ROW_A) { a.Ys = (const float*)(ws + WS_SLAB); a.nslab = NSLAB; a.subp = 0; a.gpost = npost + (i * 3 + 0) * 1024; a.coef = 0.5f; a.subn = 1; a.gpre = npre + (i * 3 + 1) * 1024; a.xn_ld = (kind == 2) ? 2048 : 1024; }
            else if (op == OP_ROW_B) { a.Ys = (const float*)(ws + WS_SLAB); a.nslab = last ? 0 : 4; a.subp = 1; a.gpost = npost + (i * 3 + 1) * 1024; a.coef = 1.0f; a.subn = 2; a.gpre = npre + (i * 3 + 2) * 1024; a.nrows = last ? NLAT : NTOK; }
            else { a.Ys = (const float*)(ws + WS_SLAB); a.nslab = last ? 0 : NSLAB; a.subp = 2; a.gpost = npost + (i * 3 + 2) * 1024; a.coef = 0.5f; a.nrows = last ? NLAT : NTOK;
                   if (last) a.modn = nullptr; else { a.modn = MOD + (size_t)(i + 1) * 9 * MODW; a.subn = 0; a.gpre = npre + ((i + 1) * 3 + 0) * 1024; } }
            if (op == OP_ROW_A && kind == 1) phase_rows_T(a, smem, (bf16_t*)(SCR + S_XT), (bf16_t*)(SCR + S_XTC)); else phase_rows(a);
        } break;
        case OP_FFN_UP: { Gemm g{XN, slot + (size_t)which * (FFN_WGU + FFN_WD), 1024, 1024, 1024, ((last && which) ? NLAT : NTOK) / 256, 2 * DFF / 256, 0, 0}; EpiSwiGLU E{G}; gemm_phase(lds, g, E);
            if (i < 3) { const int nbusy = (g.nM * g.nN) % (int)gridDim.x, bid = obid();
                if (bid >= nbusy) { __syncthreads(); conv_ffn_w((float*)smem, p, i + 1, which, (bf16_t*)(ws + WS_WF) + (size_t)((i + 1) & 1) * FFN_SLOT, bid - nbusy, (int)gridDim.x - nbusy); } } } break;
        case OP_MLA_DQKV: { Gemm g{XN, M + MLA_DQKV, 1024, 1024, 1024, NTOK / 256, 4, 0, 0}; EpiF32 E{Y, 1024, nullptr, nullptr}; gemm_phase(lds, g, E);
            if (i == 0) { const int nbusy = (g.nM * g.nN) % (int)gridDim.x, bid = obid(); if (bid >= nbusy) { __syncthreads(); prep_late(p, smem, bid - nbusy, (int)gridDim.x - nbusy); } } } break;
        case OP_FFN_DN: case OP_MLA_WO: case OP_FN_OUT: case OP_RW_WO: {
            Gemm g{XN, M + MLA_WO, 1024, 1024, 1024, NLAT / 256, 4, 0, 0}; EpiY E{(bf16_t*)Y, nullptr, (float*)(ws + WS_SLAB)};
            bool tail = true;
            if (op == OP_FFN_DN) { g.A = G; g.Bt = slot + (size_t)which * (FFN_WGU + FFN_WD) + FFN_WGU; g.lda = g.ldb = g.K = DFF; tail = !(last && which); g.KS = 512; g.nSl = NSLAB; }
            else if (op == OP_MLA_WO) { tail = !last; g.KS = 256; g.nSl = 4; }
            else if (op == OP_FN_OUT) { g.A = (bf16_t*)(SCR + S_P); g.Bt = WM + WM_W2T; g.lda = g.ldb = g.K = 2048; E.bias = p.in(19); g.KS = 512; g.nSl = 4; }
            else { g.Bt = WM + WM_RWO; g.KS = 256; g.nSl = 4; }
            if (tail) g.nTailM = NCTX / 256; else g.nSl = 0;
            gemm_phase(lds, g, E);
        } break;
        case OP_MLA_NORM: phase_mla_norm(p, j, Y, (bf16_t*)(SCR + S_QN), (bf16_t*)(SCR + S_CKVN), (bf16_t*)(SCR + S_K)); break;
        case OP_MLA_UQ: { Gemm g{(bf16_t*)(SCR + S_QN), M + MLA_UQ, 512, 512, 512, NTOK / 256, 6, 0, 0}; EpiUQ E{(bf16_t*)(SCR + S_Q), (const float*)(ws + WS_ROPE), (const float*)(ws + WS_ROPE) + 1024}; gemm_phase(lds, g, E); } break;
        case OP_MLA_UKV: { Gemm g{(bf16_t*)(SCR + S_CKVN), M + MLA_UKV, 256, 256, 256, NTOK / 256, 8, 0, 0}; EpiUKV E{(bf16_t*)(SCR + S_K), (bf16_t*)(SCR + S_V)}; gemm_phase(lds, g, E); } break;
        case OP_MLA_ATTN: phase_attn((bf16_t*)(SCR + S_Q), (bf16_t*)(SCR + S_K), (bf16_t*)(SCR + S_V), XN, !last, (char*)smem); break;
        case OP_FN_DFT: case OP_FN_DFTC: {
            Gemm g{WM + WM_DT2, (bf16_t*)(SCR + S_XT), 2048, 2048, 2048, 128, 4, 16, (size_t)1024 * 2048 * 2}; EpiDFT1 E{(bf16_t*)(SCR + S_P), 4, 2048, 0};
            if (op == OP_FN_DFTC) { g.A = WM + WM_DT2C; g.Bt = (bf16_t*)(SCR + S_XTC); g.lda = g.ldb = g.K = 256; g.nM = 16; g.amod = 2; g.bbatch = (size_t)1024 * 256 * 2; E.shift = 1; E.rpb = 256; E.rowbase = NLAT; }
            gemm_phase(lds, g, E);
        } break;
        case OP_RW_SHIFT: phase_rwkv_shift(XN); break;
        case OP_RW_G1: { Gemm g{XN, WM + WM_WCAT, 2048, 2048, 2048, NTOK / 256, 14, 0, 0}; EpiRwkv1 E{(bf16_t*)(SCR + S_R), (bf16_t*)(SCR + S_A2)}; gemm_phase(lds, g, E); } break;
        case OP_RW_G2W: case OP_RW_G2A: {
            Gemm g{(bf16_t*)(SCR + S_A2), WM + WM_BW, 512, 256, 256, NTOK / 256, 8, 0, 0};
            if (op == OP_RW_G2A) { g.Bt = WM + WM_BA; EpiRwkv2<1> E{(bf16_t*)(SCR + S_AA), p.in(27)}; gemm_phase(lds, g, E); }
            else { EpiRwkv2<0> E{XN, p.in(24)}; gemm_phase(lds, g, E); }
        } break;
        case OP_RW_G2G: { Gemm g{(bf16_t*)(SCR + S_A2) + 256, WM + WM_BG, 512, 256, 256, NTOK / 256, 4, 0, 0}; EpiBf16 E{(bf16_t*)(SCR + S_GG), 1024}; gemm_phase(lds, g, E); } break;
        case OP_RW_SCAN: phase_scan(p, (bf16_t*)(SCR + S_R), (bf16_t*)(SCR + S_KK), (bf16_t*)(SCR + S_VV), (bf16_t*)(SCR + S_AA), XN, Y, (bf16_t*)(ws + WS_SLAB), smem); break;
        case OP_RW_OUT: phase_rwkv_out(p, Y, (const bf16_t*)(ws + WS_SLAB), (bf16_t*)(SCR + S_R), (bf16_t*)(SCR + S_KK), (bf16_t*)(SCR + S_VV), (bf16_t*)(SCR + S_AA), (bf16_t*)(SCR + S_GG), XN); break;
        default: break;
        }
        if (!nosync && PC + 1 < NPROG) { if (PC == 0 && kp.ws == nullptr) grid.sync(); xcd_barrier((unsigned*)(kp.ws + WS_BAR), (volatile LAS unsigned*)(lds + LDS_BYTES - 16)); }
    }
    if constexpr (PC + 1 < NPROG) run_prog<PC + 1>(kp, smem, grid);
}
__global__ void __launch_bounds__(512) fwd_megakernel(Params kp) {
    extern __shared__ __attribute__((aligned(16))) unsigned char smem[];
    cg::grid_group grid = cg::this_grid();
    if (otid() < 4) ((volatile LAS unsigned*)((LAS unsigned char*)smem + LDS_BYTES - 16))[otid()] = 0u;
    __syncthreads();
    xcd_barrier_post((unsigned*)(kp.ws + WS_BAR));
    run_prog<0>(kp, smem, grid);
}

extern "C" void kernel_launch(void* const* d_in, const int* in_sizes, int n_in, void* d_out, int out_size, void* d_ws, size_t ws_size, hipStream_t stream) {
    static int grid = 0;
    if (grid == 0) {
        if (n_in != 38 || ws_size < WS_END) { fprintf(stderr, "kernel_launch: need 38 inputs and %zu bytes of workspace; got %d, %zu\n", (size_t)WS_END, n_in, ws_size); grid = -1; return; }
        int dev = 0, cus = 0, per_cu = 0;
        (void)hipGetDevice(&dev); (void)hipDeviceGetAttribute(&cus, hipDeviceAttributeMultiprocessorCount, dev);
        if (hipFuncSetAttribute((const void*)fwd_megakernel, hipFuncAttributeMaxDynamicSharedMemorySize, LDS_BYTES) != hipSuccess) { fprintf(stderr, "kernel_launch: hipFuncSetAttribute failed\n"); grid = -1; return; }
        if (hipOccupancyMaxActiveBlocksPerMultiprocessor(&per_cu, (const void*)fwd_megakernel, 512, LDS_BYTES) != hipSuccess || per_cu < 1) { fprintf(stderr, "kernel_launch: occupancy query says %d\n", per_cu); per_cu = 1; }
        (void)hipGetLastError();
        grid = cus * 1;
    }
    if (grid < 0) return;
    Params p{};
    for (int i = 0; i < 38; ++i) p.in[i] = (const float*)d_in[i];
    p.out = (float*)d_out; p.ws = (unsigned char*)d_ws;
    if (hipMemsetAsync((char*)d_ws + WS_BAR, 0, 16384, stream) != hipSuccess) { fprintf(stderr, "kernel_launch: memset failed\n"); return; }
    void* args[] = {&p};
    hipError_t e = hipLaunchCooperativeKernel((const void*)fwd_megakernel, dim3(grid), dim3(512), args, LDS_BYTES, stream);
    if (e != hipSuccess) fprintf(stderr, "cooperative launch failed: %s (grid %d)\n", hipGetErrorString(e), grid);
}
```

```cpp
#include <hip/hip_runtime.h>
#include <hip/hip_cooperative_groups.h>
#include <cstdio>
namespace cg = cooperative_groups;

#define LAS __attribute__((address_space(3)))
#define DEVINL __device__ __forceinline__
typedef unsigned short bf16_t;
typedef short bf16x8 __attribute__((ext_vector_type(8)));
typedef short s16x4 __attribute__((ext_vector_type(4)));
typedef float f32x4 __attribute__((ext_vector_type(4)));
typedef float f32x16 __attribute__((ext_vector_type(16)));
typedef unsigned u32x4 __attribute__((ext_vector_type(4)));
typedef unsigned u32x2 __attribute__((ext_vector_type(2)));

constexpr int DM = 1024, NB = 8, SEQ = 2048, CTX = 256, DFF = 2816, NLAT = NB * SEQ, NCTX = NB * CTX, NTOK = NLAT + NCTX, TKV = SEQ + CTX;
constexpr int MODW = 9 * DM;
constexpr float EPS = 1e-6f;

constexpr size_t al256(size_t x) { return (x + 255) / 256 * 256; }
constexpr size_t WS_MOD = 0;
constexpr size_t WS_ROPE = al256(WS_MOD + (size_t)4 * 9 * MODW * 4);
constexpr size_t WS_HC = al256(WS_ROPE + 2 * 64 * 16 * 4);
constexpr size_t WS_XN = al256(WS_HC + (size_t)NCTX * DM * 4);
constexpr size_t WS_Y = al256(WS_XN + (size_t)NTOK * 2048 * 2);
constexpr size_t FFN_WGU = (size_t)2 * DFF * DM;
constexpr size_t FFN_WD = (size_t)DM * DFF;
constexpr size_t FFN_SLOT = 2 * (FFN_WGU + FFN_WD);
constexpr size_t WS_WF = al256(WS_Y + (size_t)NTOK * DM * 4);
constexpr size_t WS_WM = al256(WS_WF + 2 * FFN_SLOT * 2);
constexpr size_t MLA_DQKV = 0, MLA_UQ = MLA_DQKV + 1024 * 1024, MLA_UKV = MLA_UQ + 1536 * 512, MLA_WO = MLA_UKV + 2048 * 256, MLA_SZ = MLA_WO + 1024 * 1024;
constexpr size_t WM_MLA0 = 0, WM_MLA1 = MLA_SZ;
constexpr size_t WM_W2T = 2 * MLA_SZ, WM_DT2 = WM_W2T + 1024 * 2048, WM_DT2C = WM_DT2 + (size_t)4096 * 2048;
constexpr size_t WM_WCAT = WM_DT2C + 512 * 256, WM_BW = WM_WCAT + (size_t)3584 * 2048, WM_BA = WM_BW + 2048 * 256, WM_BG = WM_BA + 2048 * 256, WM_RWO = WM_BG + 1024 * 256;
constexpr size_t WM_END = WM_RWO + 1024 * 1024;
constexpr size_t WS_SCR = al256(WS_WM + WM_END * 2);
constexpr size_t SCR_BYTES = 245366784;
constexpr size_t WS_BAR = WS_SCR + SCR_BYTES;
constexpr int NSLAB = 6;
constexpr size_t WS_SLAB = WS_BAR + 16384;
constexpr size_t WS_END = WS_SLAB + (size_t)NSLAB * NCTX * DM * 4;
constexpr size_t S_G = 0;
constexpr size_t S_QN = 0, S_CKVN = S_QN + (size_t)NTOK * 512 * 2, S_Q = S_CKVN + (size_t)NTOK * 256 * 2, S_K = S_Q + (size_t)64 * TKV * 192 * 2,
                 S_V = S_K + (size_t)64 * TKV * 192 * 2;
constexpr size_t S_XT = 0, S_XTC = S_XT + (size_t)8 * 1024 * 2048 * 2, S_P = al256(S_XTC + (size_t)8 * 1024 * 256 * 2);
constexpr size_t S_R = 0, S_KK = S_R + (size_t)NTOK * DM * 2, S_VV = S_KK + (size_t)NTOK * DM * 2, S_A2 = S_VV + (size_t)NTOK * DM * 2,
                 S_AA = S_A2 + (size_t)NTOK * 512 * 2, S_GG = S_AA + (size_t)2 * NTOK * DM * 2;
static_assert(S_GG + (size_t)NTOK * DM * 2 <= SCR_BYTES, "scratch");
static_assert(S_V + (size_t)64 * TKV * 128 * 2 <= SCR_BYTES, "scratch");
static_assert(S_P + (size_t)NTOK * 2048 * 2 <= SCR_BYTES, "scratch");

constexpr int LDS_BYTES = 135168;

struct Params { const float* in[38]; float* out; unsigned char* ws; };
struct PV { const Params& p; int z; unsigned char* ws; float* out;
    __device__ __forceinline__ const float* in(int k) const { return p.in[k + z]; } };

DEVINL int otid() { int t = threadIdx.x; asm volatile("" : "+v"(t)); return t; }
DEVINL int obid() { int b = blockIdx.x; asm volatile("" : "+s"(b)); return b; }
DEVINL float bf2f(bf16_t b) { return __uint_as_float(((unsigned)b) << 16); }
DEVINL bf16_t f2bf(float f) { unsigned u = __float_as_uint(f); u += 0x7FFFu + ((u >> 16) & 1u); return (bf16_t)(u >> 16); }
typedef float f32x2c __attribute__((ext_vector_type(2)));
typedef __bf16 bf16x2c __attribute__((ext_vector_type(2)));
DEVINL unsigned pk2(float lo, float hi) { const f32x2c v = {lo, hi}; const bf16x2c r = __builtin_convertvector(v, bf16x2c); return __builtin_bit_cast(unsigned, r); }
DEVINL float wave_sum(float v) {
#pragma unroll
    for (int o = 32; o > 0; o >>= 1) v += __shfl_xor(v, o);
    return v; }
#define DPPF(v, ctrl) __builtin_bit_cast(float, __builtin_amdgcn_update_dpp(0, __builtin_bit_cast(int, (v)), (ctrl), 0xF, 0xF, false))
DEVINL float wave_sum_dpp(float v) {
    v += DPPF(v, 0xB1); v += DPPF(v, 0x4E); v += DPPF(v, 0x141); v += DPPF(v, 0x140);
    const int vi_ = __builtin_bit_cast(int, v);
    return __builtin_bit_cast(float, __builtin_amdgcn_readlane(vi_, 0)) + __builtin_bit_cast(float, __builtin_amdgcn_readlane(vi_, 16)) + __builtin_bit_cast(float, __builtin_amdgcn_readlane(vi_, 32)) + __builtin_bit_cast(float, __builtin_amdgcn_readlane(vi_, 48));
}
DEVINL float sum16(float v) {
    v += DPPF(v, 0xB1); v += DPPF(v, 0x4E); v += DPPF(v, 0x141); v += DPPF(v, 0x140);
    return v; }
DEVINL float silu_f(float x) { return x * __builtin_amdgcn_rcpf(1.f + __expf(-x)); }
DEVINL float sigm_f(float x) { return __builtin_amdgcn_rcpf(1.f + __expf(-x)); }
DEVINL float lo_bf(unsigned w) { return __uint_as_float(w << 16); }
DEVINL float hi_bf(unsigned w) { return __uint_as_float(w & 0xFFFF0000u); }

constexpr int BM = 256, BK = 64, HALF = 128, HTB = HALF * BK * 2, NXCD = 8, WGM = 8;
DEVINL int lds_byte(int r, int c) { const int st = (r >> 4) * 2 + (c >> 5), rr = r & 15, cc = c & 31, ob = rr * 64 + cc * 2; return st * 1024 + (ob ^ (((ob >> 9) & 1) << 5)); }
DEVINL void stage_rc(int b, int& R, int& C) { const int st = b / 1024, sb = b % 1024, swz = sb ^ (((sb >> 9) & 1) << 5); R = (st >> 1) * 16 + swz / 64; C = (st & 1) * 32 + (swz % 64) / 2; }
DEVINL int perm32(int rho) { const int n = rho >> 4, i = rho & 15; return 8 * (i >> 2) + 4 * n + (i & 3); }
struct Unit { int pm, pn, ks; };
struct Gemm { const bf16_t* A; const bf16_t* Bt; int lda, ldb, K, nM, nN, amod; size_t bbatch; int nTailM, nSl, KS; };
struct Sched {
    int nM, nN, nwg, G, c, ntail, nSl;
    DEVINL void init(int nM_, int nN_, int nTailM, int nSl_) { nM = nM_; nN = nN_; nwg = nM * nN; G = gridDim.x; c = obid(); nSl = nSl_; ntail = nTailM * nN_ * nSl_; }
    DEVINL bool next(int i, Unit& u) const {
        const long L = (long)i * G + c; if (L >= nwg + ntail) return false;
        if (L >= nwg) { const int t = (int)L - nwg, rest = t / nSl; u.ks = t % nSl; u.pn = rest % nN; u.pm = nM + rest / nN; return true; }
        u.ks = -1;
        int wgid = (int)L; { const int q = nwg / NXCD, r = nwg % NXCD, xcd = wgid % NXCD, off = wgid / NXCD; wgid = (xcd < r ? xcd * (q + 1) : r * (q + 1) + (xcd - r) * q) + off; }
        const int nig = WGM * nN, gid = wgid / nig, fm = gid * WGM, gsz = (nM - fm) < WGM ? (nM - fm) : WGM;
        u.pm = fm + ((wgid % nig) % gsz); u.pn = (wgid % nig) / gsz; return true;
    }
};
typedef f32x4 Acc[2][2][4][2];

template <class Epi>
DEVINL void gemm_phase(LAS unsigned char* lds, const Gemm g, const Epi& E) {
    const int tid = otid(), wid = __builtin_amdgcn_readfirstlane(tid >> 6), lane = tid & 63, wr = wid >> 2, wc = wid & 3, fr = lane & 15, fq = lane >> 4;
    Sched S; S.init(g.nM, g.nN, g.nTailM, g.nSl);
    const int K = g.K;
    unsigned voffA[2], voffB[2];
#pragma unroll
    for (int i = 0; i < 2; ++i) { int R, C; stage_rc(tid * 16 + i * 8192, R, C);
        const int Rb = Epi::PERM ? ((R & ~31) + perm32(R & 31)) : R;
        voffA[i] = (unsigned)(R * g.lda + C) * 2u; voffB[i] = (unsigned)(Rb * g.ldb + C) * 2u; }
    const size_t kstep = (size_t)(BK * 2);
    const size_t hstepA = (size_t)HALF * g.lda * 2, hstepB = (size_t)HALF * g.ldb * 2;
    const size_t tstepA = 2 * hstepA, tstepB = 2 * hstepB;
    const unsigned ldsw = (unsigned)wid * 1024u;
    const int aoff = lds_byte(wr * 64 + fr, fq * 8), boff = lds_byte(wc * 32 + fr, fq * 8);
#define PG8_SA(b, h) (((b) * 2 + (h)) * HTB)
#define PG8_SB(b, h) ((4 + (b) * 2 + (h)) * HTB)
#define PG8_STAGE(bufoff, gbase, voff) do { _Pragma("unroll") for (int _i = 0; _i < 2; ++_i) \
        __builtin_amdgcn_global_load_lds((const unsigned*)((const char*)(gbase) + (voff)[_i]), (LAS unsigned*)(lds + (bufoff) + ldsw + _i * 8192), 16, 0, 0); } while (0)
#define PG8_LDA(dst, b, h) do { _Pragma("unroll") for (int m = 0; m < 4; ++m) _Pragma("unroll") for (int k = 0; k < 2; ++k) dst[m][k] = *(const LAS bf16x8*)(lds + PG8_SA(b, h) + aoff + m * 2048 + k * 1024); } while (0)
#define PG8_LDB(dst, b, h) do { _Pragma("unroll") for (int n = 0; n < 2; ++n) _Pragma("unroll") for (int k = 0; k < 2; ++k) dst[n][k] = *(const LAS bf16x8*)(lds + PG8_SB(b, h) + boff + n * 2048 + k * 1024); } while (0)
#define PG8_MMA(ai, bj, At, Bt) do { __builtin_amdgcn_s_setprio(1); _Pragma("unroll") for (int m = 0; m < 4; ++m) _Pragma("unroll") for (int n = 0; n < 2; ++n) _Pragma("unroll") for (int k = 0; k < 2; ++k) \
        acc[ai][bj][m][n] = __builtin_amdgcn_mfma_f32_16x16x32_bf16(Bt[n][k], At[m][k], acc[ai][bj][m][n], 0, 0, 0); __builtin_amdgcn_s_setprio(0); } while (0)
#define PG8_WAIT_V(n) asm volatile("s_waitcnt vmcnt(" #n ")" ::: "memory")
#define PG8_WAIT_L(n) asm volatile("s_waitcnt lgkmcnt(" #n ")" ::: "memory")
#define PG8_BAR __builtin_amdgcn_s_barrier()
#define PG8_SCHED __builtin_amdgcn_sched_barrier(0)
    Unit cur, nxt; int ui = 0;
    if (!S.next(0, cur)) return;
    Acc acc;
#pragma unroll
    for (int a = 0; a < 2; ++a)
#pragma unroll
        for (int b = 0; b < 2; ++b)
#pragma unroll
            for (int m = 0; m < 4; ++m)
#pragma unroll
                for (int n = 0; n < 2; ++n) acc[a][b][m][n] = (f32x4){0.f, 0.f, 0.f, 0.f};
    bf16x8 At[4][2], B0[2][2], B1[2][2];
#define PG8_KOFF(u) ((u).ks > 0 ? (size_t)(u).ks * g.KS * 2 : (size_t)0)
#define PG8_NT(u) ((u).ks < 0 ? K / BK : ((K - (u).ks * g.KS) < g.KS ? (K - (u).ks * g.KS) : g.KS) / BK)
#define PG8_APTR(u) ((const char*)g.A + (size_t)(g.amod ? (u).pm % g.amod : (u).pm) * tstepA + PG8_KOFF(u))
#define PG8_BPTR(u) ((const char*)g.Bt + (size_t)(u).pn * tstepB + (g.amod ? (size_t)((u).pm / g.amod) * g.bbatch : (size_t)0) + PG8_KOFF(u))
    const char* cA = PG8_APTR(cur); const char* cB = PG8_BPTR(cur); int nt = PG8_NT(cur);
    PG8_STAGE(PG8_SB(0, 0), cB, voffB); PG8_STAGE(PG8_SA(0, 0), cA, voffA); PG8_STAGE(PG8_SB(0, 1), cB + hstepB, voffB); PG8_STAGE(PG8_SA(0, 1), cA + hstepA, voffA);
    if (wr == 1) PG8_BAR;
    PG8_WAIT_V(4); PG8_BAR;
    PG8_STAGE(PG8_SB(1, 0), cB + kstep, voffB); PG8_STAGE(PG8_SA(1, 0), cA + kstep, voffA); PG8_STAGE(PG8_SB(1, 1), cB + hstepB + kstep, voffB);
    PG8_WAIT_V(6); PG8_BAR;
    for (;;) {
        const bool has_next = S.next(ui + 1, nxt);
        const char* nA = has_next ? PG8_APTR(nxt) : cA; const char* nB = has_next ? PG8_BPTR(nxt) : cB;
        for (int t = 0; t < nt; t += 2) {
            const bool last = (t == nt - 2);
            const char* a1 = cA + (size_t)(t + 1) * kstep;
            const char* a2 = last ? nA : cA + (size_t)(t + 2) * kstep; const char* b2 = last ? nB : cB + (size_t)(t + 2) * kstep;
            const char* a3 = a2 + kstep; const char* b3 = b2 + kstep;
            PG8_LDB(B0, 0, 0); PG8_SCHED; PG8_LDA(At, 0, 0); PG8_STAGE(PG8_SA(1, 1), a1 + hstepA, voffA);
            PG8_WAIT_L(8); PG8_BAR; PG8_WAIT_L(0); PG8_MMA(0, 0, At, B0); PG8_BAR; PG8_SCHED;
            PG8_LDB(B1, 0, 1); PG8_STAGE(PG8_SB(0, 0), b2, voffB);
            PG8_BAR; PG8_WAIT_L(0); PG8_MMA(0, 1, At, B1); PG8_BAR;
            PG8_LDA(At, 0, 1); PG8_STAGE(PG8_SA(0, 0), a2, voffA);
            PG8_BAR; PG8_WAIT_L(0); PG8_MMA(1, 0, At, B0); PG8_BAR; PG8_SCHED;
            PG8_STAGE(PG8_SB(0, 1), b2 + hstepB, voffB);
            PG8_WAIT_V(6); PG8_BAR; PG8_MMA(1, 1, At, B1); PG8_BAR;
            PG8_LDB(B0, 1, 0); PG8_SCHED; PG8_LDA(At, 1, 0); PG8_STAGE(PG8_SA(0, 1), a2 + hstepA, voffA);
            PG8_WAIT_L(8); PG8_BAR; PG8_WAIT_L(0); PG8_MMA(0, 0, At, B0); PG8_BAR; PG8_SCHED;
            PG8_LDB(B1, 1, 1); PG8_STAGE(PG8_SB(1, 0), b3, voffB);
            PG8_BAR; PG8_WAIT_L(0); PG8_MMA(0, 1, At, B1); PG8_BAR;
            PG8_LDA(At, 1, 1); PG8_STAGE(PG8_SA(1, 0), a3, voffA);
            PG8_BAR; PG8_WAIT_L(0); PG8_MMA(1, 0, At, B0); PG8_BAR; PG8_SCHED;
            PG8_STAGE(PG8_SB(1, 1), b3 + hstepB, voffB);
            PG8_WAIT_V(6); PG8_BAR; PG8_MMA(1, 1, At, B1); PG8_BAR;
        }
        E(acc, cur, wr, wc, fr, fq);
        if (!has_next) break;
#pragma unroll
        for (int a = 0; a < 2; ++a)
#pragma unroll
            for (int b = 0; b < 2; ++b)
#pragma unroll
                for (int m = 0; m < 4; ++m)
#pragma unroll
                    for (int n = 0; n < 2; ++n) acc[a][b][m][n] = (f32x4){0.f, 0.f, 0.f, 0.f};
        cur = nxt; cA = nA; cB = nB; ++ui; nt = PG8_NT(cur);
    }
    PG8_WAIT_V(0);
    if (wr == 0) PG8_BAR;
    PG8_BAR;
#undef PG8_SA
#undef PG8_SB
#undef PG8_STAGE
#undef PG8_LDA
#undef PG8_LDB
#undef PG8_MMA
#undef PG8_BAR
#undef PG8_SCHED
#undef PG8_APTR
#undef PG8_KOFF
#undef PG8_NT
#undef PG8_BPTR
}
#define WAIT_V0() asm volatile("s_waitcnt vmcnt(0)" ::: "memory")

#define EPI_LOOP_ROWS for (int ai = 0; ai < 2; ++ai) for (int m = 0; m < 4; ++m)
DEVINL void st_bf4(bf16_t* p, f32x4 v) { u32x2 w; w.x = pk2(v[0], v[1]); w.y = pk2(v[2], v[3]); *(u32x2*)p = w; }

DEVINL void st_bf8(bf16_t* p, f32x4 a, f32x4 b) { u32x4 w; w.x = pk2(a[0], a[1]); w.y = pk2(a[2], a[3]); w.z = pk2(b[0], b[1]); w.w = pk2(b[2], b[3]); *(u32x4*)p = w; }
struct EpiF32 { static constexpr bool PERM = false;
    float* C; int ldc; const float* bias; float* Cs;
    DEVINL void operator()(const Acc& acc, const Unit& u, int wr, int wc, int fr, int fq) const {
        const int row0 = u.pm * BM + wr * 64 + fr, col0 = u.pn * BM + wc * 32 + 4 * fq;
        float* base = u.ks < 0 ? C : Cs + ((long)u.ks * NCTX - NLAT) * 1024;
#pragma unroll
        for (int ai = 0; ai < 2; ++ai)
#pragma unroll
            for (int m = 0; m < 4; ++m) { float* rowp = base + (size_t)(row0 + ai * HALF + m * 16) * ldc + col0;
#pragma unroll
                for (int bj = 0; bj < 2; ++bj)
#pragma unroll
                    for (int n = 0; n < 2; ++n) { f32x4 v = acc[ai][bj][m][n];
                        if (bias) v += *(const f32x4*)(bias + col0 + bj * HALF + n * 16);
                        *(f32x4*)(rowp + bj * HALF + n * 16) = v; } }
    }
};
struct EpiY { static constexpr bool PERM = true;
    bf16_t* Yb; const float* bias; float* Cs;
    DEVINL void operator()(const Acc& acc, const Unit& u, int wr, int wc, int fr, int fq) const {
        const int row0 = u.pm * BM + wr * 64 + fr, col0 = u.pn * BM + wc * 32 + 8 * fq;
        const bool addb = bias != nullptr && u.ks <= 0;
        float* sbase = Cs + ((long)u.ks * NCTX - NLAT) * 1024;
#pragma unroll
        for (int ai = 0; ai < 2; ++ai)
#pragma unroll
            for (int m = 0; m < 4; ++m) { const size_t ro = (size_t)(row0 + ai * HALF + m * 16) * 1024 + col0;
#pragma unroll
                for (int bj = 0; bj < 2; ++bj) { f32x4 v0 = acc[ai][bj][m][0], v1 = acc[ai][bj][m][1];
                    if (addb) { v0 += *(const f32x4*)(bias + col0 + bj * HALF); v1 += *(const f32x4*)(bias + col0 + bj * HALF + 4); }
                    if (u.ks < 0) st_bf8(Yb + ro + bj * HALF, v0, v1); else { *(f32x4*)(sbase + ro + bj * HALF) = v0; *(f32x4*)(sbase + ro + bj * HALF + 4) = v1; } } }
    }
};
struct EpiBf16 { static constexpr bool PERM = true;
    bf16_t* O; int ldc;
    DEVINL void operator()(const Acc& acc, const Unit& u, int wr, int wc, int fr, int fq) const {
        const int row0 = u.pm * BM + wr * 64 + fr, col0 = u.pn * BM + wc * 32 + 8 * fq;
#pragma unroll
        for (int ai = 0; ai < 2; ++ai)
#pragma unroll
            for (int m = 0; m < 4; ++m) { bf16_t* rowp = O + (size_t)(row0 + ai * HALF + m * 16) * ldc + col0;
#pragma unroll
                for (int bj = 0; bj < 2; ++bj) st_bf8(rowp + bj * HALF, acc[ai][bj][m][0], acc[ai][bj][m][1]); }
    }
};
struct EpiSwiGLU { static constexpr bool PERM = true;
    bf16_t* G;
    DEVINL void operator()(const Acc& acc, const Unit& u, int wr, int wc, int fr, int fq) const {
        const int row0 = u.pm * BM + wr * 64 + fr, col0 = u.pn * HALF + wc * 32 + 8 * fq;
#pragma unroll
        for (int ai = 0; ai < 2; ++ai)
#pragma unroll
            for (int m = 0; m < 4; ++m) { bf16_t* rowp = G + (size_t)(row0 + ai * HALF + m * 16) * DFF + col0;
                f32x4 o[2];
#pragma unroll
                for (int n = 0; n < 2; ++n) { const f32x4 gt = acc[ai][0][m][n], up = acc[ai][1][m][n];
#pragma unroll
                    for (int j = 0; j < 4; ++j) o[n][j] = silu_f(gt[j]) * up[j]; }
                st_bf8(rowp, o[0], o[1]); }
    }
};
DEVINL void tok_of_row(int r, int& b, int& tk, bool& lat) { lat = r < NLAT; if (lat) { b = r >> 11; tk = r & 2047; } else { const int rc = r - NLAT; b = rc >> 8; tk = SEQ + (rc & 255); } }
struct EpiUQ { static constexpr bool PERM = false;
    bf16_t* Q; const float* cosT; const float* sinT;
    DEVINL void operator()(const Acc& acc, const Unit& u, int wr, int wc, int fr, int fq) const {
#pragma unroll
        for (int ai = 0; ai < 2; ++ai)
#pragma unroll
            for (int m = 0; m < 4; ++m) { const int r = u.pm * BM + ai * HALF + wr * 64 + m * 16 + fr; int b, tq; bool lat; tok_of_row(r, b, tq, lat);
#pragma unroll
                for (int bj = 0; bj < 2; ++bj) { const int col32 = u.pn * BM + bj * HALF + wc * 32, head = col32 / 192, off = col32 % 192;
                    f32x4 v0 = acc[ai][bj][m][0], v1 = acc[ai][bj][m][1];
                    if (off >= 128 && lat) { const int axis = (off - 128) >> 5, pos = axis == 0 ? (tq >> 6) : (tq & 63);
                        const f32x4 c = *(const f32x4*)(cosT + pos * 16 + fq * 4), s = *(const f32x4*)(sinT + pos * 16 + fq * 4);
                        const f32x4 o0 = v0 * c - v1 * s, o1 = v1 * c + v0 * s; v0 = o0; v1 = o1; }
                    bf16_t* dst = Q + ((size_t)(b * 8 + head) * TKV + tq) * 192 + off + fq * 4;
                    st_bf4(dst, v0); st_bf4(dst + 16, v1); } }
    }
};
struct EpiUKV { static constexpr bool PERM = true;
    bf16_t* Kb; bf16_t* Vb;
    DEVINL void operator()(const Acc& acc, const Unit& u, int wr, int wc, int fr, int fq) const {
#pragma unroll
        for (int ai = 0; ai < 2; ++ai)
#pragma unroll
            for (int m = 0; m < 4; ++m) { const int r = u.pm * BM + ai * HALF + wr * 64 + m * 16 + fr; int b, tk; bool lat; tok_of_row(r, b, tk, lat);
                const size_t tokidx = (size_t)(b * 8 + u.pn) * TKV + tk; const int c = wc * 32 + fq * 8;
                st_bf8(Kb + tokidx * 192 + c, acc[ai][0][m][0], acc[ai][0][m][1]); st_bf8(Vb + tokidx * 128 + c, acc[ai][1][m][0], acc[ai][1][m][1]); }
    }
};
struct EpiDFT1 { static constexpr bool PERM = true;
    bf16_t* P; int shift, rpb, rowbase;
    DEVINL void operator()(const Acc& acc, const Unit& u, int wr, int wc, int fr, int fq) const {
        const int b = u.pm >> shift, tile = u.pm & ((1 << shift) - 1), cs = tile >> (shift - 1), t0 = (tile & ((1 << (shift - 1)) - 1)) * 256;
        const int row0 = rowbase + b * rpb + t0 + wr * 64 + fr, col0 = cs * 1024 + u.pn * BM + wc * 32 + 8 * fq;
#pragma unroll
        for (int ai = 0; ai < 2; ++ai)
#pragma unroll
            for (int m = 0; m < 4; ++m) { bf16_t* rowp = P + (size_t)(row0 + ai * HALF + m * 16) * 2048 + col0;
#pragma unroll
                for (int bj = 0; bj < 2; ++bj) st_bf8(rowp + bj * HALF, acc[ai][bj][m][0], acc[ai][bj][m][1]); }
    }
};
struct EpiRwkv1 { static constexpr bool PERM = true;
    bf16_t* R; bf16_t* A2;
    DEVINL void operator()(const Acc& acc, const Unit& u, int wr, int wc, int fr, int fq) const {
        const int row0 = u.pm * BM + wr * 64 + fr;
#pragma unroll
        for (int ai = 0; ai < 2; ++ai)
#pragma unroll
            for (int m = 0; m < 4; ++m) { const size_t r = (size_t)(row0 + ai * HALF + m * 16);
#pragma unroll
                for (int bj = 0; bj < 2; ++bj) { f32x4 v0 = acc[ai][bj][m][0], v1 = acc[ai][bj][m][1]; const int c = bj * HALF + wc * 32 + fq * 8;
                    if (u.pn < 12) { st_bf8(R + (size_t)(u.pn >> 2) * NTOK * DM + r * DM + (u.pn & 3) * 256 + c, v0, v1); }
                    else if (u.pn == 12) { if (bj == 0) {
#pragma unroll
                            for (int j = 0; j < 4; ++j) { const float e0 = __expf(-2.f * fabsf(v0[j])), t0 = (1.f - e0) / (1.f + e0); v0[j] = v0[j] < 0.f ? -t0 : t0;
                                const float e1 = __expf(-2.f * fabsf(v1[j])), t1 = (1.f - e1) / (1.f + e1); v1[j] = v1[j] < 0.f ? -t1 : t1; } }
                        st_bf8(A2 + r * 512 + c, v0, v1); }
                    else {
#pragma unroll
                        for (int j = 0; j < 4; ++j) { v0[j] = (c + j < 160) ? sigm_f(v0[j]) : 0.f; v1[j] = (c + 4 + j < 160) ? sigm_f(v1[j]) : 0.f; }
                        st_bf8(A2 + r * 512 + 256 + c, v0, v1); } } }
    }
};
template <int mode> struct EpiRwkv2 { static constexpr bool PERM = true;
    bf16_t* O; const float* bias;
    DEVINL void operator()(const Acc& acc, const Unit& u, int wr, int wc, int fr, int fq) const {
        const int row0 = u.pm * BM + wr * 64 + fr, e = u.pn >> 2, d0 = (u.pn & 3) * 256 + wc * 32 + 8 * fq;
#pragma unroll
        for (int ai = 0; ai < 2; ++ai)
#pragma unroll
            for (int m = 0; m < 4; ++m) { bf16_t* rowp = O + (size_t)e * NTOK * DM + (size_t)(row0 + ai * HALF + m * 16) * DM + d0;
#pragma unroll
                for (int bj = 0; bj < 2; ++bj) { const int d = d0 + bj * HALF;
                    st_bf8(rowp + bj * HALF, acc[ai][bj][m][0] + *(const f32x4*)(bias + e * DM + d), acc[ai][bj][m][1] + *(const f32x4*)(bias + e * DM + d + 4)); } }
    }
};

DEVINL void convT(float* tile, const float* src, int ldsrc, int K, int N, bf16_t* dst, int ldd, int drow0, int dcol0, const float* rs, int rdiv, int rmul, int bid = -1, int nb = 0) {
    const int tid = otid(), tK = (K + 63) / 64, tN = (N + 63) / 64;
    if (bid < 0) { bid = obid(); nb = gridDim.x; }
    for (int t = bid; t < tK * tN; t += nb) {
        const int k0 = (t / tN) * 64, n0 = (t % tN) * 64;
        __syncthreads();
#pragma unroll
        for (int p = 0; p < 8; ++p) { const int i = (tid >> 6) + 8 * p, j = tid & 63; float v = 0.f;
            if (k0 + i < K && n0 + j < N) { v = src[(size_t)(k0 + i) * ldsrc + n0 + j]; if (rs) v *= rs[k0 + i]; }
            tile[i * 65 + j] = v; }
        __syncthreads();
#pragma unroll
        for (int p = 0; p < 4; ++p) { const int j = (tid >> 5) + 16 * p, i = (tid & 31) * 2, n = n0 + j;
            if (n < N && k0 + i < K) { const int row = (n / rdiv) * rmul + (n % rdiv) + drow0;
                *(unsigned*)(dst + (size_t)row * ldd + dcol0 + k0 + i) = pk2(tile[i * 65 + j], tile[(i + 1) * 65 + j]); } }
    }
}
DEVINL void zero2d(bf16_t* dst, int ld, int r0, int r1, int c0, int c1, int bid = -1, int nb = 0) {
    const int w = (c1 - c0) / 2, n = (r1 - r0) * w;
    if (bid < 0) { bid = obid(); nb = gridDim.x; }
    for (int i = bid * 512 + otid(); i < n; i += nb * 512) { const int r = r0 + i / w, c = c0 + (i % w) * 2; *(unsigned*)(dst + (size_t)r * ld + c) = 0u; }
}
DEVINL void conv_ffn_w(float* tile, const PV& p, int layer, int w, bf16_t* slot, int bid, int nb) {
    const size_t o = (size_t)(layer * 2 + w) * DM * DFF;
    bf16_t* gu = slot + w * (FFN_WGU + FFN_WD); bf16_t* wd = gu + FFN_WGU;
    convT(tile, p.in(8) + o, DFF, DM, DFF, gu, DM, 0, 0, nullptr, 128, 256, bid, nb);
    convT(tile, p.in(9) + o, DFF, DM, DFF, gu, DM, 128, 0, nullptr, 128, 256, bid, nb);
    convT(tile, p.in(10) + o, DM, DFF, DM, wd, DFF, 0, 0, nullptr, 1 << 30, 0, bid, nb);
}
DEVINL void conv_ffn(float* tile, const PV& p, int layer, bf16_t* slot) { conv_ffn_w(tile, p, layer, 0, slot, obid(), gridDim.x); conv_ffn_w(tile, p, layer, 1, slot, obid(), gridDim.x); }

DEVINL void phase_prep(const PV& p, unsigned char* sm) {
    const int tid = otid(), wid = tid >> 6, lane = tid & 63;
    unsigned char* ws = p.ws;
    float* tile = (float*)sm;
    bf16_t* WM = (bf16_t*)(ws + WS_WM);
    {
        float* sc = (float*)sm; float* part = sc + 9 * 1024;
        for (int i = tid; i < 9 * 1024; i += 512) { const float v = i < 8192 ? p.in(1)[i] : p.in(3)[i - 8192]; sc[i] = silu_f(v); }
        __syncthreads();
        float* MOD = (float*)(ws + WS_MOD);
        for (int it = obid(); it < 4 * 144; it += gridDim.x) {
            const int layer = it / 144, col = (it % 144) * 64 + lane;
            const float* W = p.in(4) + (size_t)layer * DM * MODW + col;
            float a[9];
#pragma unroll
            for (int r = 0; r < 9; ++r) a[r] = 0.f;
            const int kb = wid * 128;
#pragma unroll 16
            for (int k = 0; k < 128; ++k) { const float w = W[(size_t)(kb + k) * MODW];
#pragma unroll
                for (int r = 0; r < 9; ++r) a[r] += sc[r * 1024 + kb + k] * w; }
#pragma unroll
            for (int r = 0; r < 9; ++r) part[(wid * 9 + r) * 64 + lane] = a[r];
            __syncthreads();
            for (int o = tid; o < 9 * 64; o += 512) { const int r = o >> 6, l = o & 63; float s = 0.f;
#pragma unroll
                for (int w = 0; w < 8; ++w) s += part[(w * 9 + r) * 64 + l];
                const int c = (it % 144) * 64 + l;
                MOD[((size_t)layer * 9 + r) * MODW + c] = s + p.in(5)[(size_t)layer * MODW + c]; }
            __syncthreads();
        }
    }
    { float* ct = (float*)(ws + WS_ROPE); float* st = ct + 1024;
      for (int i = obid() * 512 + tid; i < 1024; i += gridDim.x * 512) { const int pos = i >> 4, pp = i & 15;
          const float inv = exp2f(-(float)pp * (13.287712379549449f / 16.f)); const float ang = (float)pos * inv; ct[i] = cosf(ang); st[i] = sinf(ang); } }
    conv_ffn(tile, p, 0, (bf16_t*)(ws + WS_WF));
    for (int j = 0; j < 1; ++j) {
        bf16_t* M = WM + (j ? WM_MLA1 : WM_MLA0);
        convT(tile, p.in(11) + (size_t)j * 1024 * 512, 512, 1024, 512, M + MLA_DQKV, 1024, 0, 0, nullptr, 1 << 30, 0);
        convT(tile, p.in(14) + (size_t)j * 1024 * 320, 320, 1024, 320, M + MLA_DQKV, 1024, 512, 0, nullptr, 1 << 30, 0);
        zero2d(M + MLA_DQKV, 1024, 832, 1024, 0, 1024);
        convT(tile, p.in(13) + (size_t)j * 512 * 1536, 1536, 512, 1536, M + MLA_UQ, 512, 0, 0, nullptr, 1 << 30, 0);
        convT(tile, p.in(16) + (size_t)j * 256 * 2048, 2048, 256, 2048, M + MLA_UKV, 256, 0, 0, nullptr, 1 << 30, 0);
        convT(tile, p.in(17) + (size_t)j * 1024 * 1024, 1024, 1024, 1024, M + MLA_WO, 1024, 0, 0, nullptr, 1 << 30, 0);
    }
    __syncthreads();
}

DEVINL void prep_late(const PV& p, unsigned char* sm, int bid, int nb) {
    const int tid = otid(), wid = tid >> 6, lane = tid & 63;
    unsigned char* ws = p.ws;
    float* tile = (float*)sm;
    bf16_t* WM = (bf16_t*)(ws + WS_WM);
    (void)wid; (void)lane;
    { bf16_t* DT = WM + WM_DT2;
      for (size_t i = (size_t)bid * 512 + tid; i < (size_t)4096 * 1024; i += (size_t)nb * 512) {
          const int row = (int)(i >> 10), t = (int)(i & 1023) * 2, cs = row >> 11, to = row & 2047;
          float v[2];
#pragma unroll
          for (int q = 0; q < 2; ++q) { const int mm = (to * (t + q)) & 2047; const float x = (float)mm * (1.f / 1024.f); v[q] = (cs ? sinpif(x) : cospif(x)) * 0.022097086912079608f; }
          *(unsigned*)(DT + (size_t)row * 2048 + t) = pk2(v[0], v[1]); }
      bf16_t* DC = WM + WM_DT2C;
      for (int i = bid * 512 + tid; i < 512 * 128; i += nb * 512) {
          const int row = i >> 7, t = (i & 127) * 2, cs = row >> 8, to = row & 255;
          float v[2];
#pragma unroll
          for (int q = 0; q < 2; ++q) { const int mm = (to * (t + q)) & 255; const float x = (float)mm * (1.f / 128.f); v[q] = (cs ? sinpif(x) : cospif(x)) * 0.0625f; }
          *(unsigned*)(DC + (size_t)row * 256 + t) = pk2(v[0], v[1]); } }
    {
        __syncthreads();
        float* ctab = (float*)sm; float* stab = ctab + 128; float* wt = ctab + 256;
        if (tid < 128) { const float x = (float)tid * (1.f / 64.f); ctab[tid] = cospif(x) * 0.08838834764831845f; stab[tid] = -sinpif(x) * 0.08838834764831845f; }
        bf16_t* W2 = WM + WM_W2T; const float* wo = p.in(18);
        for (int it = bid; it < 128; it += nb) {
            const int g = it >> 4, n0 = (it & 15) * 64;
            __syncthreads();
            for (int q = tid; q < 128 * 64; q += 512) wt[q] = wo[(size_t)(g * 128 + (q >> 6)) * DM + n0 + (q & 63)];
            __syncthreads();
            const int k = tid & 127, cs = (tid >> 7) & 1, ng = tid >> 8; const float* tab = cs ? stab : ctab;
            float acc[32];
#pragma unroll
            for (int q = 0; q < 32; ++q) acc[q] = 0.f;
            for (int j = 0; j < 128; ++j) { const float t = tab[(k * j) & 127]; const float* wr = wt + j * 64 + ng * 32;
#pragma unroll
                for (int q = 0; q < 32; q += 4) { const f32x4 w4 = *(const f32x4*)(wr + q); acc[q] += t * w4[0]; acc[q + 1] += t * w4[1]; acc[q + 2] += t * w4[2]; acc[q + 3] += t * w4[3]; } }
#pragma unroll
            for (int q = 0; q < 32; ++q) W2[(size_t)(n0 + ng * 32 + q) * 2048 + cs * 1024 + g * 128 + k] = f2bf(acc[q]);
        }
        __syncthreads();
    }
    for (int j = 1; j < 2; ++j) {
        bf16_t* M = WM + (j ? WM_MLA1 : WM_MLA0);
        convT(tile, p.in(11) + (size_t)j * 1024 * 512, 512, 1024, 512, M + MLA_DQKV, 1024, 0, 0, nullptr, 1 << 30, 0, bid, nb);
        convT(tile, p.in(14) + (size_t)j * 1024 * 320, 320, 1024, 320, M + MLA_DQKV, 1024, 512, 0, nullptr, 1 << 30, 0, bid, nb);
        zero2d(M + MLA_DQKV, 1024, 832, 1024, 0, 1024, bid, nb);
        convT(tile, p.in(13) + (size_t)j * 512 * 1536, 1536, 512, 1536, M + MLA_UQ, 512, 0, 0, nullptr, 1 << 30, 0, bid, nb);
        convT(tile, p.in(16) + (size_t)j * 256 * 2048, 2048, 256, 2048, M + MLA_UKV, 256, 0, 0, nullptr, 1 << 30, 0, bid, nb);
        convT(tile, p.in(17) + (size_t)j * 1024 * 1024, 1024, 1024, 1024, M + MLA_WO, 1024, 0, 0, nullptr, 1 << 30, 0, bid, nb);
    }
    {
        bf16_t* WC = WM + WM_WCAT; const float* mix = p.in(20);
        for (int h = 0; h < 2; ++h) { const int dc = h * 1024;
            convT(tile, p.in(21), 1024, 1024, 1024, WC, 2048, 0, dc, h ? mix + 0 * 1024 : nullptr, 1 << 30, 0, bid, nb);
            convT(tile, p.in(22), 1024, 1024, 1024, WC, 2048, 1024, dc, h ? mix + 2 * 1024 : nullptr, 1 << 30, 0, bid, nb);
            convT(tile, p.in(23), 1024, 1024, 1024, WC, 2048, 2048, dc, h ? mix + 3 * 1024 : nullptr, 1 << 30, 0, bid, nb);
            for (int e = 0; e < 2; ++e) {
                convT(tile, p.in(25) + (size_t)e * 1024 * 64, 64, 1024, 64, WC, 2048, 3072 + e * 64, dc, h ? mix + 1 * 1024 : nullptr, 1 << 30, 0, bid, nb);
                convT(tile, p.in(28) + (size_t)e * 1024 * 64, 64, 1024, 64, WC, 2048, 3200 + e * 64, dc, h ? mix + 4 * 1024 : nullptr, 1 << 30, 0, bid, nb); }
            convT(tile, p.in(30), 160, 1024, 160, WC, 2048, 3328, dc, h ? mix + 5 * 1024 : nullptr, 1 << 30, 0, bid, nb); }
        zero2d(WC, 2048, 3488, 3584, 0, 2048, bid, nb);
        bf16_t* BW = WM + WM_BW; bf16_t* BA = WM + WM_BA; bf16_t* BG = WM + WM_BG;
        for (int e = 0; e < 2; ++e) {
            convT(tile, p.in(26) + (size_t)e * 64 * 1024, 1024, 64, 1024, BW, 256, e * 1024, e * 64, nullptr, 1 << 30, 0, bid, nb);
            convT(tile, p.in(29) + (size_t)e * 64 * 1024, 1024, 64, 1024, BA, 256, e * 1024, 128 + e * 64, nullptr, 1 << 30, 0, bid, nb);
            zero2d(BW, 256, e * 1024, e * 1024 + 1024, (1 - e) * 64, (1 - e) * 64 + 64, bid, nb); zero2d(BW, 256, e * 1024, e * 1024 + 1024, 128, 256, bid, nb);
            zero2d(BA, 256, e * 1024, e * 1024 + 1024, 128 + (1 - e) * 64, 128 + (1 - e) * 64 + 64, bid, nb); zero2d(BA, 256, e * 1024, e * 1024 + 1024, 0, 128, bid, nb); }
        convT(tile, p.in(31), 1024, 160, 1024, BG, 256, 0, 0, nullptr, 1 << 30, 0, bid, nb);
        zero2d(BG, 256, 0, 1024, 160, 256, bid, nb);
        convT(tile, p.in(37), 1024, 1024, 1024, WM + WM_RWO, 1024, 0, 0, nullptr, 1 << 30, 0, bid, nb);
    }
    __syncthreads();
}

struct RowArgs {
    const float* hin_l; const float* hin_c; float* hout_l; float* hout_c;
    const float* Y; const float* modp; int subp; const float* gpost; float coef;
    const float* modn; int subn; const float* gpre;
    bf16_t* xn; int xn_ld; int nrows; int upd_ctx; const float* Ys; int nslab;
    int pad_;
};
struct RowIn { f32x4 h[4], y[4]; };
DEVINL void row_load(const RowArgs& a, int r, int lane, RowIn& v) {
    const bool lat = r < NLAT; const int rc = r - NLAT;
    const float* hin = lat ? a.hin_l + (size_t)r * DM : a.hin_c + (size_t)rc * DM;
#pragma unroll
    for (int i = 0; i < 4; ++i) v.h[i] = *(const f32x4*)(hin + i * 256 + lane * 4);
    if (a.Y != nullptr && (lat || a.upd_ctx)) {
        if (lat || a.nslab == 0) {
#pragma unroll
            for (int i = 0; i < 4; ++i) { const u32x2 w = *(const u32x2*)((const bf16_t*)a.Y + (size_t)r * DM + i * 256 + lane * 4); v.y[i] = (f32x4){lo_bf(w.x), hi_bf(w.x), lo_bf(w.y), hi_bf(w.y)}; }
        } else {
#pragma unroll
            for (int i = 0; i < 4; ++i) v.y[i] = *(const f32x4*)(a.Ys + (size_t)rc * DM + i * 256 + lane * 4);
            for (int sl = 1; sl < a.nslab; ++sl) {
#pragma unroll
                for (int i = 0; i < 4; ++i) v.y[i] += *(const f32x4*)(a.Ys + ((size_t)sl * NCTX + rc) * DM + i * 256 + lane * 4); }
        }
    }
}
DEVINL void row_math(const RowArgs& a, int r, int lane, RowIn& v, f32x4 (&xo)[4]) {
    const bool lat = r < NLAT; const int rc = r - NLAT; const int mrow = lat ? (r >> 11) : 8;
    const float* hin = lat ? a.hin_l + (size_t)r * DM : a.hin_c + (size_t)rc * DM;
    float* hout = lat ? a.hout_l + (size_t)r * DM : a.hout_c + (size_t)rc * DM;
    const bool upd = a.Y != nullptr && (lat || a.upd_ctx);
    if (upd) {
        float ss = 0.f;
#pragma unroll
        for (int i = 0; i < 4; ++i)
#pragma unroll
            for (int j = 0; j < 4; ++j) ss += v.y[i][j] * v.y[i][j];
        ss = wave_sum_dpp(ss); const float rs = rsqrtf(ss * (1.f / 1024.f) + EPS) * a.coef;
        const float* gate = a.modp + (size_t)mrow * MODW + (a.subp * 3 + 2) * 1024;
#pragma unroll
        for (int i = 0; i < 4; ++i) { const int c = i * 256 + lane * 4; const f32x4 gt = *(const f32x4*)(gate + c), gp = *(const f32x4*)(a.gpost + c);
            v.h[i] += gt * (v.y[i] * gp) * rs; }
    }
    if (upd || hin != hout) {
#pragma unroll
        for (int i = 0; i < 4; ++i) *(f32x4*)(hout + i * 256 + lane * 4) = v.h[i];
    }
    if (a.modn) {
        float ss = 0.f;
#pragma unroll
        for (int i = 0; i < 4; ++i)
#pragma unroll
            for (int j = 0; j < 4; ++j) ss += v.h[i][j] * v.h[i][j];
        ss = wave_sum_dpp(ss); const float rs = rsqrtf(ss * (1.f / 1024.f) + EPS);
        const float* sh = a.modn + (size_t)mrow * MODW + (a.subn * 3 + 0) * 1024; const float* scl = sh + 1024;
#pragma unroll
        for (int i = 0; i < 4; ++i) { const int c = i * 256 + lane * 4; const f32x4 g = *(const f32x4*)(a.gpre + c), s1 = *(const f32x4*)(scl + c), s0 = *(const f32x4*)(sh + c);
            xo[i] = (v.h[i] * rs * g) * (s1 + 1.f) + s0; }
    }
}
DEVINL void row_core(const RowArgs& a, int r, int lane, f32x4 (&xo)[4]) { RowIn v; row_load(a, r, lane, v); row_math(a, r, lane, v, xo); }
DEVINL void phase_rows(const RowArgs& a) {
    const int lane = otid() & 63, gw = obid() * 8 + (otid() >> 6), nw = gridDim.x * 8;
    RowIn cur, n1, n2;
    if (gw < a.nrows) row_load(a, gw, lane, cur);
    if (gw + nw < a.nrows) row_load(a, gw + nw, lane, n1);
    for (int r = gw; r < a.nrows; r += nw) {
        if (r + 2 * nw < a.nrows) row_load(a, r + 2 * nw, lane, n2);
        f32x4 xo[4]; row_math(a, r, lane, cur, xo);
        if (a.modn) {
#pragma unroll
            for (int i = 0; i < 4; ++i) st_bf4(a.xn + (size_t)r * a.xn_ld + i * 256 + lane * 4, xo[i]);
        }
        cur = n1; n1 = n2;
    }
}
DEVINL void phase_rows_T(const RowArgs& a, unsigned char* sm, bf16_t* XT, bf16_t* XTc) {
    const int tid = otid(), wid = tid >> 6, lane = tid & 63;
    constexpr int RS = 2052;
    for (int tl = obid(); tl < NTOK / 64; tl += gridDim.x) {
        __syncthreads();
        RowIn cur, nxt; row_load(a, tl * 64 + wid * 8, lane, cur);
        for (int q = 0; q < 8; ++q) { const int lr = wid * 8 + q, r = tl * 64 + lr; f32x4 xo[4];
            if (q < 7) row_load(a, r + 1, lane, nxt);
            row_math(a, r, lane, cur, xo); cur = nxt;
#pragma unroll
            for (int i = 0; i < 4; ++i) { u32x2 w; w.x = pk2(xo[i][0], xo[i][1]); w.y = pk2(xo[i][2], xo[i][3]);
                unsigned* dp = (unsigned*)(sm + lr * RS + (i * 256 + lane * 4) * 2); dp[0] = w.x; dp[1] = w.y; } }
        __syncthreads();
        const int r0 = tl * 64; const bool lat = r0 < NLAT; const int b = lat ? (r0 >> 11) : ((r0 - NLAT) >> 8), t0 = lat ? (r0 & 2047) : ((r0 - NLAT) & 255), T = lat ? 2048 : 256;
        bf16_t* dstb = (lat ? XT : XTc) + (size_t)b * 1024 * T + t0;
        for (int it = tid; it < 1024 * 8; it += 512) { const int d = it >> 3, tc = it & 7; unsigned w[4];
#pragma unroll
            for (int q = 0; q < 4; ++q) { const unsigned lo = *(const bf16_t*)(sm + (tc * 8 + q * 2) * RS + d * 2), hi = *(const bf16_t*)(sm + (tc * 8 + q * 2 + 1) * RS + d * 2); w[q] = lo | (hi << 16); }
            *(u32x4*)(dstb + (size_t)d * T + tc * 8) = (u32x4){w[0], w[1], w[2], w[3]}; }
    }
    __syncthreads();
}

DEVINL void phase_mla_norm(const PV& p, int j, const float* raw, bf16_t* QN, bf16_t* CKVN, bf16_t* Kb) {
    const int lane = otid() & 63, gw = obid() * 8 + (otid() >> 6), nw = gridDim.x * 8;
    const float* qg = p.in(12) + j * 512; const float* kg = p.in(15) + j * 256;
    const float* ct = (const float*)(p.ws + WS_ROPE); const float* st = ct + 1024;
    f32x4 nq0 = {0.f, 0.f, 0.f, 0.f}, nq1 = nq0, nkv = nq0; float nkp = 0.f;
    if (gw < NTOK) { const float* row = raw + (size_t)gw * 1024; nq0 = *(const f32x4*)(row + lane * 4); nq1 = *(const f32x4*)(row + 256 + lane * 4); nkv = *(const f32x4*)(row + 512 + lane * 4); nkp = row[768 + lane]; }
    for (int r = gw; r < NTOK; r += nw) {
        f32x4 q0 = nq0, q1 = nq1, kv = nkv; const float kp = nkp;
        if (r + nw < NTOK) { const float* row = raw + (size_t)(r + nw) * 1024; nq0 = *(const f32x4*)(row + lane * 4); nq1 = *(const f32x4*)(row + 256 + lane * 4); nkv = *(const f32x4*)(row + 512 + lane * 4); nkp = row[768 + lane]; }
        float sq = 0.f, sk = 0.f;
#pragma unroll
        for (int i = 0; i < 4; ++i) { sq += q0[i] * q0[i] + q1[i] * q1[i]; sk += kv[i] * kv[i]; }
        sq = wave_sum_dpp(sq); sk = wave_sum_dpp(sk);
        const float rq = rsqrtf(sq * (1.f / 512.f) + EPS), rk = rsqrtf(sk * (1.f / 256.f) + EPS);
        st_bf4(QN + (size_t)r * 512 + lane * 4, q0 * rq * *(const f32x4*)(qg + lane * 4));
        st_bf4(QN + (size_t)r * 512 + 256 + lane * 4, q1 * rq * *(const f32x4*)(qg + 256 + lane * 4));
        st_bf4(CKVN + (size_t)r * 256 + lane * 4, kv * rk * *(const f32x4*)(kg + lane * 4));
        int b, tk; bool lat; tok_of_row(r, b, tk, lat);
        const float other = __shfl_xor(kp, 16); float o = kp;
        if (lat) { const int axis = lane >> 5, half = (lane >> 4) & 1, pp = lane & 15, pos = axis == 0 ? (tk >> 6) : (tk & 63);
            const float c = ct[pos * 16 + pp], s = st[pos * 16 + pp];
            o = half == 0 ? kp * c - other * s : kp * c + other * s; }
        const bf16_t ob = f2bf(o);
#pragma unroll
        for (int h = 0; h < 8; ++h) Kb[((size_t)(b * 8 + h) * TKV + tk) * 192 + 128 + lane] = ob;
    }
}

constexpr int QBLK = 32, KVBLK = 64, NW = 8;
constexpr float ATT_SCALE = 0.07216878364870322f;
constexpr float ATT_THR = 8.f;
constexpr size_t SHM_V = KVBLK * 128 * 2, SHM_K = KVBLK * 192 * 2;
#define KSWZ(row, colB) ((row) * 384 + ((colB) ^ ((((row) >> 1) & 7) << 4)))
#define SBAR() __builtin_amdgcn_sched_barrier(0)
DEVINL int crow(int r, int hi) { return (r & 3) + 8 * (r >> 2) + 4 * hi; }
DEVINL void partialSM(f32x16& p0, f32x16& p1, float& m_reg, float& mn, float& alpha) {
    constexpr float C = ATT_SCALE * 1.4426950408889634f;
    float pmax = p0[0];
#pragma unroll
    for (int r = 1; r < 16; ++r) pmax = fmaxf(pmax, p0[r]);
#pragma unroll
    for (int r = 0; r < 16; ++r) pmax = fmaxf(pmax, p1[r]);
    { auto rr = __builtin_amdgcn_permlane32_swap(__float_as_uint(pmax), __float_as_uint(pmax), false, false);
      pmax = fmaxf(__uint_as_float(rr[0]), __uint_as_float(rr[1])); }
    if (__builtin_expect(__all(pmax - m_reg <= ATT_THR / ATT_SCALE), 1)) { mn = m_reg; alpha = 1.f; }
    else { mn = fmaxf(m_reg, pmax); alpha = __builtin_amdgcn_exp2f((m_reg - mn) * C); m_reg = mn; }
    const float mnC = -mn * C;
#pragma unroll
    for (int r = 0; r < 16; ++r) p0[r] = fmaf(p0[r], C, mnC);
#pragma unroll
    for (int r = 0; r < 16; ++r) p1[r] = fmaf(p1[r], C, mnC);
#pragma unroll
    for (int r = 0; r < 16; ++r) p0[r] = __builtin_amdgcn_exp2f(p0[r]);
}
DEVINL void finishSM(f32x16& p0, f32x16& p1, float alpha, float& l_reg, bf16x8& pa0, bf16x8& pa1, bf16x8& pa2, bf16x8& pa3) {
#pragma unroll
    for (int r = 0; r < 16; ++r) p1[r] = __builtin_amdgcn_exp2f(p1[r]);
    float ps = 0;
#pragma unroll
    for (int r = 0; r < 16; ++r) ps += p0[r];
#pragma unroll
    for (int r = 0; r < 16; ++r) ps += p1[r];
    { auto rr = __builtin_amdgcn_permlane32_swap(__float_as_uint(ps), __float_as_uint(ps), false, false);
      ps = __uint_as_float(rr[0]) + __uint_as_float(rr[1]); }
    l_reg = l_reg * alpha + ps;
#define PK4(P, BASE, OUT) do { unsigned a0 = pk2(P[BASE + 0], P[BASE + 1]), a1 = pk2(P[BASE + 2], P[BASE + 3]);   \
    unsigned b0 = pk2(P[BASE + 4], P[BASE + 5]), b1 = pk2(P[BASE + 6], P[BASE + 7]);                              \
    auto r0 = __builtin_amdgcn_permlane32_swap(a0, b0, false, false); auto r1 = __builtin_amdgcn_permlane32_swap(a1, b1, false, false); \
    u32x4 w = {r0[0], r1[0], r0[1], r1[1]}; OUT = *reinterpret_cast<bf16x8*>(&w); } while (0)
    PK4(p0, 0, pa0); PK4(p0, 8, pa1); PK4(p1, 0, pa2); PK4(p1, 8, pa3);
#undef PK4
}
DEVINL void qkt(f32x16& p0, f32x16& p1, const char* Ks, const bf16x8* qr, const char* qpe, int qsw, int r32, int hi) {
    p0 = f32x16{}; p1 = f32x16{};
#pragma unroll
    for (int d0 = 0; d0 < 12; ++d0) { const int cb = (d0 * 16 + hi * 8) * 2;
        const bf16x8 b0 = *reinterpret_cast<const bf16x8*>(Ks + KSWZ(r32, cb));
        const bf16x8 b1 = *reinterpret_cast<const bf16x8*>(Ks + KSWZ(32 + r32, cb));
        const bf16x8 q = d0 < 8 ? qr[d0 < 8 ? d0 : 0] : *reinterpret_cast<const bf16x8*>(qpe + (((((d0 - 8) * 2 + hi) ^ qsw) & 7) << 4));
        p0 = __builtin_amdgcn_mfma_f32_32x32x16_bf16(b0, q, p0, 0, 0, 0);
        p1 = __builtin_amdgcn_mfma_f32_32x32x16_bf16(b1, q, p1, 0, 0, 0); }
}
DEVINL int v_st(int k, int c) { const int kk = (k & ~0xC) | ((k & 4) << 1) | ((k & 8) >> 1); return ((kk >> 3) * 4 + (c >> 5)) * 512 + ((kk & 7) * 32 + (c & 31)) * 2; }
DEVINL int v_rd_base(int lane) { return ((lane & 3) << 3) | (((lane >> 2) & 3) << 6) | (((lane >> 4) & 1) << 5) | (((lane >> 5) & 1) << 8); }
constexpr int v_rd_off(int d0, int ks, int half) { return d0 * 512 + ks * 4096 + half * 2048; }
template <int OFF> DEVINL s16x4 tr_read(int vb) { s16x4 r; asm volatile("ds_read_b64_tr_b16 %0, %1 offset:%2" : "=&v"(r) : "v"(vb), "i"(OFF) : "memory"); return r; }
template <int D0> DEVINL void pv_one(f32x16& od, int vb, bf16x8 pa0, bf16x8 pa1, bf16x8 pa2, bf16x8 pa3) {
    const s16x4 l0 = tr_read<v_rd_off(D0, 0, 0)>(vb), h0 = tr_read<v_rd_off(D0, 0, 1)>(vb), l1 = tr_read<v_rd_off(D0, 1, 0)>(vb), h1 = tr_read<v_rd_off(D0, 1, 1)>(vb);
    const s16x4 l2 = tr_read<v_rd_off(D0, 2, 0)>(vb), h2 = tr_read<v_rd_off(D0, 2, 1)>(vb), l3 = tr_read<v_rd_off(D0, 3, 0)>(vb), h3 = tr_read<v_rd_off(D0, 3, 1)>(vb);
    asm volatile("s_waitcnt lgkmcnt(0)" ::: "memory"); SBAR();
#define PK(L, H) (bf16x8){L[0], L[1], L[2], L[3], H[0], H[1], H[2], H[3]}
    od = __builtin_amdgcn_mfma_f32_32x32x16_bf16(pa0, PK(l0, h0), od, 0, 0, 0);
    od = __builtin_amdgcn_mfma_f32_32x32x16_bf16(pa1, PK(l1, h1), od, 0, 0, 0);
    od = __builtin_amdgcn_mfma_f32_32x32x16_bf16(pa2, PK(l2, h2), od, 0, 0, 0);
    od = __builtin_amdgcn_mfma_f32_32x32x16_bf16(pa3, PK(l3, h3), od, 0, 0, 0);
#undef PK
}
DEVINL void pv_d0(f32x16* o, int vb, bf16x8 pa0, bf16x8 pa1, bf16x8 pa2, bf16x8 pa3) {
    pv_one<0>(o[0], vb, pa0, pa1, pa2, pa3); pv_one<1>(o[1], vb, pa0, pa1, pa2, pa3); pv_one<2>(o[2], vb, pa0, pa1, pa2, pa3); pv_one<3>(o[3], vb, pa0, pa1, pa2, pa3);
}
DEVINL void attn_body(const bf16_t* __restrict__ Qb, const bf16_t* __restrict__ Kh, const bf16_t* __restrict__ Vh, bf16_t* __restrict__ Ob, int seq, char* lds) {
    const int tid = otid(), wid = tid >> 6, lane = tid & 63, r32 = lane & 31, hi = lane >> 5;
    char* V_lds = lds; char* K_lds = lds + 2 * SHM_V;
    float* wsm = (float*)(lds + 2 * SHM_V + 2 * SHM_K) + wid * 64; float* li_l = wsm; float* al_l = wsm + 32;
    float m_reg = -1e30f, l_reg = 0; f32x16 o[4] = {}; bf16x8 qr[8];
    const bf16_t* Qw = Qb + (long)(wid * QBLK + r32) * 192 + hi * 8;
    char* qpe = lds + 2 * SHM_V + 2 * SHM_K + 2048 + wid * 4096 + r32 * 128; const int qsw = (r32 >> 1) & 7;
#pragma unroll
    for (int d0 = 0; d0 < 8; ++d0) qr[d0] = *reinterpret_cast<const bf16x8*>(Qw + d0 * 16);
#pragma unroll
    for (int d0 = 8; d0 < 12; ++d0) *reinterpret_cast<bf16x8*>(qpe + (((((d0 - 8) * 2 + hi) ^ qsw) & 7) << 4)) = *reinterpret_cast<const bf16x8*>(Qw + d0 * 16);
    const int sr = tid >> 4, sc = (tid & 15) * 8, vst0 = v_st(sr, sc), vst1 = v_st(32 + sr, sc);
    int kst[3];
#pragma unroll
    for (int i = 0; i < 3; ++i) { const int id = tid + 512 * i, row = id / 24, ch = id % 24; kst[i] = KSWZ(row, ch * 16); }
    const int vb0 = (int)(uintptr_t)V_lds + v_rd_base(lane);
    bf16x8 vs0, vs1, ks0, ks1, ks2;
#define SLOAD(k0) do { vs0 = *reinterpret_cast<const bf16x8*>(&Vh[(long)((k0) + sr) * 128 + sc]); vs1 = *reinterpret_cast<const bf16x8*>(&Vh[(long)((k0) + 32 + sr) * 128 + sc]); \
    const bf16_t* kp_ = Kh + (long)(k0) * 192 + tid * 8; ks0 = *reinterpret_cast<const bf16x8*>(kp_); ks1 = *reinterpret_cast<const bf16x8*>(kp_ + 4096); ks2 = *reinterpret_cast<const bf16x8*>(kp_ + 8192); } while (0)
#define SWRITE(b) do { *(bf16x8*)(V_lds + (b) * SHM_V + vst0) = vs0; *(bf16x8*)(V_lds + (b) * SHM_V + vst1) = vs1; \
    *(bf16x8*)(K_lds + (b) * SHM_K + kst[0]) = ks0; *(bf16x8*)(K_lds + (b) * SHM_K + kst[1]) = ks1; *(bf16x8*)(K_lds + (b) * SHM_K + kst[2]) = ks2; } while (0)
#define RESC(a) do { if (__any((a) < 1.f)) { if (hi == 0) al_l[r32] = (a); asm volatile("s_waitcnt lgkmcnt(0)" ::: "memory"); \
    _Pragma("unroll") for (int d = 0; d < 4; ++d) _Pragma("unroll") for (int r = 0; r < 16; ++r) o[d][r] *= al_l[crow(r, hi)]; } } while (0)
    f32x16 pA0, pA1, pB0, pB1; float mnA, mnB, alA, alB; bf16x8 pa0, pa1, pa2, pa3; const int NT = seq / KVBLK;
    __syncthreads();
    SLOAD(0); WAIT_V0(); SWRITE(0); __syncthreads();
    qkt(pA0, pA1, K_lds, qr, qpe, qsw, r32, hi); partialSM(pA0, pA1, m_reg, mnA, alA);
    SLOAD(KVBLK);
    WAIT_V0(); SWRITE(1); __syncthreads();
    for (int j = 1; j + 1 < NT; j += 2) {
        SBAR(); qkt(pB0, pB1, K_lds + SHM_K, qr, qpe, qsw, r32, hi);
        finishSM(pA0, pA1, alA, l_reg, pa0, pa1, pa2, pa3); SBAR();
        SLOAD((j + 1) * KVBLK); SBAR();
        pv_d0(o, vb0, pa0, pa1, pa2, pa3); partialSM(pB0, pB1, m_reg, mnB, alB);
        __syncthreads(); WAIT_V0(); SWRITE(0);
        RESC(alB); __syncthreads();
        SBAR(); qkt(pA0, pA1, K_lds, qr, qpe, qsw, r32, hi);
        finishSM(pB0, pB1, alB, l_reg, pa0, pa1, pa2, pa3); SBAR();
        SLOAD((j + 2) * KVBLK); SBAR();
        pv_d0(o, vb0 + (int)SHM_V, pa0, pa1, pa2, pa3); partialSM(pA0, pA1, m_reg, mnA, alA);
        __syncthreads(); WAIT_V0(); SWRITE(1);
        RESC(alA); __syncthreads();
    }
    SBAR(); qkt(pB0, pB1, K_lds + SHM_K, qr, qpe, qsw, r32, hi);
    finishSM(pA0, pA1, alA, l_reg, pa0, pa1, pa2, pa3); SBAR();
    pv_d0(o, vb0, pa0, pa1, pa2, pa3); partialSM(pB0, pB1, m_reg, mnB, alB);
    __syncthreads(); RESC(alB);
    finishSM(pB0, pB1, alB, l_reg, pa0, pa1, pa2, pa3); SBAR();
    pv_d0(o, vb0 + (int)SHM_V, pa0, pa1, pa2, pa3);
    if (hi == 0) li_l[r32] = l_reg; asm volatile("s_waitcnt lgkmcnt(0)" ::: "memory");
    float rli[16];
#pragma unroll
    for (int r = 0; r < 16; ++r) rli[r] = __builtin_amdgcn_rcpf(li_l[crow(r, hi)]);
    bf16_t* Ow = Ob + (long)(wid * QBLK) * 1024;
#pragma unroll
    for (int r = 0; r < 16; ++r) { const int orow = crow(r, hi);
#pragma unroll
        for (int d0 = 0; d0 < 4; ++d0) Ow[(long)orow * 1024 + d0 * 32 + r32] = f2bf(o[d0][r] * rli[r]); }
#undef SLOAD
#undef SWRITE
#undef RESC
}
DEVINL void phase_attn(const bf16_t* Q, const bf16_t* K, const bf16_t* V, bf16_t* O, bool with_ctx, char* lds) {
    const int nu = 512 + (with_ctx ? 64 : 0);
    for (int u = obid(); u < nu; u += gridDim.x) {
        if (u < 512) {
            int bh = u >> 3, qb = u & 7;
            if (gridDim.x == 256) { const int x = u & 7, l = (u >> 8) * 32 + ((u & 255) >> 3); bh = x * 8 + (l >> 3); qb = l & 7; }
            const int b = bh >> 3, h = bh & 7;
            attn_body(Q + ((size_t)bh * TKV + qb * 256) * 192, K + (size_t)bh * TKV * 192, V + (size_t)bh * TKV * 128, O + ((size_t)(b * SEQ + qb * 256)) * 1024 + h * 128, TKV, lds); }
        else { const int bh = u - 512, b = bh >> 3, h = bh & 7;
            attn_body(Q + ((size_t)bh * TKV + SEQ) * 192, K + ((size_t)bh * TKV + SEQ) * 192, V + ((size_t)bh * TKV + SEQ) * 128, O + ((size_t)(NLAT + b * CTX)) * 1024 + h * 128, CTX, lds); }
    }
    __syncthreads();
}

DEVINL void phase_rwkv_shift(bf16_t* XN) {
    for (size_t it = (size_t)obid() * 512 + otid(); it < (size_t)NTOK * 128; it += (size_t)gridDim.x * 512) {
        const int r = (int)(it >> 7), c = (int)(it & 127) * 8; int b, tk; bool lat; tok_of_row(r, b, tk, lat);
        const int t = lat ? tk : tk - SEQ, T = lat ? SEQ : CTX;
        const bf16_t* up = XN + (size_t)r * 2048 + c;
        const u32x4 u0 = *(const u32x4*)up; u32x4 um = {0, 0, 0, 0}, upl = {0, 0, 0, 0};
        if (t > 0) um = *(const u32x4*)(up - 2048);
        if (t < T - 1) upl = *(const u32x4*)(up + 2048);
        u32x4 o;
#pragma unroll
        for (int q = 0; q < 4; ++q) { const float a = 0.5f * (lo_bf(um[q]) + lo_bf(upl[q])) - lo_bf(u0[q]), bq = 0.5f * (hi_bf(um[q]) + hi_bf(upl[q])) - hi_bf(u0[q]); o[q] = pk2(a, bq); }
        *(u32x4*)(XN + (size_t)r * 2048 + 1024 + c) = o;
    }
}
DEVINL void zero_f32(float* p, size_t n4) { for (size_t i = (size_t)obid() * 512 + otid(); i < n4; i += (size_t)gridDim.x * 512) ((f32x4*)p)[i] = (f32x4){0.f, 0.f, 0.f, 0.f}; }

DEVINL float red8(float v) {
    v += __builtin_bit_cast(float, __builtin_amdgcn_update_dpp(0, __builtin_bit_cast(int, v), 0xB1, 0xF, 0xF, false));
    v += __builtin_bit_cast(float, __builtin_amdgcn_update_dpp(0, __builtin_bit_cast(int, v), 0x4E, 0xF, 0xF, false));
    v += __builtin_bit_cast(float, __builtin_amdgcn_update_dpp(0, __builtin_bit_cast(int, v), 0x141, 0xF, 0xF, false));
    return v;
}
typedef float f32x2 __attribute__((ext_vector_type(2)));
struct StepOps { f32x4 a0, a1, q0, q1, w0, w1, b0, b1, k0, k1; float viA, viB; f32x2 sc2; };
DEVINL void phase_scan(const PV& p, const bf16_t* R, const bf16_t* Kf, const bf16_t* Vf, const bf16_t* AA, const bf16_t* LW, float* Y0, bf16_t* Y1, unsigned char* sm) {
    constexpr int TC = 32, NCH = (CTX + SEQ) / TC;
    const int tid = otid(), wid = __builtin_amdgcn_readfirstlane(tid >> 6), lane = tid & 63;
    float* Fb = (float*)sm;
    float* ybb = Fb + 2 * TC * 384;
    float* sclb = ybb + 2 * TC * 64;
    const float* kkp = p.in(32); const float* kap = p.in(33);
    for (int it = obid(); it < 256; it += gridDim.x) {
        const int e = it >> 7, b = (it >> 4) & 7, h = it & 15, ch = h * 64 + lane;
        __syncthreads();
        if (wid >= 4) {
            const int hw = wid - 4;
            const float k_k = kkp[ch], k_a = kap[ch];
            const bf16_t* Ae = AA + (size_t)e * NTOK * DM; const bf16_t* Le = LW + (size_t)e * NTOK * DM;
            bf16_t pr[8], pk[8], pv[8], pa[8], pl[8];
#define SC_ROW(c_, s_) ({ const int g_ = (c_) * TC + (s_); const bool cx_ = g_ < CTX; const int sl_ = cx_ ? g_ : g_ - CTX, T_ = cx_ ? CTX : SEQ; \
            (cx_ ? NLAT + b * CTX : b * SEQ) + (e == 0 ? sl_ : T_ - 1 - sl_); })
#define SC_LOAD(c_) do { _Pragma("unroll") for (int q = 0; q < 8; ++q) { const size_t o_ = (size_t)SC_ROW(c_, hw + 4 * q) * DM + ch; \
            pr[q] = R[o_]; pk[q] = Kf[o_]; pv[q] = Vf[o_]; pa[q] = Ae[o_]; pl[q] = Le[o_]; } } while (0)
#define SC_DERIVE(c_) do { float* F_ = Fb + ((c_) & 1) * TC * 384; float* scl_ = sclb + ((c_) & 1) * TC * 2; _Pragma("unroll") for (int q = 0; q < 8; ++q) { const int s = hw + 4 * q; \
            const float r = bf2f(pr[q]), k = bf2f(pk[q]), v = bf2f(pv[q]), a = sigm_f(bf2f(pa[q])), nx = -bf2f(pl[q]); \
            const float sp = fmaxf(nx, 0.f) + __logf(1.f + __expf(-fabsf(nx))), w = __expf(-__expf(-sp - 0.5f)); \
            const float kv = k * k_k; const float n2 = wave_sum_dpp(kv * kv); const float kk = kv * __builtin_amdgcn_rsqf(fmaxf(n2, 1e-24f)); \
            const float bb = kk * a, kd = k * (1.f + (a - 1.f) * k_a); \
            const float br = wave_sum_dpp(bb * r), kr = wave_sum_dpp(kd * r); \
            float* f = F_ + s * 384 + lane; \
            f[0] = -kk; f[64] = bb; f[128] = w; f[192] = kd; f[256] = w * r; f[320] = v; \
            if (lane == 0) { scl_[s * 2] = br; scl_[s * 2 + 1] = kr; } } } while (0)
#define SC_FLUSH(c_) do { const float* yb_ = ybb + ((c_) & 1) * TC * 64; _Pragma("unroll") for (int q = 0; q < 8; ++q) { const int s = hw + 4 * q; const size_t o_ = (size_t)SC_ROW(c_, s) * DM + ch; \
            const float yv = yb_[s * 64 + lane]; if (e == 0) Y0[o_] = yv; else Y1[o_] = f2bf(yv); } } while (0)
            SC_LOAD(0); SC_DERIVE(0); SC_LOAD(1);
            __syncthreads();
            for (int c = 0; c < NCH; ++c) {
                if (c + 1 < NCH) { SC_DERIVE(c + 1); if (c + 2 < NCH) SC_LOAD(c + 2); }
                if (c >= 1) SC_FLUSH(c - 1);
                __syncthreads();
            }
            SC_FLUSH(NCH - 1);
#undef SC_LOAD
#undef SC_DERIVE
#undef SC_FLUSH
#undef SC_ROW
        } else {
            f32x2 SA[4], SB[4];
#pragma unroll
            for (int j = 0; j < 4; ++j) { SA[j] = (f32x2){0.f, 0.f}; SB[j] = (f32x2){0.f, 0.f}; }
            const int iA = wid * 16 + (lane >> 3), iB = iA + 8, cg8 = (lane & 7) * 8;
            __syncthreads();
            for (int c = 0; c < NCH; ++c) {
                const float* F = Fb + (c & 1) * TC * 384; float* yb = ybb + (c & 1) * TC * 64; const float* scl = sclb + (c & 1) * TC * 2;
#define ST_LD(o, s_) do { const float* f_ = F + (s_) * 384 + cg8; o.a0 = *(const f32x4*)(f_); o.a1 = *(const f32x4*)(f_ + 4); o.q0 = *(const f32x4*)(f_ + 256); o.q1 = *(const f32x4*)(f_ + 260); \
                o.w0 = *(const f32x4*)(f_ + 128); o.w1 = *(const f32x4*)(f_ + 132); o.b0 = *(const f32x4*)(f_ + 64); o.b1 = *(const f32x4*)(f_ + 68); o.k0 = *(const f32x4*)(f_ + 192); o.k1 = *(const f32x4*)(f_ + 196); \
                o.viA = F[(s_) * 384 + 320 + iA]; o.viB = F[(s_) * 384 + 320 + iB]; o.sc2 = *(const f32x2*)(scl + (s_) * 2); } while (0)
#define P2(v, i) (f32x2){v[i], v[i + 1]}
#define ST_ROW(o, S, vi, irow, s_) do { \
                f32x2 da = S[0] * P2(o.a0, 0), dq = S[0] * P2(o.q0, 0); da += S[1] * P2(o.a0, 2); dq += S[1] * P2(o.q0, 2); \
                da += S[2] * P2(o.a1, 0); dq += S[2] * P2(o.q1, 0); da += S[3] * P2(o.a1, 2); dq += S[3] * P2(o.q1, 2); \
                float sa = da[0] + da[1], sy = dq[0] + dq[1]; \
                sa += DPPF(sa, 0xB1); sy += DPPF(sy, 0xB1); sa += DPPF(sa, 0x4E); sy += DPPF(sy, 0x4E); sa += DPPF(sa, 0x141); sy += DPPF(sy, 0x141); \
                const f32x2 sa2 = {sa, sa}, vi2 = {vi, vi}; \
                S[0] = S[0] * P2(o.w0, 0) + sa2 * P2(o.b0, 0) + vi2 * P2(o.k0, 0); S[1] = S[1] * P2(o.w0, 2) + sa2 * P2(o.b0, 2) + vi2 * P2(o.k0, 2); \
                S[2] = S[2] * P2(o.w1, 0) + sa2 * P2(o.b1, 0) + vi2 * P2(o.k1, 0); S[3] = S[3] * P2(o.w1, 2) + sa2 * P2(o.b1, 2) + vi2 * P2(o.k1, 2); \
                yb[(s_) * 64 + irow] = sy + sa * o.sc2[0] + vi * o.sc2[1]; } while (0)
                StepOps X, Z; ST_LD(X, 0);
#pragma unroll
                for (int s = 0; s < TC; s += 2) {
                    ST_LD(Z, s + 1);
                    ST_ROW(X, SA, X.viA, iA, s); ST_ROW(X, SB, X.viB, iB, s);
                    ST_LD(X, s + 2);
                    ST_ROW(Z, SA, Z.viA, iA, s + 1); ST_ROW(Z, SB, Z.viB, iB, s + 1);
                }
#undef ST_LD
#undef ST_ROW
#undef P2
                __syncthreads();
            }
        }
    }
    __syncthreads();
}
struct ROIn { f32x4 y[4]; u32x2 y1[4], rw[4], kw[4], vw[4], a0w[4], a1w[4], gw[4]; };
DEVINL f32x4 bf4(u32x2 w) { return (f32x4){lo_bf(w.x), hi_bf(w.x), lo_bf(w.y), hi_bf(w.y)}; }
DEVINL void phase_rwkv_out(const PV& p, const float* Y, const bf16_t* Y1, const bf16_t* R, const bf16_t* Kf, const bf16_t* Vf, const bf16_t* AA, const bf16_t* Gg, bf16_t* XO) {
    const int lane = otid() & 63, gw = obid() * 8 + (otid() >> 6), nw = gridDim.x * 8;
    const float* k_a = p.in(33); const float* r_k = p.in(34); const float* lnw = p.in(35); const float* lnb = p.in(36);
#define RO_LOAD(v, r_) do { _Pragma("unroll") for (int i = 0; i < 4; ++i) { const size_t o = (size_t)(r_) * DM + i * 256 + lane * 4; \
        v.y[i] = *(const f32x4*)(Y + o); v.y1[i] = *(const u32x2*)(Y1 + o); v.rw[i] = *(const u32x2*)(R + o); v.kw[i] = *(const u32x2*)(Kf + o); v.vw[i] = *(const u32x2*)(Vf + o); \
        v.a0w[i] = *(const u32x2*)(AA + o); v.a1w[i] = *(const u32x2*)(AA + (size_t)NTOK * DM + o); v.gw[i] = *(const u32x2*)(Gg + o); } } while (0)
    ROIn cur, nxt;
    if (gw < NTOK) RO_LOAD(cur, gw);
    for (int r = gw; r < NTOK; r += nw) {
        const bool more = r + nw < NTOK;
        if (more) RO_LOAD(nxt, r + nw);
#pragma unroll
        for (int i = 0; i < 4; ++i) { const int c = i * 256 + lane * 4; const size_t o = (size_t)r * DM + c;
            const f32x4 y = cur.y[i] + bf4(cur.y1[i]);
            const f32x4 rr = bf4(cur.rw[i]), kk = bf4(cur.kw[i]), vv = bf4(cur.vw[i]), gg = bf4(cur.gw[i]);
            const f32x4 a0r = bf4(cur.a0w[i]), a1r = bf4(cur.a1w[i]);
            const f32x4 a0 = {sigm_f(a0r[0]), sigm_f(a0r[1]), sigm_f(a0r[2]), sigm_f(a0r[3])}, a1 = {sigm_f(a1r[0]), sigm_f(a1r[1]), sigm_f(a1r[2]), sigm_f(a1r[3])};
            const f32x4 ka = *(const f32x4*)(k_a + c), rk = *(const f32x4*)(r_k + c), lw = *(const f32x4*)(lnw + c), lb = *(const f32x4*)(lnb + c);
            float s = y[0] + y[1] + y[2] + y[3]; s = sum16(s); const float mu = s * (1.f / 64.f);
            const f32x4 d = y - mu; float vs = d[0] * d[0] + d[1] * d[1] + d[2] * d[2] + d[3] * d[3]; vs = sum16(vs);
            const float rstd = rsqrtf(vs * (1.f / 64.f) + 64e-5f);
            const f32x4 kd = kk * ((a0 + a1 - 2.f) * ka + 2.f);
            const f32x4 cf = rr * kd * rk; float co = cf[0] + cf[1] + cf[2] + cf[3]; co = sum16(co);
            const f32x4 out = (d * rstd * lw + lb + vv * co) * gg;
            st_bf4(XO + o, out); }
        if (more) cur = nxt;
    }
#undef RO_LOAD
}

enum { OP_PREP, OP_ROW0, OP_ROW_A, OP_ROW_B, OP_ROW_C, OP_FFN_UP, OP_FFN_DN, OP_MLA_DQKV, OP_MLA_NORM, OP_MLA_UQ, OP_MLA_UKV, OP_MLA_ATTN, OP_MLA_WO,
       OP_FN_DFT, OP_FN_DFTC, OP_FN_OUT, OP_RW_SHIFT, OP_RW_G1, OP_RW_G2W, OP_RW_G2A, OP_RW_G2G, OP_RW_SCAN, OP_RW_OUT, OP_RW_WO };
#define OPC(op, layer, which, nosync) ((op) | ((layer) << 8) | ((which) << 12) | ((nosync) << 16))
#define FFN1(l) OPC(OP_FFN_UP, l, 0, 0), OPC(OP_FFN_DN, l, 0, 0), OPC(OP_ROW_A, l, 0, 0)
#define FFN2(l) OPC(OP_ROW_B, l, 0, 0), OPC(OP_FFN_UP, l, 1, 0), OPC(OP_FFN_DN, l, 1, 0), OPC(OP_ROW_C, l, 0, 0)
#define MLA(l) OPC(OP_MLA_DQKV, l, 0, 0), OPC(OP_MLA_NORM, l, 0, 0), OPC(OP_MLA_UQ, l, 0, 1), OPC(OP_MLA_UKV, l, 0, 0), OPC(OP_MLA_ATTN, l, 0, 0), OPC(OP_MLA_WO, l, 0, 0)
constexpr int PROG[] = {
    OPC(OP_PREP, 0, 0, 0), OPC(OP_ROW0, 0, 0, 0),
    FFN1(0), MLA(0), FFN2(0),
    FFN1(1), OPC(OP_FN_DFT, 1, 0, 1), OPC(OP_FN_DFTC, 1, 0, 0), OPC(OP_FN_OUT, 1, 0, 0), FFN2(1),
    FFN1(2), OPC(OP_RW_SHIFT, 2, 0, 0), OPC(OP_RW_G1, 2, 0, 0), OPC(OP_RW_G2W, 2, 0, 1), OPC(OP_RW_G2A, 2, 0, 1), OPC(OP_RW_G2G, 2, 0, 0), OPC(OP_RW_SCAN, 2, 0, 0),
             OPC(OP_RW_OUT, 2, 0, 0), OPC(OP_RW_WO, 2, 0, 0), FFN2(2),
    FFN1(3), MLA(3), FFN2(3) };
constexpr int NPROG = 2 + (3 + 6 + 4) + (3 + 3 + 4) + (3 + 8 + 4) + (3 + 6 + 4);

#define XB_TMO      128
#define XB_XCNT(j)  (256  + 64 * (j))
#define XB_XSUB(j)  (1280 + 64 * (j))
#define XB_XGEN(j)  (2304 + 64 * (j))
#define XB_TOP      3328
#define XB_TOPGEN   3392
#define XCD_BAR_WORDS 3456
#define XB_SPIN_CAP (1u << 20)
DEVINL unsigned xb_ld(unsigned* p)              { return __hip_atomic_load(p, __ATOMIC_RELAXED, __HIP_MEMORY_SCOPE_AGENT); }
DEVINL unsigned xb_add(unsigned* p, unsigned v) { return __hip_atomic_fetch_add(p, v, __ATOMIC_RELAXED, __HIP_MEMORY_SCOPE_AGENT); }
DEVINL unsigned xb_xcc_id() { return (unsigned)__builtin_amdgcn_s_getreg((3 << 11) | 20) & 0xFu; }
#define XB_SPIN(cond, bar) do { unsigned _sp = 0; while (cond) { __builtin_amdgcn_s_sleep(1); \
    if ((++_sp & 255u) == 0u) { if (xb_ld(&(bar)[XB_TMO])) break; if (_sp > XB_SPIN_CAP) { atomicAdd(&(bar)[XB_TMO], 1u); break; } } } } while (0)
DEVINL void xcd_barrier_post(unsigned* bar) { if (otid() == 0) (void)xb_add(&bar[XB_XCNT(xb_xcc_id())], 1u); }
DEVINL void xcd_barrier_complete(unsigned* bar, unsigned x, unsigned& nloc, unsigned& nx) {
    const unsigned G = gridDim.x;
    unsigned sum, cnt, mine, sp = 0u;
    for (;;) {
        sum = 0u; cnt = 0u; mine = 0u;
#pragma unroll
        for (unsigned j = 0; j < 16; ++j) { const unsigned c = xb_ld(&bar[XB_XCNT(j)]); sum += c; cnt += (c > 0u) ? 1u : 0u; mine = (j == x) ? c : mine; }
        if (sum == G) break;
        __builtin_amdgcn_s_sleep(1);
        if ((++sp & 255u) == 0u) { if (xb_ld(&bar[XB_TMO])) break; if (sp > XB_SPIN_CAP) { atomicAdd(&bar[XB_TMO], 1u); break; } }
    }
    nloc = mine > 0u ? mine : 1u; nx = cnt > 0u ? cnt : 1u;
}
DEVINL void xcd_barrier(unsigned* bar, volatile LAS unsigned* st) {
    asm volatile("s_waitcnt vmcnt(0)" ::: "memory");
    __syncthreads();
    if (otid() == 0) {
        const unsigned x = xb_xcc_id();
        __builtin_amdgcn_s_waitcnt(0);
        unsigned nloc = st[0], nx = st[1];
        if (nloc == 0u) { xcd_barrier_complete(bar, x, nloc, nx); st[0] = nloc; st[1] = nx; }
        const unsigned old = xb_add(&bar[XB_XSUB(x)], 1u);
        const unsigned gen = old / nloc;
        if (old + 1u == (gen + 1u) * nloc) {
            __builtin_amdgcn_fence(__ATOMIC_RELEASE, "agent");
            asm volatile("s_waitcnt vmcnt(0)" ::: "memory");
            const unsigned og = xb_add(&bar[XB_TOP], 1u);
            const unsigned tg = og / nx;
            if (og + 1u == (tg + 1u) * nx) xb_add(&bar[XB_TOPGEN], 1u);
            else XB_SPIN(xb_ld(&bar[XB_TOPGEN]) == tg, bar);
            __builtin_amdgcn_fence(__ATOMIC_ACQUIRE, "agent");
            xb_add(&bar[XB_XGEN(x)], 1u);
            asm volatile("s_waitcnt vmcnt(0)" ::: "memory");
        } else {
            XB_SPIN(xb_ld(&bar[XB_XGEN(x)]) == gen, bar);
            __builtin_amdgcn_fence(__ATOMIC_ACQUIRE, "agent");
            asm volatile("s_waitcnt vmcnt(0)" ::: "memory");
        }
    }
    __syncthreads();
}
constexpr int bar_ordinal(int pc) { int n = 0; for (int q = 1; q <= pc; ++q) if (!((PROG[q] >> 16) & 1)) ++n; return n; }
template <int PC>
DEVINL void run_prog(const Params& kp, unsigned char* smem, cg::grid_group& grid) {
    LAS unsigned char* lds = (LAS unsigned char*)smem;
    {
        constexpr int code = PROG[PC], op = code & 0xff, i = (code >> 8) & 0xf, which = (code >> 12) & 0xf, nosync = (code >> 16) & 1;
        unsigned char* ws = kp.ws;
        const int zz = 0;
        float* outp = kp.out;
        const PV p{kp, zz, ws, outp};
        float* MOD = (float*)(ws + WS_MOD); float* HC = (float*)(ws + WS_HC); bf16_t* XN = (bf16_t*)(ws + WS_XN); float* Y = (float*)(ws + WS_Y);
        bf16_t* WM = (bf16_t*)(ws + WS_WM); unsigned char* SCR = ws + WS_SCR;
        const float* npre = p.in(6); const float* npost = p.in(7);
        const int kind = i % 3, j = i / 3; const bool last = (i == 3);
        const float* modi = MOD + (size_t)i * 9 * MODW;
        bf16_t* slot = (bf16_t*)(ws + WS_WF) + (size_t)(i & 1) * FFN_SLOT;
        bf16_t* G = (bf16_t*)(SCR + S_G);
        bf16_t* M = WM + (j ? WM_MLA1 : WM_MLA0);
        switch (op) {
        case OP_PREP: phase_prep(p, smem); break;
        case OP_ROW0: case OP_ROW_A: case OP_ROW_B: case OP_ROW_C: {
            RowArgs a{}; a.hin_l = p.out; a.hin_c = HC; a.hout_l = p.out; a.hout_c = HC; a.Y = Y; a.modp = modi; a.xn = XN; a.xn_ld = 1024; a.nrows = NTOK; a.upd_ctx = 1; a.modn = modi;
            if (op == OP_ROW0) { a.hin_l = p.in(0); a.hin_c = p.in(2); a.Y = nullptr; a.subn = 0; a.gpre = npre; }
            else if (op == OP_ROW_A) { a.Ys = (const float*)(ws + WS_SLAB); a.nslab = NSLAB; a.subp = 0; a.gpost = npost + (i * 3 + 0) * 1024; a.coef = 0.5f; a.subn = 1; a.gpre = npre + (i * 3 + 1) * 1024; a.xn_ld = (kind == 2) ? 2048 : 1024; }
            else if (op == OP_ROW_B) { a.Ys = (const float*)(ws + WS_SLAB); a.nslab = last ? 0 : 4; a.subp = 1; a.gpost = npost + (i * 3 + 1) * 1024; a.coef = 1.0f; a.subn = 2; a.gpre = npre + (i * 3 + 2) * 1024; a.nrows = last ? NLAT : NTOK; }
            else { a.Ys = (const float*)(ws + WS_SLAB); a.nslab = last ? 0 : NSLAB; a.subp = 2; a.gpost = npost + (i * 3 + 2) * 1024; a.coef = 0.5f; a.nrows = last ? NLAT : NTOK;
                   if (last) a.modn = nullptr; else { a.modn = MOD + (size_t)(i + 1) * 9 * MODW; a.subn = 0; a.gpre = npre + ((i + 1) * 3 + 0) * 1024; } }
            if (op == OP_ROW_A && kind == 1) phase_rows_T(a, smem, (bf16_t*)(SCR + S_XT), (bf16_t*)(SCR + S_XTC)); else phase_rows(a);
        } break;
        case OP_FFN_UP: { Gemm g{XN, slot + (size_t)which * (FFN_WGU + FFN_WD), 1024, 1024, 1024, ((last && which) ? NLAT : NTOK) / 256, 2 * DFF / 256, 0, 0}; EpiSwiGLU E{G}; gemm_phase(lds, g, E);
            if (i < 3) { const int nbusy = (g.nM * g.nN) % (int)gridDim.x, bid = obid();
                if (bid >= nbusy) { __syncthreads(); conv_ffn_w((float*)smem, p, i + 1, which, (bf16_t*)(ws + WS_WF) + (size_t)((i + 1) & 1) * FFN_SLOT, bid - nbusy, (int)gridDim.x - nbusy); } } } break;
        case OP_MLA_DQKV: { Gemm g{XN, M + MLA_DQKV, 1024, 1024, 1024, NTOK / 256, 4, 0, 0}; EpiF32 E{Y, 1024, nullptr, nullptr}; gemm_phase(lds, g, E);
            if (i == 0) { const int nbusy = (g.nM * g.nN) % (int)gridDim.x, bid = obid(); if (bid >= nbusy) { __syncthreads(); prep_late(p, smem, bid - nbusy, (int)gridDim.x - nbusy); } } } break;
        case OP_FFN_DN: case OP_MLA_WO: case OP_FN_OUT: case OP_RW_WO: {
            Gemm g{XN, M + MLA_WO, 1024, 1024, 1024, NLAT / 256, 4, 0, 0}; EpiY E{(bf16_t*)Y, nullptr, (float*)(ws + WS_SLAB)};
            bool tail = true;
            if (op == OP_FFN_DN) { g.A = G; g.Bt = slot + (size_t)which * (FFN_WGU + FFN_WD) + FFN_WGU; g.lda = g.ldb = g.K = DFF; tail = !(last && which); g.KS = 512; g.nSl = NSLAB; }
            else if (op == OP_MLA_WO) { tail = !last; g.KS = 256; g.nSl = 4; }
            else if (op == OP_FN_OUT) { g.A = (bf16_t*)(SCR + S_P); g.Bt = WM + WM_W2T; g.lda = g.ldb = g.K = 2048; E.bias = p.in(19); g.KS = 512; g.nSl = 4; }
            else { g.Bt = WM + WM_RWO; g.KS = 256; g.nSl = 4; }
            if (tail) g.nTailM = NCTX / 256; else g.nSl = 0;
            gemm_phase(lds, g, E);
        } break;
        case OP_MLA_NORM: phase_mla_norm(p, j, Y, (bf16_t*)(SCR + S_QN), (bf16_t*)(SCR + S_CKVN), (bf16_t*)(SCR + S_K)); break;
        case OP_MLA_UQ: { Gemm g{(bf16_t*)(SCR + S_QN), M + MLA_UQ, 512, 512, 512, NTOK / 256, 6, 0, 0}; EpiUQ E{(bf16_t*)(SCR + S_Q), (const float*)(ws + WS_ROPE), (const float*)(ws + WS_ROPE) + 1024}; gemm_phase(lds, g, E); } break;
        case OP_MLA_UKV: { Gemm g{(bf16_t*)(SCR + S_CKVN), M + MLA_UKV, 256, 256, 256, NTOK / 256, 8, 0, 0}; EpiUKV E{(bf16_t*)(SCR + S_K), (bf16_t*)(SCR + S_V)}; gemm_phase(lds, g, E); } break;
        case OP_MLA_ATTN: phase_attn((bf16_t*)(SCR + S_Q), (bf16_t*)(SCR + S_K), (bf16_t*)(SCR + S_V), XN, !last, (char*)smem); break;
        case OP_FN_DFT: case OP_FN_DFTC: {
            Gemm g{WM + WM_DT2, (bf16_t*)(SCR + S_XT), 2048, 2048, 2048, 128, 4, 16, (size_t)1024 * 2048 * 2}; EpiDFT1 E{(bf16_t*)(SCR + S_P), 4, 2048, 0};
            if (op == OP_FN_DFTC) { g.A = WM + WM_DT2C; g.Bt = (bf16_t*)(SCR + S_XTC); g.lda = g.ldb = g.K = 256; g.nM = 16; g.amod = 2; g.bbatch = (size_t)1024 * 256 * 2; E.shift = 1; E.rpb = 256; E.rowbase = NLAT; }
            gemm_phase(lds, g, E);
        } break;
        case OP_RW_SHIFT: phase_rwkv_shift(XN); break;
        case OP_RW_G1: { Gemm g{XN, WM + WM_WCAT, 2048, 2048, 2048, NTOK / 256, 14, 0, 0}; EpiRwkv1 E{(bf16_t*)(SCR + S_R), (bf16_t*)(SCR + S_A2)}; gemm_phase(lds, g, E); } break;
        case OP_RW_G2W: case OP_RW_G2A: {
            Gemm g{(bf16_t*)(SCR + S_A2), WM + WM_BW, 512, 256, 256, NTOK / 256, 8, 0, 0};
            if (op == OP_RW_G2A) { g.Bt = WM + WM_BA; EpiRwkv2<1> E{(bf16_t*)(SCR + S_AA), p.in(27)}; gemm_phase(lds, g, E); }
            else { EpiRwkv2<0> E{XN, p.in(24)}; gemm_phase(lds, g, E); }
        } break;
        case OP_RW_G2G: { Gemm g{(bf16_t*)(SCR + S_A2) + 256, WM + WM_BG, 512, 256, 256, NTOK / 256, 4, 0, 0}; EpiBf16 E{(bf16_t*)(SCR + S_GG), 1024}; gemm_phase(lds, g, E); } break;
        case OP_RW_SCAN: phase_scan(p, (bf16_t*)(SCR + S_R), (bf16_t*)(SCR + S_KK), (bf16_t*)(SCR + S_VV), (bf16_t*)(SCR + S_AA), XN, Y, (bf16_t*)(ws + WS_SLAB), smem); break;
        case OP_RW_OUT: phase_rwkv_out(p, Y, (const bf16_t*)(ws + WS_SLAB), (bf16_t*)(SCR + S_R), (bf16_t*)(SCR + S_KK), (bf16_t*)(SCR + S_VV), (bf16_t*)(SCR + S_AA), (bf16_t*)(SCR + S_GG), XN); break;
        default: break;
        }
        if (!nosync && PC + 1 < NPROG) { if (PC == 0 && kp.ws == nullptr) grid.sync(); xcd_barrier((unsigned*)(kp.ws + WS_BAR), (volatile LAS unsigned*)(lds + LDS_BYTES - 16)); }
    }
    if constexpr (PC + 1 < NPROG) run_prog<PC + 1>(kp, smem, grid);
}
__global__ void __launch_bounds__(512) fwd_megakernel(Params kp) {
    extern __shared__ __attribute__((aligned(16))) unsigned char smem[];
    cg::grid_group grid = cg::this_grid();
    if (otid() < 4) ((volatile LAS unsigned*)((LAS unsigned char*)smem + LDS_BYTES - 16))[otid()] = 0u;
    __syncthreads();
    xcd_barrier_post((unsigned*)(kp.ws + WS_BAR));
    run_prog<0>(kp, smem, grid);
}

extern "C" void kernel_launch(void* const* d_in, const int* in_sizes, int n_in, void* d_out, int out_size, void* d_ws, size_t ws_size, hipStream_t stream) {
    static int grid = 0;
    if (grid == 0) {
        if (n_in != 38 || ws_size < WS_END) { fprintf(stderr, "kernel_launch: need 38 inputs and %zu bytes of workspace; got %d, %zu\n", (size_t)WS_END, n_in, ws_size); grid = -1; return; }
        int dev = 0, cus = 0, per_cu = 0;
        (void)hipGetDevice(&dev); (void)hipDeviceGetAttribute(&cus, hipDeviceAttributeMultiprocessorCount, dev);
        if (hipFuncSetAttribute((const void*)fwd_megakernel, hipFuncAttributeMaxDynamicSharedMemorySize, LDS_BYTES) != hipSuccess) { fprintf(stderr, "kernel_launch: hipFuncSetAttribute failed\n"); grid = -1; return; }
        if (hipOccupancyMaxActiveBlocksPerMultiprocessor(&per_cu, (const void*)fwd_megakernel, 512, LDS_BYTES) != hipSuccess || per_cu < 1) { fprintf(stderr, "kernel_launch: occupancy query says %d\n", per_cu); per_cu = 1; }
        (void)hipGetLastError();
        grid = cus * 1;
    }
    if (grid < 0) return;
    Params p{};
    for (int i = 0; i < 38; ++i) p.in[i] = (const float*)d_in[i];
    p.out = (float*)d_out; p.ws = (unsigned char*)d_ws;
    if (hipMemsetAsync((char*)d_ws + WS_BAR, 0, 16384, stream) != hipSuccess) { fprintf(stderr, "kernel_launch: memset failed\n"); return; }
    void* args[] = {&p};
    hipError_t e = hipLaunchCooperativeKernel((const void*)fwd_megakernel, dim3(grid), dim3(512), args, LDS_BYTES, stream);
    if (e != hipSuccess) fprintf(stderr, "cooperative launch failed: %s (grid %d)\n", hipGetErrorString(e), grid);
}
```
